# Optimizing an MI355X kernel written in HIP

```python
import jax
import jax.numpy as jnp
from jax import lax
import numpy as np

D_MODEL = 1024
BATCH = 2
SEQ = 16384
DEPTH = 4

CTX_LEN = 256
GRID_W = 64
HEAD_DIM = 64
GROUP_HEADS = 4
GROUP_W = GROUP_HEADS * HEAD_DIM
N_MIXERS = 4
MIX_W = N_MIXERS * GROUP_W
MLA_Q_RANK = 256
MLA_KV_RANK = 128
MLA_NOPE = 64
MLA_ROPE = 32
MLA_V = 64
MLA_BLOCK = 128
RET_CHUNK = 128
NA_KR = 8
NA_KC = 16
SWA_KV_HEADS = 2
SWA_WINDOW = 128
SWA_BLOCK = 128
FFN_HIDDEN = ((8 * D_MODEL + 3 * 256 - 1) // (3 * 256)) * 256
ROPE_THETA = 10000.0
EPS = 1e-6
NEG_INF = -1e30

IN_SIZES = (MLA_Q_RANK, MLA_KV_RANK, MLA_ROPE,
            GROUP_W, GROUP_W, GROUP_W, GROUP_W, GROUP_W,
            GROUP_W, GROUP_W, GROUP_W,
            GROUP_W, SWA_KV_HEADS * HEAD_DIM, SWA_KV_HEADS * HEAD_DIM)
IN_W = sum(IN_SIZES)
IN_SPLIT = tuple(sum(IN_SIZES[:i + 1]) for i in range(len(IN_SIZES) - 1))

kernel_name = 'hybrid_parallel_head_flow_block'


def rms_norm(x, g):
    xf = x.astype(jnp.float32)
    y = xf * lax.rsqrt(jnp.mean(xf * xf, axis=-1, keepdims=True) + EPS)
    return (y * g.astype(jnp.float32)).astype(x.dtype)


def head_rms(t):
    return t * lax.rsqrt(jnp.mean(t * t, axis=-1, keepdims=True) + EPS)


def heads(t, h):
    b, n, _ = t.shape
    return t.reshape(b, n, h, -1).transpose(0, 2, 1, 3)


def merge_heads(t):
    b, h, n, d = t.shape
    return t.transpose(0, 2, 1, 3).reshape(b, n, h * d)


def rope_1d(x, pos):
    d = x.shape[-1]
    inv = ROPE_THETA ** (-jnp.arange(0, d, 2, dtype=jnp.float32) / d)
    ang = pos.astype(jnp.float32)[:, None] * inv[None, :]
    cos, sin = jnp.cos(ang), jnp.sin(ang)
    xf = x.astype(jnp.float32)
    x1, x2 = xf[..., : d // 2], xf[..., d // 2:]
    return jnp.concatenate([x1 * cos - x2 * sin, x2 * cos + x1 * sin], axis=-1).astype(x.dtype)


def rope_2d(x, row, col):
    h = x.shape[-1] // 2
    return jnp.concatenate([rope_1d(x[..., :h], row), rope_1d(x[..., h:], col)], axis=-1)


def softmax_attend(q, k, v, scale, sink=None):
    s = jnp.einsum('bhqd,bhkd->bhqk', q, k, preferred_element_type=jnp.float32) * scale
    if sink is not None:
        s = jnp.concatenate([s, jnp.broadcast_to(sink.astype(jnp.float32)[None, :, None, None], s.shape[:-1] + (1,))], axis=-1)
    p = jax.nn.softmax(s, axis=-1)
    if sink is not None:
        p = p[..., :-1]
    return jnp.einsum('bhqk,bhkd->bhqd', p.astype(v.dtype), v)


def mla_mixer(xcq, xckv, xkr, ycq, yckv, ykr, row, col, q_norm, w_uq, kv_norm, w_ukv):
    H = GROUP_HEADS
    scale = (MLA_NOPE + MLA_ROPE) ** -0.5

    def qkv(cq, ckv, kr, rotate):
        q = heads(rms_norm(cq, q_norm) @ w_uq, H)
        kv = heads(rms_norm(ckv, kv_norm) @ w_ukv, H)
        q_nope, q_rope = q[..., :MLA_NOPE], q[..., MLA_NOPE:]
        k_nope, v = kv[..., :MLA_NOPE], kv[..., MLA_NOPE:]
        k_rope = kr[:, None]
        if rotate:
            q_rope = rope_2d(q_rope, row, col)
            k_rope = rope_2d(k_rope, row, col)
        k_rope = jnp.broadcast_to(k_rope, k_nope.shape[:-1] + (MLA_ROPE,))
        return (jnp.concatenate([q_nope, q_rope], axis=-1),
                jnp.concatenate([k_nope, k_rope], axis=-1), v)

    qx, kx, vx = qkv(xcq, xckv, xkr, True)
    qy, ky, vy = qkv(ycq, yckv, ykr, False)
    k_all = jnp.concatenate([kx, ky], axis=2)
    v_all = jnp.concatenate([vx, vy], axis=2)
    B, _, S, dq = qx.shape
    nb = S // MLA_BLOCK
    qb = jnp.moveaxis(qx.reshape(B, H, nb, MLA_BLOCK, dq), 2, 0)
    ob = lax.map(lambda qblk: softmax_attend(qblk, k_all, v_all, scale), qb)
    ox = jnp.moveaxis(ob, 0, 2).reshape(B, H, S, MLA_V)
    oy = softmax_attend(qy, ky, vy, scale)
    return merge_heads(ox), merge_heads(oy)


def retention_scan(q, k, v, log_g, state0):
    B, H, T, _ = q.shape
    C = RET_CHUNK
    n = T // C
    i = jnp.arange(C, dtype=jnp.float32)
    diff = i[:, None] - i[None, :]
    lg = log_g[:, None, None]
    inner_decay = jnp.where(diff >= 0, jnp.exp(lg * jnp.maximum(diff, 0.0)), 0.0)
    q_decay = jnp.exp(lg * (i + 1.0)[:, None])
    k_decay = jnp.exp(lg * (C - 1.0 - i)[:, None])
    chunk_decay = jnp.exp(lg * C)

    def chunks(t):
        return jnp.moveaxis(t.reshape(B, H, n, C, t.shape[-1]), 2, 0)

    def step(state, inp):
        qc, kc, vc = inp
        att = jnp.einsum('bhid,bhjd->bhij', qc, kc) * inner_decay
        out = (jnp.einsum('bhij,bhjd->bhid', att, vc)
               + jnp.einsum('bhid,bhde->bhie', qc, state) * q_decay)
        state = state * chunk_decay + jnp.einsum('bhjd,bhje->bhde', kc * k_decay, vc)
        return state, out

    state, out = lax.scan(step, state0, (chunks(q), chunks(k), chunks(v)))
    return jnp.moveaxis(out, 0, 2).reshape(B, H, T, v.shape[-1]), state


def retention_mixer(xq, xk, xv, xgf, xgb, yq, yk, yv, ygf, ygb, decay, row, col):
    H = GROUP_HEADS
    f32 = jnp.float32
    kscale = HEAD_DIM ** -0.5
    q = rope_2d(heads(xq, H), row, col).astype(f32)
    k = rope_2d(heads(xk, H), row, col).astype(f32) * kscale
    v = heads(xv, H).astype(f32)
    qy = heads(yq, H).astype(f32)
    ky = heads(yk, H).astype(f32) * kscale
    vy = heads(yv, H).astype(f32)
    log_g = jax.nn.log_sigmoid(decay.astype(f32))
    zero = jnp.zeros((q.shape[0], H, HEAD_DIM, HEAD_DIM), f32)
    flip = lambda t: jnp.flip(t, axis=2)
    yf, sf = retention_scan(qy, ky, vy, log_g[0], zero)
    of, _ = retention_scan(q, k, v, log_g[0], sf)
    yb, sb = retention_scan(flip(qy), flip(ky), flip(vy), log_g[1], zero)
    ob, _ = retention_scan(flip(q), flip(k), flip(v), log_g[1], sb)

    def gate_merge(o_f, o_b, gf, gb):
        out = (head_rms(o_f) * jax.nn.silu(heads(gf, H).astype(f32))
               + head_rms(flip(o_b)) * jax.nn.silu(heads(gb, H).astype(f32)))
        return merge_heads(out).astype(gf.dtype)

    return gate_merge(of, ob, xgf, xgb), gate_merge(yf, yb, ygf, ygb)


def na_mixer(xq, xk, xv, yq, yk, yv, rpb):
    B, S, _ = xq.shape
    H, d = GROUP_HEADS, HEAD_DIM
    rows = S // GRID_W
    kr = min(NA_KR, rows)
    scale = d ** -0.5
    q = xq.reshape(B, rows, GRID_W, H, d)
    k = xk.reshape(B, rows, GRID_W, H, d)
    v = xv.reshape(B, rows, GRID_W, H, d)
    r = jnp.arange(rows)
    r0 = jnp.clip(r - kr // 2, 0, rows - kr)
    row_idx = r0[:, None] + jnp.arange(kr)[None, :]
    kg = k[:, row_idx]
    vg = v[:, row_idx]
    c = jnp.arange(GRID_W)
    c0 = jnp.clip(c - NA_KC // 2, 0, GRID_W - NA_KC)
    col_in = (c[None, :] >= c0[:, None]) & (c[None, :] < c0[:, None] + NA_KC)
    dr = row_idx - r[:, None] + NA_KR - 1
    dc = jnp.clip(c[None, :] - c[:, None], -(NA_KC - 1), NA_KC - 1) + NA_KC - 1
    bias = rpb[:, dr[:, None, :, None], dc[None, :, None, :]].astype(jnp.float32)
    s_loc = jnp.einsum('brchd,brkwhd->bhrckw', q, kg, preferred_element_type=jnp.float32) * scale + bias
    s_loc = jnp.where(col_in[:, None, :], s_loc, NEG_INF)
    kyh = yk.reshape(B, -1, H, d)
    vyh = yv.reshape(B, -1, H, d)
    s_ctx = jnp.einsum('brchd,blhd->bhrcl', q, kyh, preferred_element_type=jnp.float32) * scale
    n_loc = kr * GRID_W
    p = jax.nn.softmax(jnp.concatenate([s_loc.reshape(B, H, rows, GRID_W, n_loc), s_ctx], axis=-1), axis=-1)
    p_loc = p[..., :n_loc].reshape(B, H, rows, GRID_W, kr, GRID_W).astype(xv.dtype)
    p_ctx = p[..., n_loc:].astype(xv.dtype)
    ox = (jnp.einsum('bhrckw,brkwhd->brchd', p_loc, vg)
          + jnp.einsum('bhrcl,blhd->brchd', p_ctx, vyh)).reshape(B, S, H * d)
    oy = softmax_attend(heads(yq, H), heads(yk, H), heads(yv, H), scale)
    return ox, merge_heads(oy)


def swa_mixer(xq, xk, xv, yq, yk, yv, sink, row, col):
    B, S, _ = xq.shape
    Hq, Hk = GROUP_HEADS, SWA_KV_HEADS
    G = Hq // Hk
    d = HEAD_DIM
    Bl = SWA_BLOCK
    nb = S // Bl
    scale = d ** -0.5
    q = rope_2d(heads(xq, Hq), row, col)
    k = rope_2d(heads(xk, Hk), row, col)
    v = heads(xv, Hk)
    qb = q.reshape(B, Hk, G, nb, Bl, d)

    def window(t):
        tp = jnp.pad(t, ((0, 0), (0, 0), (Bl, Bl), (0, 0))).reshape(B, Hk, nb + 2, Bl, d)
        return jnp.concatenate([tp[:, :, :-2], tp[:, :, 1:-1], tp[:, :, 2:]], axis=3)

    kw, vw = window(k), window(v)
    qi = jnp.arange(Bl)
    j = jnp.arange(3 * Bl)
    blk = jnp.arange(nb)
    key_pos = (blk[:, None] - 1) * Bl + j[None, :]
    delta = j[None, :] - Bl - qi[:, None]
    valid = (jnp.abs(delta) <= SWA_WINDOW)[None] & ((key_pos >= 0) & (key_pos < S))[:, None, :]
    s_win = jnp.einsum('bkgnqd,bknjd->bkgnqj', qb, kw, preferred_element_type=jnp.float32) * scale
    s_win = jnp.where(valid, s_win, NEG_INF)
    ky = heads(yk, Hk)
    vy = heads(yv, Hk)
    L = ky.shape[2]
    s_ctx = jnp.einsum('bkgnqd,bkld->bkgnql', qb, ky, preferred_element_type=jnp.float32) * scale
    s_sink = jnp.broadcast_to(sink.astype(jnp.float32).reshape(Hk, G, 1, 1, 1), (B, Hk, G, nb, Bl, 1))
    p = jax.nn.softmax(jnp.concatenate([s_win, s_ctx, s_sink], axis=-1), axis=-1)
    ox = (jnp.einsum('bkgnqj,bknjd->bkgnqd', p[..., :3 * Bl].astype(xv.dtype), vw)
          + jnp.einsum('bkgnql,bkld->bkgnqd', p[..., 3 * Bl:3 * Bl + L].astype(xv.dtype), vy))
    ox = ox.reshape(B, Hq, S, d)
    oy = softmax_attend(heads(yq, Hq), jnp.repeat(ky, G, axis=1), jnp.repeat(vy, G, axis=1), scale, sink)
    return merge_heads(ox), merge_heads(oy)


def token_mixers(px, py, row, col, mla_q_norm, mla_w_uq, mla_kv_norm, mla_w_ukv, ret_decay, na_rpb, swa_sink):
    xs = jnp.split(px, IN_SPLIT, axis=-1)
    ys = jnp.split(py, IN_SPLIT, axis=-1)
    mla_x, mla_y = mla_mixer(xs[0], xs[1], xs[2], ys[0], ys[1], ys[2], row, col,
                             mla_q_norm, mla_w_uq, mla_kv_norm, mla_w_ukv)
    ret_x, ret_y = retention_mixer(xs[3], xs[4], xs[5], xs[6], xs[7],
                                   ys[3], ys[4], ys[5], ys[6], ys[7], ret_decay, row, col)
    na_x, na_y = na_mixer(xs[8], xs[9], xs[10], ys[8], ys[9], ys[10], na_rpb)
    swa_x, swa_y = swa_mixer(xs[11], xs[12], xs[13], ys[11], ys[12], ys[13], swa_sink, row, col)
    return (jnp.concatenate([mla_x, ret_x, na_x, swa_x], axis=-1),
            jnp.concatenate([mla_y, ret_y, na_y, swa_y], axis=-1))


def swiglu(h, w1, w3, w2):
    return (jax.nn.silu(h @ w1) * (h @ w3)) @ w2


def setup_inputs(seed: int = 0) -> dict:
    key = jax.random.key(seed)
    ks = jax.random.split(key, 24)
    f32 = jnp.float32
    nrm = lambda k, shape, s: jax.random.normal(k, shape, f32) * s
    H = GROUP_HEADS
    L = DEPTH
    base_decay = jnp.log(2.0 ** (5.0 + jnp.arange(H, dtype=f32)) - 1.0)
    return {
        'x': nrm(ks[0], (BATCH, SEQ, D_MODEL), 1.0),
        'c': nrm(ks[1], (BATCH, D_MODEL), 1.0),
        'ctx': nrm(ks[2], (BATCH, CTX_LEN, D_MODEL), 1.0),
        'c_ctx': nrm(ks[3], (D_MODEL,), 1.0),
        'ada_w': nrm(ks[4], (L, D_MODEL, 6 * D_MODEL), 0.5 * D_MODEL ** -0.5),
        'ada_b': nrm(ks[5], (L, 6 * D_MODEL), 0.02),
        'norm1_g': 1.0 + nrm(ks[6], (L, D_MODEL), 0.02),
        'w_in': nrm(ks[7], (L, D_MODEL, IN_W), D_MODEL ** -0.5),
        'mla_q_norm': 1.0 + nrm(ks[8], (L, MLA_Q_RANK), 0.02),
        'mla_w_uq': nrm(ks[9], (L, MLA_Q_RANK, H * (MLA_NOPE + MLA_ROPE)), MLA_Q_RANK ** -0.5),
        'mla_kv_norm': 1.0 + nrm(ks[10], (L, MLA_KV_RANK), 0.02),
        'mla_w_ukv': nrm(ks[11], (L, MLA_KV_RANK, H * (MLA_NOPE + MLA_V)), MLA_KV_RANK ** -0.5),
        'ret_decay': base_decay[None, None, :] + nrm(ks[12], (L, 2, H), 0.1),
        'na_rpb': nrm(ks[13], (L, H, 2 * NA_KR - 1, 2 * NA_KC - 1), 0.1),
        'swa_sink': nrm(ks[14], (L, H), 0.5),
        'w_out': nrm(ks[15], (L, MIX_W, D_MODEL), MIX_W ** -0.5),
        'norm2_g': 1.0 + nrm(ks[16], (L, D_MODEL), 0.02),
        'ffn_w1': nrm(ks[17], (L, D_MODEL, FFN_HIDDEN), D_MODEL ** -0.5),
        'ffn_w3': nrm(ks[18], (L, D_MODEL, FFN_HIDDEN), D_MODEL ** -0.5),
        'ffn_w2': nrm(ks[19], (L, FFN_HIDDEN, D_MODEL), FFN_HIDDEN ** -0.5),
        'final_norm_g': 1.0 + nrm(ks[20], (D_MODEL,), 0.02),
    }


def reference(x, c, ctx, c_ctx, ada_w, ada_b, norm1_g, w_in, mla_q_norm, mla_w_uq, mla_kv_norm,
              mla_w_ukv, ret_decay, na_rpb, swa_sink, w_out, norm2_g, ffn_w1, ffn_w3, ffn_w2,
              final_norm_g):
    S = x.shape[1]
    t = jnp.arange(S)
    row = t // GRID_W
    col = t % GRID_W
    y = ctx
    sc = jax.nn.silu(c)
    scc = jax.nn.silu(c_ctx)
    for l in range(DEPTH):
        mod_x = (sc @ ada_w[l] + ada_b[l])[:, None, :]
        mod_y = scc @ ada_w[l] + ada_b[l]
        shx1, scx1, gx1, shx2, scx2, gx2 = jnp.split(mod_x, 6, axis=-1)
        shy1, scy1, gy1, shy2, scy2, gy2 = jnp.split(mod_y, 6, axis=-1)
        hx = rms_norm(x, norm1_g[l]) * (1.0 + scx1) + shx1
        hy = rms_norm(y, norm1_g[l]) * (1.0 + scy1) + shy1
        mx, my = token_mixers(hx @ w_in[l], hy @ w_in[l], row, col, mla_q_norm[l], mla_w_uq[l],
                              mla_kv_norm[l], mla_w_ukv[l], ret_decay[l], na_rpb[l], swa_sink[l])
        x = x + gx1 * (mx @ w_out[l])
        hx = rms_norm(x, norm2_g[l]) * (1.0 + scx2) + shx2
        x = x + gx2 * swiglu(hx, ffn_w1[l], ffn_w3[l], ffn_w2[l])
        if l < DEPTH - 1:
            y = y + gy1 * (my @ w_out[l])
            hy = rms_norm(y, norm2_g[l]) * (1.0 + scy2) + shy2
            y = y + gy2 * swiglu(hy, ffn_w1[l], ffn_w3[l], ffn_w2[l])
    return rms_norm(x, final_norm_g)
```

```cpp
#include <hip/hip_runtime.h>
#include <hip/hip_cooperative_groups.h>
#include <cstdio>
#include <cstdint>
namespace cg = cooperative_groups;

#ifndef MULTI_LAUNCH
#define MULTI_LAUNCH 0
#endif

typedef unsigned short bf16_t;
typedef short bf16x8 __attribute__((ext_vector_type(8)));
typedef short s16x4 __attribute__((ext_vector_type(4)));
typedef float f32x4 __attribute__((ext_vector_type(4)));
typedef float f32x2 __attribute__((ext_vector_type(2)));
typedef __bf16 bf2_t __attribute__((ext_vector_type(2)));
typedef unsigned u32x4 __attribute__((ext_vector_type(4)));
typedef unsigned u32x2 __attribute__((ext_vector_type(2)));
#define MK4(a,b,c,d) ((u32x4){(a),(b),(c),(d)})
#define MK2(a,b) ((u32x2){(a),(b)})

#define NROWS 33280
#define NLAT 32768
#define PW 3072
#define LOG2E 1.4426950408889634f
#define LDS_BYTES 73728

#define C_CQ 0
#define C_CKV 256
#define C_KR 384
#define C_RQ 416
#define C_RK 672
#define C_RV 928
#define C_RGF 1184
#define C_RGB 1440
#define C_NQ 1696
#define C_NK 1952
#define C_NV 2208
#define C_SQ 2464
#define C_SK 2720
#define C_SV 2848

#define WO_IN 0
#define WO_UQ 3145728
#define WO_UKV 3244032
#define WO_OUT 3309568
#define WO_13 4358144
#define WO_2 10125312
#define W_LAYER 13008896

struct Params {
  const float *x, *c, *ctx, *c_ctx, *ada_w, *ada_b, *norm1_g, *w_in, *mla_q_norm, *mla_w_uq, *mla_kv_norm, *mla_w_ukv,
      *ret_decay, *na_rpb, *swa_sink, *w_out, *norm2_g, *ffn_w1, *ffn_w3, *ffn_w2, *final_g;
  float* out;
  float* Y;
  bf16_t* ACT;
  bf16_t* P;
  bf16_t *Qm, *Km, *Vm;
  float* Ksum;
  bf16_t* St;
  bf16_t* W;
  float* mod;
  float* rope64;
  float* rope32;
};

__device__ __forceinline__ int otid() { int t = threadIdx.x; asm volatile("" : "+v"(t)); return t; }
typedef __amdgpu_buffer_rsrc_t rsrc_t;
__device__ __forceinline__ rsrc_t mkbuf(const void* base) { return __builtin_amdgcn_make_buffer_rsrc((void*)base, 0, 0x7fffffff, 0x00020000); }
__device__ __forceinline__ u32x4 bload16(rsrc_t r, unsigned voff, unsigned soff) { return __builtin_amdgcn_raw_buffer_load_b128(r, voff, soff, 0); }
__device__ __forceinline__ u32x2 bload8(rsrc_t r, unsigned voff, unsigned soff) { return __builtin_amdgcn_raw_buffer_load_b64(r, voff, soff, 0); }
__device__ __forceinline__ float bf2f(bf16_t h) { return __uint_as_float(((unsigned)h) << 16); }
__device__ __forceinline__ unsigned pack2(float a, float b) { f32x2 v = {a, b}; bf2_t r = __builtin_convertvector(v, bf2_t); return __builtin_bit_cast(unsigned, r); }
__device__ __forceinline__ bf16_t f2bf(float a) { return (bf16_t)(pack2(a, 0.f) & 0xffffu); }
__device__ __forceinline__ float lo_f(unsigned u) { return __uint_as_float(u << 16); }
__device__ __forceinline__ float hi_f(unsigned u) { return __uint_as_float(u & 0xffff0000u); }
__device__ __forceinline__ f32x4 mfma16(bf16x8 a, bf16x8 b, f32x4 c) { return __builtin_amdgcn_mfma_f32_16x16x32_bf16(a, b, c, 0, 0, 0); }
typedef __attribute__((address_space(3))) s16x4 lds_s16x4;
__device__ __forceinline__ s16x4 tr_read(const bf16_t* p) { return __builtin_amdgcn_ds_read_tr16_b64_v4i16((lds_s16x4*)p); }
__device__ __forceinline__ bf16x8 cat8(s16x4 a, s16x4 b) { bf16x8 r; r[0]=a[0]; r[1]=a[1]; r[2]=a[2]; r[3]=a[3]; r[4]=b[0]; r[5]=b[1]; r[6]=b[2]; r[7]=b[3]; return r; }
__device__ __forceinline__ float wave_sum(float v) {
  v += __shfl_xor(v, 32); v += __shfl_xor(v, 16); v += __shfl_xor(v, 8); v += __shfl_xor(v, 4); v += __shfl_xor(v, 2); v += __shfl_xor(v, 1); return v;
}
__device__ __forceinline__ float silu_f(float a) { return a / (1.f + __expf(-a)); }

__device__ __forceinline__ float* xrow(const Params& p, int row) { return row < NLAT ? p.out + (size_t)row * 1024 : p.Y + (size_t)(row - NLAT) * 1024; }
__device__ __forceinline__ const float* xsrc(const Params& p, int l, int row) {
  if (l == 0) return row < NLAT ? p.x + (size_t)row * 1024 : p.ctx + (size_t)(row - NLAT) * 1024;
  return xrow(p, row);
}
__device__ __forceinline__ int modv(int row) { return row < 16384 ? 0 : (row < NLAT ? 1 : 2); }

__device__ void transpose_tile(const float* __restrict__ src, int N, int k0, int n0, bf16_t* __restrict__ dst, int ldd, int mode,
                               const float* __restrict__ kscale, char* lds) {
  bf16_t(*t)[66] = (bf16_t(*)[66])lds;
  const int tid = otid();
  __syncthreads();
#pragma unroll 4
  for (int i = 0; i < 16; ++i) {
    int kk = i * 4 + (tid >> 6), nn = tid & 63;
    float v = (n0 + nn < N) ? src[(size_t)(k0 + kk) * N + n0 + nn] : 0.f;
    if (kscale) v *= kscale[k0 + kk];
    t[kk][nn] = f2bf(v);
  }
  __syncthreads();
  int nn = tid >> 2, kq = tid & 3;
  int n = n0 + nn;
  if (n < N) {
    int row = mode == 0 ? n : ((n >> 4) * 32 + (n & 15) + (mode == 2 ? 16 : 0));
    unsigned w[8];
#pragma unroll
    for (int e = 0; e < 8; ++e) w[e] = (unsigned)t[kq * 16 + 2 * e][nn] | ((unsigned)t[kq * 16 + 2 * e + 1][nn] << 16);
    u32x4* d = (u32x4*)(dst + (size_t)row * ldd + k0 + kq * 16);
    d[0] = MK4(w[0], w[1], w[2], w[3]);
    d[1] = MK4(w[4], w[5], w[6], w[7]);
  }
}

__device__ void prologue_phase(const Params& p, int bid, int nb, char* lds) {
  const int tid = otid();
  for (int it = bid; it < 4 * 3160; it += nb) {
    int l = it / 3160, r = it % 3160;
    bf16_t* W = p.W + (size_t)l * W_LAYER;
    if (r < 752) { int kt = r / 47, nt = r % 47; transpose_tile(p.w_in + (size_t)l * 1024 * 2976, 2976, kt * 64, nt * 64, W + WO_IN, 1024, 0, nullptr, lds); continue; }
    r -= 752;
    if (r < 24) { int kt = r / 6, nt = r % 6; transpose_tile(p.mla_w_uq + (size_t)l * 256 * 384, 384, kt * 64, nt * 64, W + WO_UQ, 256, 0, p.mla_q_norm + l * 256, lds); continue; }
    r -= 24;
    if (r < 16) { int kt = r / 8, nt = r % 8; transpose_tile(p.mla_w_ukv + (size_t)l * 128 * 512, 512, kt * 64, nt * 64, W + WO_UKV, 128, 0, p.mla_kv_norm + l * 128, lds); continue; }
    r -= 16;
    if (r < 256) { int kt = r / 16, nt = r % 16; transpose_tile(p.w_out + (size_t)l * 1024 * 1024, 1024, kt * 64, nt * 64, W + WO_OUT, 1024, 0, nullptr, lds); continue; }
    r -= 256;
    if (r < 704) { int kt = r / 44, nt = r % 44; transpose_tile(p.ffn_w1 + (size_t)l * 1024 * 2816, 2816, kt * 64, nt * 64, W + WO_13, 1024, 1, nullptr, lds); continue; }
    r -= 704;
    if (r < 704) { int kt = r / 44, nt = r % 44; transpose_tile(p.ffn_w3 + (size_t)l * 1024 * 2816, 2816, kt * 64, nt * 64, W + WO_13, 1024, 2, nullptr, lds); continue; }
    r -= 704;
    { int kt = r / 16, nt = r % 16; transpose_tile(p.ffn_w2 + (size_t)l * 2816 * 1024, 1024, kt * 64, nt * 64, W + WO_2, 2816, 0, nullptr, lds); }
  }
  for (int it = bid; it < 4 * 48; it += nb) {
    int l = it / 48, part = it % 48;
    u32x4* d = (u32x4*)(p.W + (size_t)l * W_LAYER + WO_IN + (size_t)2976 * 1024);
    d[part * 256 + tid] = MK4(0, 0, 0, 0);
  }
  for (int it = bid; it < 4 * 96; it += nb) {
    int l = it / 96, cb = it % 96;
    float* s = (float*)lds;
    float* red = s + 3 * 1024;
    __syncthreads();
    for (int i = tid; i < 3072; i += 256) {
      int v = i >> 10, k = i & 1023;
      float cv = v < 2 ? p.c[v * 1024 + k] : p.c_ctx[k];
      s[i] = silu_f(cv);
    }
    __syncthreads();
    int col = cb * 64 + (tid & 63), kp = tid >> 6;
    const float* w = p.ada_w + (size_t)l * 1024 * 6144 + (size_t)(kp * 256) * 6144 + col;
    float a0 = 0.f, a1 = 0.f, a2 = 0.f;
#pragma unroll 8
    for (int k = 0; k < 256; ++k) {
      float wv = w[(size_t)k * 6144];
      a0 += s[kp * 256 + k] * wv; a1 += s[1024 + kp * 256 + k] * wv; a2 += s[2048 + kp * 256 + k] * wv;
    }
    red[(kp * 3 + 0) * 64 + (tid & 63)] = a0; red[(kp * 3 + 1) * 64 + (tid & 63)] = a1; red[(kp * 3 + 2) * 64 + (tid & 63)] = a2;
    __syncthreads();
    if (tid < 192) {
      int v = tid >> 6, cc = tid & 63;
      float sum = red[(0 * 3 + v) * 64 + cc] + red[(1 * 3 + v) * 64 + cc] + red[(2 * 3 + v) * 64 + cc] + red[(3 * 3 + v) * 64 + cc];
      p.mod[(size_t)(l * 3 + v) * 6144 + cb * 64 + cc] = sum + p.ada_b[l * 6144 + cb * 64 + cc];
    }
  }
  if (bid == (nb > 1 ? 1 : 0)) {
    int pos = tid;
    for (int i = 0; i < 16; ++i) {
      float inv = exp2f(-(float)(2 * i) / 32.f * 13.287712379549449f);
      float ang = (float)pos * inv;
      float n = rintf(ang * 0.15915494309189535f);
      float r = fmaf(-n, 6.28318548202514648f, ang); r = fmaf(-n, -1.74845553146951715e-07f, r);
      p.rope64[(pos * 16 + i) * 2] = cosf(r); p.rope64[(pos * 16 + i) * 2 + 1] = sinf(r);
    }
    for (int i = 0; i < 8; ++i) {
      float inv = exp2f(-(float)(2 * i) / 16.f * 13.287712379549449f);
      float ang = (float)pos * inv;
      float n = rintf(ang * 0.15915494309189535f);
      float r = fmaf(-n, 6.28318548202514648f, ang); r = fmaf(-n, -1.74845553146951715e-07f, r);
      p.rope32[(pos * 8 + i) * 2] = cosf(r); p.rope32[(pos * 8 + i) * 2 + 1] = sinf(r);
    }
  }
}

__device__ void norm_phase(const Params& p, int l, int which, int bid, int nb) {
  const int wave = otid() >> 6, lane = otid() & 63;
  const float* g = (which == 0 ? p.norm1_g : p.norm2_g) + l * 1024;
  for (int row = bid * 4 + wave; row < NROWS; row += nb * 4) {
    const float* src = which == 0 ? xsrc(p, l, row) : xrow(p, row);
    const float* md = p.mod + (size_t)(l * 3 + modv(row)) * 6144 + which * 3072;
    f32x4 v[4]; float ss = 0.f;
#pragma unroll
    for (int i = 0; i < 4; ++i) { v[i] = *(const f32x4*)(src + i * 256 + lane * 4); ss += v[i][0] * v[i][0] + v[i][1] * v[i][1] + v[i][2] * v[i][2] + v[i][3] * v[i][3]; }
    ss = wave_sum(ss);
    float rinv = rsqrtf(ss * (1.f / 1024.f) + 1e-6f);
#pragma unroll
    for (int i = 0; i < 4; ++i) {
      int col = i * 256 + lane * 4;
      f32x4 g4 = *(const f32x4*)(g + col), sh = *(const f32x4*)(md + col), sc = *(const f32x4*)(md + 1024 + col);
      f32x4 y;
#pragma unroll
      for (int j = 0; j < 4; ++j) y[j] = (v[i][j] * rinv * g4[j]) * (1.f + sc[j]) + sh[j];
      *(u32x2*)(p.ACT + (size_t)row * 1024 + col) = MK2(pack2(y[0], y[1]), pack2(y[2], y[3]));
    }
  }
}

__device__ void final_norm_phase(const Params& p, int bid, int nb) {
  const int wave = otid() >> 6, lane = otid() & 63;
  for (int row = bid * 4 + wave; row < NLAT; row += nb * 4) {
    float* src = p.out + (size_t)row * 1024;
    f32x4 v[4]; float ss = 0.f;
#pragma unroll
    for (int i = 0; i < 4; ++i) { v[i] = *(const f32x4*)(src + i * 256 + lane * 4); ss += v[i][0] * v[i][0] + v[i][1] * v[i][1] + v[i][2] * v[i][2] + v[i][3] * v[i][3]; }
    ss = wave_sum(ss);
    float rinv = rsqrtf(ss * (1.f / 1024.f) + 1e-6f);
#pragma unroll
    for (int i = 0; i < 4; ++i) {
      int col = i * 256 + lane * 4;
      f32x4 g4 = *(const f32x4*)(p.final_g + col);
      f32x4 y;
#pragma unroll
      for (int j = 0; j < 4; ++j) y[j] = v[i][j] * rinv * g4[j];
      *(f32x4*)(src + col) = y;
    }
  }
}

#define GSTR 72
template <class Epi>
__device__ __forceinline__ void gemm_tile(const bf16_t* __restrict__ A, int lda, const bf16_t* __restrict__ Bt, int ldb, int K, int m0, int n0,
                                          const Epi& epi, char* lds) {
  bf16_t* As = (bf16_t*)lds;
  bf16_t* Bs = As + 2 * 128 * GSTR;
  const int tid = otid(), wave = tid >> 6, lane = tid & 63, wm = wave >> 1, wn = wave & 1, lr = lane & 15, quad = lane >> 4;
  const int lrow = tid >> 3, lch = tid & 7;
  rsrc_t gar = mkbuf(A + (size_t)m0 * lda), gbr = mkbuf(Bt + (size_t)n0 * ldb);
  unsigned aoff[4], boff[4];
#pragma unroll
  for (int i = 0; i < 4; ++i) { aoff[i] = (unsigned)((lrow + 32 * i) * lda + lch * 8) * 2u; boff[i] = (unsigned)((lrow + 32 * i) * ldb + lch * 8) * 2u; }
  u32x4 ra[4], rb[4];
  f32x4 acc[4][4];
#pragma unroll
  for (int i = 0; i < 4; ++i)
#pragma unroll
    for (int j = 0; j < 4; ++j) acc[i][j] = (f32x4){0.f, 0.f, 0.f, 0.f};
#pragma unroll
  for (int i = 0; i < 4; ++i) { ra[i] = bload16(gar, aoff[i], 0); rb[i] = bload16(gbr, boff[i], 0); }
  __syncthreads();
#pragma unroll
  for (int i = 0; i < 4; ++i) { *(u32x4*)(As + (lrow + 32 * i) * GSTR + lch * 8) = ra[i]; *(u32x4*)(Bs + (lrow + 32 * i) * GSTR + lch * 8) = rb[i]; }
  __syncthreads();
  const int nk = K >> 6;
  for (int kt = 0; kt < nk; ++kt) {
    const int cur = kt & 1;
    if (kt + 1 < nk) {
      const unsigned so = (unsigned)(kt + 1) * 128u;
#pragma unroll
      for (int i = 0; i < 4; ++i) { ra[i] = bload16(gar, aoff[i], so); rb[i] = bload16(gbr, boff[i], so); }
    }
    const bf16_t* as = As + cur * 128 * GSTR + (wm * 64 + lr) * GSTR + quad * 8;
    const bf16_t* bs = Bs + cur * 128 * GSTR + (wn * 64 + lr) * GSTR + quad * 8;
#pragma unroll
    for (int ks = 0; ks < 2; ++ks) {
      bf16x8 af[4], bfr[4];
#pragma unroll
      for (int i = 0; i < 4; ++i) { af[i] = *(const bf16x8*)(as + i * 16 * GSTR + ks * 32); bfr[i] = *(const bf16x8*)(bs + i * 16 * GSTR + ks * 32); }
#pragma unroll
      for (int mi = 0; mi < 4; ++mi)
#pragma unroll
        for (int ni = 0; ni < 4; ++ni) acc[mi][ni] = mfma16(bfr[ni], af[mi], acc[mi][ni]);
    }
    if (kt + 1 < nk) {
      const int nx = cur ^ 1;
#pragma unroll
      for (int i = 0; i < 4; ++i) { *(u32x4*)(As + nx * 128 * GSTR + (lrow + 32 * i) * GSTR + lch * 8) = ra[i]; *(u32x4*)(Bs + nx * 128 * GSTR + (lrow + 32 * i) * GSTR + lch * 8) = rb[i]; }
    }
    __syncthreads();
  }
  epi(acc, m0 + wm * 64, n0 + wn * 64, lr, quad);
}

__device__ __forceinline__ void tile_coord(int t, int nN, int& pm, int& pn) {
  int gsz = 20 * nN; int g = t / gsz, r = t % gsz; pm = g * 20 + (r % 20); pn = r / 20;
}

struct EpiWin {
  bf16_t* P;
  __device__ __forceinline__ void operator()(f32x4 (&acc)[4][4], int mb, int nbs, int lr, int quad) const {
#pragma unroll
    for (int mi = 0; mi < 4; ++mi) {
      bf16_t* rp = P + (size_t)(mb + mi * 16 + lr) * PW + nbs + quad * 4;
#pragma unroll
      for (int ni = 0; ni < 4; ++ni) *(u32x2*)(rp + ni * 16) = MK2(pack2(acc[mi][ni][0], acc[mi][ni][1]), pack2(acc[mi][ni][2], acc[mi][ni][3]));
    }
  }
};

struct EpiResid {
  const Params* p; int l; int goff; int use_src;
  __device__ __forceinline__ void operator()(f32x4 (&acc)[4][4], int mb, int nbs, int lr, int quad) const {
#pragma unroll
    for (int mi = 0; mi < 4; ++mi) {
      int row = mb + mi * 16 + lr;
      const float* gate = p->mod + (size_t)(l * 3 + modv(row)) * 6144 + goff;
      const float* src = use_src ? xsrc(*p, l, row) : xrow(*p, row);
      float* dst = xrow(*p, row);
#pragma unroll
      for (int ni = 0; ni < 4; ++ni) {
        int col = nbs + ni * 16 + quad * 4;
        f32x4 g4 = *(const f32x4*)(gate + col), x4 = *(const f32x4*)(src + col);
#pragma unroll
        for (int j = 0; j < 4; ++j) x4[j] += g4[j] * acc[mi][ni][j];
        *(f32x4*)(dst + col) = x4;
      }
    }
  }
};

struct EpiFfn1 {
  bf16_t* U;
  __device__ __forceinline__ void operator()(f32x4 (&acc)[4][4], int mb, int nbs, int lr, int quad) const {
#pragma unroll
    for (int mi = 0; mi < 4; ++mi) {
      int row = mb + mi * 16 + lr;
#pragma unroll
      for (int pr = 0; pr < 2; ++pr) {
        int ucol = ((nbs + pr * 32) >> 5) * 16 + quad * 4;
        float u[4];
#pragma unroll
        for (int j = 0; j < 4; ++j) u[j] = silu_f(acc[mi][2 * pr][j]) * acc[mi][2 * pr + 1][j];
        *(u32x2*)(U + (size_t)row * 2816 + ucol) = MK2(pack2(u[0], u[1]), pack2(u[2], u[3]));
      }
    }
  }
};

struct EpiUq {
  const Params* p;
  __device__ __forceinline__ void operator()(f32x4 (&acc)[4][4], int mb, int nbs, int lr, int quad) const {
#pragma unroll
    for (int mi = 0; mi < 4; ++mi) {
      int row = mb + mi * 16 + lr;
      const bf16_t* cq = p->P + (size_t)row * PW + C_CQ + quad * 64;
      float ss = 0.f;
#pragma unroll
      for (int i = 0; i < 8; ++i) {
        u32x4 w = *(const u32x4*)(cq + i * 8);
        float a;
        a = lo_f(w.x); ss += a * a; a = hi_f(w.x); ss += a * a; a = lo_f(w.y); ss += a * a; a = hi_f(w.y); ss += a * a;
        a = lo_f(w.z); ss += a * a; a = hi_f(w.z); ss += a * a; a = lo_f(w.w); ss += a * a; a = hi_f(w.w); ss += a * a;
      }
      ss += __shfl_xor(ss, 16); ss += __shfl_xor(ss, 32);
      float rinv = rsqrtf(ss * (1.f / 256.f) + 1e-6f);
      bool latent = row < NLAT;
      int tok = row & 16383, prow = tok >> 6, pcol = tok & 63;
#pragma unroll
      for (int ni = 0; ni < 4; ++ni) {
        int col = nbs + ni * 16 + quad * 4;
        int sub = ((nbs >> 4) + ni) % 6;
        float v[4];
#pragma unroll
        for (int j = 0; j < 4; ++j) v[j] = acc[mi][ni][j] * rinv;
        if (sub >= 4) {
          float o[4];
#pragma unroll
          for (int j = 0; j < 4; ++j) o[j] = __shfl_xor(v[j], 32);
          if (latent) {
            int pos = sub == 4 ? prow : pcol;
#pragma unroll
            for (int j = 0; j < 4; ++j) {
              int i = (quad & 1) * 4 + j;
              float cs = p->rope32[(pos * 8 + i) * 2], sn = p->rope32[(pos * 8 + i) * 2 + 1];
              v[j] = quad < 2 ? v[j] * cs - o[j] * sn : v[j] * cs + o[j] * sn;
            }
          }
        }
        *(u32x2*)(p->Qm + (size_t)row * 384 + col) = MK2(pack2(v[0], v[1]), pack2(v[2], v[3]));
      }
    }
  }
};

__device__ __forceinline__ void mla_key_of_row(int row, int& b, int& key) {
  if (row < NLAT) { b = row >> 14; key = row & 16383; } else { b = (row - NLAT) >> 8; key = 16384 + ((row - NLAT) & 255); }
}

struct EpiUkv {
  const Params* p;
  __device__ __forceinline__ void operator()(f32x4 (&acc)[4][4], int mb, int nbs, int lr, int quad) const {
    int h = nbs >> 7, isv = (nbs >> 6) & 1;
#pragma unroll
    for (int mi = 0; mi < 4; ++mi) {
      int row = mb + mi * 16 + lr;
      const bf16_t* ck = p->P + (size_t)row * PW + C_CKV + quad * 32;
      float ss = 0.f;
#pragma unroll
      for (int i = 0; i < 4; ++i) {
        u32x4 w = *(const u32x4*)(ck + i * 8);
        float a;
        a = lo_f(w.x); ss += a * a; a = hi_f(w.x); ss += a * a; a = lo_f(w.y); ss += a * a; a = hi_f(w.y); ss += a * a;
        a = lo_f(w.z); ss += a * a; a = hi_f(w.z); ss += a * a; a = lo_f(w.w); ss += a * a; a = hi_f(w.w); ss += a * a;
      }
      ss += __shfl_xor(ss, 16); ss += __shfl_xor(ss, 32);
      float rinv = rsqrtf(ss * (1.f / 128.f) + 1e-6f);
      int b, key; mla_key_of_row(row, b, key);
      size_t kidx = (size_t)(b * 4 + h) * 16640 + key;
      bf16_t* dst = isv ? p->Vm + kidx * 64 : p->Km + kidx * 96;
#pragma unroll
      for (int ni = 0; ni < 4; ++ni) {
        f32x4 a = acc[mi][ni];
        *(u32x2*)(dst + ni * 16 + quad * 4) = MK2(pack2(a[0] * rinv, a[1] * rinv), pack2(a[2] * rinv, a[3] * rinv));
      }
    }
  }
};

__device__ __forceinline__ void rope64_pair_vals(const bf16_t* base, int pr, int prow, int pcol, const float* rope64, bool rotate, float (&o1)[8], float (&o2)[8], int& c0) {
  c0 = pr < 2 ? pr : pr + 2;
  int pos = pr < 2 ? prow : pcol, i0 = (pr & 1) * 8;
  u32x4 a = *(const u32x4*)(base + c0 * 8), b = *(const u32x4*)(base + (c0 + 2) * 8);
  unsigned aw[4] = {a.x, a.y, a.z, a.w}, bw[4] = {b.x, b.y, b.z, b.w};
#pragma unroll
  for (int e = 0; e < 8; ++e) {
    float x1 = (e & 1) ? hi_f(aw[e >> 1]) : lo_f(aw[e >> 1]);
    float x2 = (e & 1) ? hi_f(bw[e >> 1]) : lo_f(bw[e >> 1]);
    if (rotate) {
      float cs = rope64[(pos * 16 + i0 + e) * 2], sn = rope64[(pos * 16 + i0 + e) * 2 + 1];
      o1[e] = x1 * cs - x2 * sn; o2[e] = x2 * cs + x1 * sn;
    } else { o1[e] = x1; o2[e] = x2; }
  }
}
__device__ __forceinline__ u32x4 pack8(const float (&o)[8]) { return MK4(pack2(o[0], o[1]), pack2(o[2], o[3]), pack2(o[4], o[5]), pack2(o[6], o[7])); }

#define VSTR 80
__device__ void ret_prep_item(const Params& p, int l, int c, int h, char* lds) {
  bf16_t* vL = (bf16_t*)lds;
  bf16_t* kfL = vL + 128 * VSTR;
  bf16_t* kbL = kfL + 128 * VSTR;
  const int tid = otid(), wave = tid >> 6, lane = tid & 63, lr = lane & 15, quad = lane >> 4;
  const bool latent = c < 256;
  const int r0 = c * 128;
  float df = p.ret_decay[l * 8 + h], db = p.ret_decay[l * 8 + 4 + h];
  float lgf = -log1pf(__expf(-df)) * LOG2E, lgb = -log1pf(__expf(-db)) * LOG2E;
  __syncthreads();
#pragma unroll
  for (int i = 0; i < 2; ++i) {
    int idx = tid + 256 * i, r = idx >> 2, pr = idx & 3;
    int row = r0 + r, tok = row & 16383, prow = tok >> 6, pcol = tok & 63;
    bf16_t* kb = p.P + (size_t)row * PW + C_RK + h * 64;
    float o1[8], o2[8]; int c0;
    rope64_pair_vals(kb, pr, prow, pcol, p.rope64, latent, o1, o2, c0);
    if (latent) { *(u32x4*)(kb + c0 * 8) = pack8(o1); *(u32x4*)(kb + (c0 + 2) * 8) = pack8(o2); }
    float wf = exp2f(lgf * (float)(127 - r)) * 0.125f, wb = exp2f(lgb * (float)r) * 0.125f;
    float t1[8], t2[8];
#pragma unroll
    for (int e = 0; e < 8; ++e) { t1[e] = o1[e] * wf; t2[e] = o2[e] * wf; }
    *(u32x4*)(kfL + r * VSTR + c0 * 8) = pack8(t1); *(u32x4*)(kfL + r * VSTR + (c0 + 2) * 8) = pack8(t2);
#pragma unroll
    for (int e = 0; e < 8; ++e) { t1[e] = o1[e] * wb; t2[e] = o2[e] * wb; }
    *(u32x4*)(kbL + r * VSTR + c0 * 8) = pack8(t1); *(u32x4*)(kbL + r * VSTR + (c0 + 2) * 8) = pack8(t2);
    if (latent) {
      bf16_t* qb = p.P + (size_t)row * PW + C_RQ + h * 64;
      rope64_pair_vals(qb, pr, prow, pcol, p.rope64, true, o1, o2, c0);
      *(u32x4*)(qb + c0 * 8) = pack8(o1); *(u32x4*)(qb + (c0 + 2) * 8) = pack8(o2);
    }
  }
#pragma unroll
  for (int i = 0; i < 4; ++i) {
    int idx = tid + 256 * i, r = idx >> 3, ch = idx & 7;
    *(u32x4*)(vL + r * VSTR + ch * 8) = *(const u32x4*)(p.P + (size_t)(r0 + r) * PW + C_RV + h * 64 + ch * 8);
  }
  __syncthreads();
  f32x4 acc[2][4];
#pragma unroll
  for (int d = 0; d < 2; ++d)
#pragma unroll
    for (int j = 0; j < 4; ++j) acc[d][j] = (f32x4){0.f, 0.f, 0.f, 0.f};
  const int roff = (quad * 4 + (lr >> 2)) * VSTR + (lr & 3) * 4;
#pragma unroll
  for (int ks = 0; ks < 4; ++ks) {
    bf16x8 af = cat8(tr_read(vL + ks * 32 * VSTR + roff + wave * 16), tr_read(vL + (ks * 32 + 16) * VSTR + roff + wave * 16));
#pragma unroll
    for (int dt = 0; dt < 4; ++dt) {
      bf16x8 b0 = cat8(tr_read(kfL + ks * 32 * VSTR + roff + dt * 16), tr_read(kfL + (ks * 32 + 16) * VSTR + roff + dt * 16));
      acc[0][dt] = mfma16(af, b0, acc[0][dt]);
      bf16x8 b1 = cat8(tr_read(kbL + ks * 32 * VSTR + roff + dt * 16), tr_read(kbL + (ks * 32 + 16) * VSTR + roff + dt * 16));
      acc[1][dt] = mfma16(af, b1, acc[1][dt]);
    }
  }
#pragma unroll
  for (int dir = 0; dir < 2; ++dir) {
    float* ks = p.Ksum + ((size_t)(dir * 260 + c) * 4 + h) * 4096;
#pragma unroll
    for (int dt = 0; dt < 4; ++dt)
#pragma unroll
      for (int j = 0; j < 4; ++j) ks[(wave * 16 + quad * 4 + j) * 64 + dt * 16 + lr] = acc[dir][dt][j];
  }
}

__device__ void swa_rope_item(const Params& p, int mt) {
  const int tid = otid();
  for (int idx = tid; idx < 128 * 24; idx += 256) {
    int r = idx / 24, pp = idx % 24;
    int row = mt * 128 + r, tok = row & 16383, prow = tok >> 6, pcol = tok & 63;
    int hd = pp >> 2, pr = pp & 3;
    bf16_t* base = p.P + (size_t)row * PW + (hd < 4 ? C_SQ + hd * 64 : C_SK + (hd - 4) * 64);
    float o1[8], o2[8]; int c0;
    rope64_pair_vals(base, pr, prow, pcol, p.rope64, true, o1, o2, c0);
    *(u32x4*)(base + c0 * 8) = pack8(o1); *(u32x4*)(base + (c0 + 2) * 8) = pack8(o2);
  }
}

__device__ void mla_krope_item(const Params& p, int m0, int h) {
  const int tid = otid();
  int row = m0 + (tid >> 1), part = tid & 1;
  bool latent = row < NLAT;
  int tok = row & 16383, pos = part == 0 ? (tok >> 6) : (tok & 63);
  const bf16_t* src = p.P + (size_t)row * PW + C_KR + part * 16;
  u32x4 a = *(const u32x4*)src, b = *(const u32x4*)(src + 8);
  unsigned aw[4] = {a.x, a.y, a.z, a.w}, bw[4] = {b.x, b.y, b.z, b.w};
  float o1[8], o2[8];
#pragma unroll
  for (int e = 0; e < 8; ++e) {
    float x1 = (e & 1) ? hi_f(aw[e >> 1]) : lo_f(aw[e >> 1]);
    float x2 = (e & 1) ? hi_f(bw[e >> 1]) : lo_f(bw[e >> 1]);
    if (latent) {
      float cs = p.rope32[(pos * 8 + e) * 2], sn = p.rope32[(pos * 8 + e) * 2 + 1];
      o1[e] = x1 * cs - x2 * sn; o2[e] = x2 * cs + x1 * sn;
    } else { o1[e] = x1; o2[e] = x2; }
  }
  int b_, key; mla_key_of_row(row, b_, key);
  bf16_t* dst = p.Km + ((size_t)(b_ * 4 + h) * 16640 + key) * 96 + 64 + part * 16;
  *(u32x4*)dst = pack8(o1); *(u32x4*)(dst + 8) = pack8(o2);
}

struct KVT { const bf16_t* k; const bf16_t* v; };

template <int DQK, bool SOFTMAX, class TileFn, class MaskFn>
__device__ __forceinline__ void attn_core(const bf16x8 (&qf)[2][DQK / 32], int ntiles, const TileFn& tf, int ldk, int ldv, const MaskFn& mk,
                                          f32x4 (&o)[4][2], float (&m)[2], float (&l)[2], char* lds) {
  constexpr int KSTR = DQK + 8, NKS = DQK / 32, KCH = DQK / 8, NKL = (64 * KCH) / 256;
  bf16_t* Kl = (bf16_t*)lds;
  bf16_t* Vl = Kl + 2 * 64 * KSTR;
  const int tid = otid(), wave = tid >> 6, lane = tid & 63, lr = lane & 15, quad = lane >> 4;
  u32x4 rk[NKL], rv[2];
  unsigned koff[NKL], voff[2];
#pragma unroll
  for (int i = 0; i < NKL; ++i) { int c = tid + i * 256, r = c / KCH, ch = c % KCH; koff[i] = (unsigned)(r * ldk + ch * 8) * 2u; }
#pragma unroll
  for (int i = 0; i < 2; ++i) { int c = tid + i * 256, r = c >> 3, ch = c & 7; voff[i] = (unsigned)(r * ldv + ch * 8) * 2u; }
  __syncthreads();
  {
    KVT kv = tf(0);
    rsrc_t kr = mkbuf(kv.k), vr = mkbuf(kv.v);
#pragma unroll
    for (int i = 0; i < NKL; ++i) rk[i] = bload16(kr, koff[i], 0);
#pragma unroll
    for (int i = 0; i < 2; ++i) rv[i] = bload16(vr, voff[i], 0);
#pragma unroll
    for (int i = 0; i < NKL; ++i) { int c = tid + i * 256, r = c / KCH, ch = c % KCH; *(u32x4*)(Kl + r * KSTR + ch * 8) = rk[i]; }
#pragma unroll
    for (int i = 0; i < 2; ++i) { int c = tid + i * 256, r = c >> 3, ch = c & 7; *(u32x4*)(Vl + r * VSTR + ch * 8) = rv[i]; }
  }
  __syncthreads();
  for (int t = 0; t < ntiles; ++t) {
    const int cur = t & 1;
    if (t + 1 < ntiles) {
      KVT kv = tf(t + 1);
      rsrc_t kr = mkbuf(kv.k), vr = mkbuf(kv.v);
#pragma unroll
      for (int i = 0; i < NKL; ++i) rk[i] = bload16(kr, koff[i], 0);
#pragma unroll
      for (int i = 0; i < 2; ++i) rv[i] = bload16(vr, voff[i], 0);
    }
    f32x4 s[4][2];
#pragma unroll
    for (int kt = 0; kt < 4; ++kt) { s[kt][0] = (f32x4){0.f, 0.f, 0.f, 0.f}; s[kt][1] = (f32x4){0.f, 0.f, 0.f, 0.f}; }
    const bf16_t* kb = Kl + cur * 64 * KSTR + lr * KSTR + quad * 8;
#pragma unroll
    for (int ks = 0; ks < NKS; ++ks)
#pragma unroll
      for (int kt = 0; kt < 4; ++kt) {
        bf16x8 kf = *(const bf16x8*)(kb + kt * 16 * KSTR + ks * 32);
        s[kt][0] = mfma16(kf, qf[0][ks], s[kt][0]);
        s[kt][1] = mfma16(kf, qf[1][ks], s[kt][1]);
        if (kt == 3) __builtin_amdgcn_sched_barrier(0);
      }
    __builtin_amdgcn_sched_barrier(0);
#pragma unroll
    for (int kt = 0; kt < 4; ++kt)
#pragma unroll
      for (int qt = 0; qt < 2; ++qt)
#pragma unroll
        for (int j = 0; j < 4; ++j) { s[kt][qt][j] = mk(t, wave * 32 + qt * 16 + lr, kt * 16 + quad * 4 + j, s[kt][qt][j]); if (j == 3) __builtin_amdgcn_sched_barrier(0); }
    if (SOFTMAX) {
#pragma unroll
      for (int qt = 0; qt < 2; ++qt) {
        float mx = s[0][qt][0];
#pragma unroll
        for (int kt = 0; kt < 4; ++kt)
#pragma unroll
          for (int j = 0; j < 4; ++j) mx = fmaxf(mx, s[kt][qt][j]);
        mx = fmaxf(mx, __shfl_xor(mx, 16)); mx = fmaxf(mx, __shfl_xor(mx, 32));
        float mnew = fmaxf(m[qt], mx);
        float alpha = exp2f(m[qt] - mnew);
        m[qt] = mnew;
        float ls = 0.f;
#pragma unroll
        for (int kt = 0; kt < 4; ++kt)
#pragma unroll
          for (int j = 0; j < 4; ++j) { float pv = exp2f(s[kt][qt][j] - mnew); s[kt][qt][j] = pv; ls += pv; if (j == 3) __builtin_amdgcn_sched_barrier(0); }
        l[qt] = l[qt] * alpha + ls;
#pragma unroll
        for (int dt = 0; dt < 4; ++dt)
#pragma unroll
          for (int j = 0; j < 4; ++j) o[dt][qt][j] *= alpha;
      }
    }
    __builtin_amdgcn_sched_barrier(0);
    bf16x8 pf[2][2];
#pragma unroll
    for (int qt = 0; qt < 2; ++qt)
#pragma unroll
      for (int kk = 0; kk < 2; ++kk) {
        unsigned w0 = pack2(s[2 * kk][qt][0], s[2 * kk][qt][1]), w1 = pack2(s[2 * kk][qt][2], s[2 * kk][qt][3]);
        unsigned w2 = pack2(s[2 * kk + 1][qt][0], s[2 * kk + 1][qt][1]), w3 = pack2(s[2 * kk + 1][qt][2], s[2 * kk + 1][qt][3]);
        u32x4 u = MK4(w0, w1, w2, w3);
        pf[qt][kk] = __builtin_bit_cast(bf16x8, u);
      }
    __builtin_amdgcn_sched_barrier(0);
    const bf16_t* vb = Vl + cur * 64 * VSTR + (quad * 4 + (lr >> 2)) * VSTR + (lr & 3) * 4;
#pragma unroll
    for (int kk = 0; kk < 2; ++kk)
#pragma unroll
      for (int dt = 0; dt < 4; ++dt) {
        bf16x8 vf = cat8(tr_read(vb + (kk * 32) * VSTR + dt * 16), tr_read(vb + (kk * 32 + 16) * VSTR + dt * 16));
        o[dt][0] = mfma16(vf, pf[0][kk], o[dt][0]);
        o[dt][1] = mfma16(vf, pf[1][kk], o[dt][1]);
        if (dt & 1) __builtin_amdgcn_sched_barrier(0);
      }
    if (t + 1 < ntiles) {
      const int nx = cur ^ 1;
#pragma unroll
      for (int i = 0; i < NKL; ++i) { int c = tid + i * 256, r = c / KCH, ch = c % KCH; *(u32x4*)(Kl + nx * 64 * KSTR + r * KSTR + ch * 8) = rk[i]; }
#pragma unroll
      for (int i = 0; i < 2; ++i) { int c = tid + i * 256, r = c >> 3, ch = c & 7; *(u32x4*)(Vl + nx * 64 * VSTR + r * VSTR + ch * 8) = rv[i]; }
    }
    __syncthreads();
  }
}

__device__ __forceinline__ void attn_store(f32x4 (&o)[4][2], float (&m)[2], float (&l)[2], bool has_sink, float sink_l2, bf16_t* dst  , int ldo) {
  const int lane = otid() & 63, wave = otid() >> 6, lr = lane & 15, quad = lane >> 4;
#pragma unroll
  for (int qt = 0; qt < 2; ++qt) {
    float lt = l[qt]; lt += __shfl_xor(lt, 16); lt += __shfl_xor(lt, 32);
    if (has_sink) lt += exp2f(sink_l2 - m[qt]);
    float inv = 1.f / lt;
    bf16_t* rp = dst + (size_t)(wave * 32 + qt * 16 + lr) * ldo + quad * 4;
#pragma unroll
    for (int dt = 0; dt < 4; ++dt)
      *(u32x2*)(rp + dt * 16) = MK2(pack2(o[dt][qt][0] * inv, o[dt][qt][1] * inv), pack2(o[dt][qt][2] * inv, o[dt][qt][3] * inv));
  }
}

template <int NKS>
__device__ __forceinline__ void load_q(bf16x8 (&qf)[2][NKS], const bf16_t* q  , int ldq) {
  const int lane = otid() & 63, wave = otid() >> 6, lr = lane & 15, quad = lane >> 4;
#pragma unroll
  for (int qt = 0; qt < 2; ++qt)
#pragma unroll
    for (int ks = 0; ks < NKS; ++ks) qf[qt][ks] = *(const bf16x8*)(q + (size_t)(wave * 32 + qt * 16 + lr) * ldq + ks * 32 + quad * 8);
}

struct TileContig { const bf16_t* k; const bf16_t* v; size_t ks, vs;
  __device__ __forceinline__ KVT operator()(int t) const { return KVT{k + (size_t)t * ks, v + (size_t)t * vs}; } };
struct MaskScale { float sl2; __device__ __forceinline__ float operator()(int, int, int, float s) const { return s * sl2; } };

__device__ void mla_item(const Params& p, int b, int h, int qt128, bool ctxq, char* lds) {
  int r0 = ctxq ? NLAT + b * 256 + qt128 * 128 : b * 16384 + qt128 * 128;
  bf16x8 qf[2][3];
  load_q<3>(qf, p.Qm + (size_t)r0 * 384 + h * 96, 384);
  f32x4 o[4][2]; float m[2] = {-1e30f, -1e30f}, l[2] = {0.f, 0.f};
#pragma unroll
  for (int dt = 0; dt < 4; ++dt) { o[dt][0] = (f32x4){0.f, 0.f, 0.f, 0.f}; o[dt][1] = (f32x4){0.f, 0.f, 0.f, 0.f}; }
  int t0 = ctxq ? 256 : 0, nt = ctxq ? 4 : 260;
  size_t kbase = (size_t)(b * 4 + h) * 16640 + (size_t)t0 * 64;
  TileContig tf{p.Km + kbase * 96, p.Vm + kbase * 64, (size_t)64 * 96, (size_t)64 * 64};
  MaskScale mk{0.10206207261596575f * LOG2E};
  attn_core<96, true>(qf, nt, tf, 96, 64, mk, o, m, l, lds);
  attn_store(o, m, l, false, 0.f, p.ACT + (size_t)r0 * 1024 + h * 64, 1024);
}

struct NaTiles { const bf16_t* P; int b, h, lo, nw;
  __device__ __forceinline__ KVT operator()(int t) const {
    size_t row = t < nw ? (size_t)b * 16384 + (size_t)(lo + t) * 64 : (size_t)NLAT + b * 256 + (size_t)(t - nw) * 64;
    return KVT{P + row * PW + C_NK + h * 64, P + row * PW + C_NV + h * 64}; } };
struct NaMask { const float* rpb; int nw, lo, qr0; float sl2;
  __device__ __forceinline__ float operator()(int t, int qi, int kj, float s) const {
    if (t >= nw) return s * sl2;
    int qr = qr0 + (qi >> 6), qc = qi & 63, kr = lo + t;
    int r0q = min(max(qr - 4, 0), 248), c0 = min(max(qc - 8, 0), 48);
    bool ok = (kr >= r0q) & (kr < r0q + 8) & (kj >= c0) & (kj < c0 + 16);
    int dr = min(max(kr - qr + 7, 0), 14), dc = min(max(kj - qc, -15), 15) + 15;
    float bias = rpb[dr * 31 + dc];
    return ok ? s * sl2 + bias * LOG2E : -INFINITY; } };

__device__ void na_item(const Params& p, int l, int b, int h, int pair, char* lds) {
  float* rpbL = (float*)(lds + 60000);
  __syncthreads();
  for (int i = otid(); i < 465; i += 256) rpbL[i] = p.na_rpb[(size_t)(l * 4 + h) * 465 + i];
  int r0 = b * 16384 + pair * 128;
  bf16x8 qf[2][2];
  load_q<2>(qf, p.P + (size_t)r0 * PW + C_NQ + h * 64, PW);
  f32x4 o[4][2]; float m[2] = {-1e30f, -1e30f}, ls[2] = {0.f, 0.f};
#pragma unroll
  for (int dt = 0; dt < 4; ++dt) { o[dt][0] = (f32x4){0.f, 0.f, 0.f, 0.f}; o[dt][1] = (f32x4){0.f, 0.f, 0.f, 0.f}; }
  int qr0 = pair * 2;
  int lo = min(max(qr0 - 4, 0), 248), hi = min(max(qr0 + 1 - 4, 0), 248) + 7;
  int nw = hi - lo + 1;
  NaTiles tf{p.P, b, h, lo, nw};
  NaMask mk{rpbL, nw, lo, qr0, 0.125f * LOG2E};
  attn_core<64, true>(qf, nw + 4, tf, PW, PW, mk, o, m, ls, lds);
  attn_store(o, m, ls, false, 0.f, p.ACT + (size_t)r0 * 1024 + 512 + h * 64, 1024);
}

struct SwaTiles { const bf16_t* P; int b, kvh, nlo, nwt;
  __device__ __forceinline__ KVT operator()(int t) const {
    size_t row = t < nwt ? (size_t)b * 16384 + (size_t)(nlo * 128 + t * 64) : (size_t)NLAT + b * 256 + (size_t)(t - nwt) * 64;
    return KVT{P + row * PW + C_SK + kvh * 64, P + row * PW + C_SV + kvh * 64}; } };
struct SwaMask { int nwt, koff  ; float sl2;
  __device__ __forceinline__ float operator()(int t, int qi, int kj, float s) const {
    if (t >= nwt) return s * sl2;
    int delta = koff + t * 64 + kj - qi;
    return (delta <= 128 && delta >= -128) ? s * sl2 : -INFINITY; } };

__device__ void swa_item(const Params& p, int l, int b, int hq, int n, bool ctxq, char* lds) {
  int r0 = ctxq ? NLAT + b * 256 + n * 128 : b * 16384 + n * 128;
  bf16x8 qf[2][2];
  load_q<2>(qf, p.P + (size_t)r0 * PW + C_SQ + hq * 64, PW);
  f32x4 o[4][2]; float m[2] = {-1e30f, -1e30f}, ls[2] = {0.f, 0.f};
#pragma unroll
  for (int dt = 0; dt < 4; ++dt) { o[dt][0] = (f32x4){0.f, 0.f, 0.f, 0.f}; o[dt][1] = (f32x4){0.f, 0.f, 0.f, 0.f}; }
  int nlo = 0, nwt = 0;
  if (!ctxq) { nlo = max(n - 1, 0); int nhi = min(n + 1, 127); nwt = (nhi - nlo + 1) * 2; }
  SwaTiles tf{p.P, b, hq >> 1, nlo, nwt};
  SwaMask mk{nwt, (nlo - n) * 128, 0.125f * LOG2E};
  attn_core<64, true>(qf, nwt + 4, tf, PW, PW, mk, o, m, ls, lds);
  float sink = p.swa_sink[l * 4 + hq] * LOG2E;
  attn_store(o, m, ls, true, sink, p.ACT + (size_t)r0 * 1024 + 768 + hq * 64, 1024);
}

__device__ void na_ctx_item(const Params& p, int b, int h, int n, char* lds) {
  int r0 = NLAT + b * 256 + n * 128;
  bf16x8 qf[2][2];
  load_q<2>(qf, p.P + (size_t)r0 * PW + C_NQ + h * 64, PW);
  f32x4 o[4][2]; float m[2] = {-1e30f, -1e30f}, ls[2] = {0.f, 0.f};
#pragma unroll
  for (int dt = 0; dt < 4; ++dt) { o[dt][0] = (f32x4){0.f, 0.f, 0.f, 0.f}; o[dt][1] = (f32x4){0.f, 0.f, 0.f, 0.f}; }
  NaTiles tf{p.P, b, h, 0, 0};
  MaskScale mk{0.125f * LOG2E};
  attn_core<64, true>(qf, 4, tf, PW, PW, mk, o, m, ls, lds);
  attn_store(o, m, ls, false, 0.f, p.ACT + (size_t)r0 * 1024 + 512 + h * 64, 1024);
}

__device__ void ret_scan_item(const Params& p, int l, int combo, int part) {
  int dir = combo >> 3, b = (combo >> 2) & 1, h = combo & 3;
  float d = p.ret_decay[l * 8 + dir * 4 + h];
  float lg = -log1pf(__expf(-d)) * LOG2E;
  float gC = exp2f(lg * 128.f);
  int idx = part * 1024 + otid() * 4;
  f32x4 S = (f32x4){0.f, 0.f, 0.f, 0.f};
#pragma unroll 4
  for (int step = 0; step < 130; ++step) {
    int chunk;
    if (dir == 0) chunk = step < 2 ? 256 + 2 * b + step : b * 128 + (step - 2);
    else chunk = step < 2 ? 256 + 2 * b + 1 - step : b * 128 + 127 - (step - 2);
    size_t off = ((size_t)(dir * 260 + chunk) * 4 + h) * 4096 + idx;
    *(u32x2*)(p.St + off) = MK2(pack2(S[0], S[1]), pack2(S[2], S[3]));
    f32x4 kv = *(const f32x4*)(p.Ksum + off);
#pragma unroll
    for (int j = 0; j < 4; ++j) S[j] = S[j] * gC + kv[j];
  }
}

struct RetMask { float lg; int dir;
  __device__ __forceinline__ float operator()(int t, int qi, int kj, float s) const {
    int j = t * 64 + kj; int df = dir == 0 ? qi - j : j - qi;
    return df >= 0 ? s * 0.125f * exp2f(lg * (float)df) : 0.f; } };

__device__ void ret_out_item(const Params& p, int l, int c, int h, char* lds) {
  const int lane = otid() & 63, wave = otid() >> 6, lr = lane & 15, quad = lane >> 4;
  int r0 = c * 128;
  bf16x8 qf[2][2];
  load_q<2>(qf, p.P + (size_t)r0 * PW + C_RQ + h * 64, PW);
  f32x4 res[4][2];
#pragma unroll
  for (int dt = 0; dt < 4; ++dt) { res[dt][0] = (f32x4){0.f, 0.f, 0.f, 0.f}; res[dt][1] = (f32x4){0.f, 0.f, 0.f, 0.f}; }
  TileContig tf{p.P + (size_t)r0 * PW + C_RK + h * 64, p.P + (size_t)r0 * PW + C_RV + h * 64, (size_t)64 * PW, (size_t)64 * PW};
#pragma unroll 1
  for (int dir = 0; dir < 2; ++dir) {
    float d = p.ret_decay[l * 8 + dir * 4 + h];
    float lg = -log1pf(__expf(-d)) * LOG2E;
    f32x4 o[4][2]; float m[2] = {0.f, 0.f}, ls[2] = {0.f, 0.f};
#pragma unroll
    for (int dt = 0; dt < 4; ++dt) { o[dt][0] = (f32x4){0.f, 0.f, 0.f, 0.f}; o[dt][1] = (f32x4){0.f, 0.f, 0.f, 0.f}; }
    rsrc_t str = mkbuf(p.St + ((size_t)(dir * 260 + c) * 4 + h) * 4096);
#pragma unroll
    for (int ks = 0; ks < 2; ++ks)
#pragma unroll
      for (int et = 0; et < 4; ++et) {
        bf16x8 af = __builtin_bit_cast(bf16x8, bload16(str, (unsigned)(lr * 64 + quad * 8) * 2u, (unsigned)(et * 16 * 64 + ks * 32) * 2u));
        o[et][0] = mfma16(af, qf[0][ks], o[et][0]);
        o[et][1] = mfma16(af, qf[1][ks], o[et][1]);
      }
#pragma unroll
    for (int qt = 0; qt < 2; ++qt) {
      int i = wave * 32 + qt * 16 + lr;
      float qdec = exp2f(lg * (float)(dir == 0 ? i + 1 : 128 - i));
#pragma unroll
      for (int et = 0; et < 4; ++et)
#pragma unroll
        for (int j = 0; j < 4; ++j) o[et][qt][j] *= qdec;
    }
    __builtin_amdgcn_sched_barrier(0);
    RetMask mk{lg, dir};
    attn_core<64, false>(qf, 2, tf, PW, PW, mk, o, m, ls, lds);
    __builtin_amdgcn_sched_barrier(0);
#pragma unroll
    for (int qt = 0; qt < 2; ++qt) {
      int i = wave * 32 + qt * 16 + lr;
      float ss = 0.f;
#pragma unroll
      for (int et = 0; et < 4; ++et)
#pragma unroll
        for (int j = 0; j < 4; ++j) { float v = o[et][qt][j]; ss += v * v; }
      ss += __shfl_xor(ss, 16); ss += __shfl_xor(ss, 32);
      float rinv = rsqrtf(ss * (1.f / 64.f) + 1e-6f);
      rsrc_t gpr = mkbuf(p.P + (size_t)r0 * PW + (dir == 0 ? C_RGF : C_RGB) + h * 64);
      unsigned goff = (unsigned)(i * PW + quad * 4) * 2u;
#pragma unroll
      for (int et = 0; et < 4; ++et) {
        u32x2 gw = bload8(gpr, goff, et * 32);
        float g0 = lo_f(gw.x), g1 = hi_f(gw.x), g2 = lo_f(gw.y), g3 = hi_f(gw.y);
        res[et][qt][0] += o[et][qt][0] * rinv * silu_f(g0);
        res[et][qt][1] += o[et][qt][1] * rinv * silu_f(g1);
        res[et][qt][2] += o[et][qt][2] * rinv * silu_f(g2);
        res[et][qt][3] += o[et][qt][3] * rinv * silu_f(g3);
      }
    }
  }
#pragma unroll
  for (int qt = 0; qt < 2; ++qt) {
    bf16_t* rp = p.ACT + (size_t)(r0 + wave * 32 + qt * 16 + lr) * 1024 + 256 + h * 64 + quad * 4;
#pragma unroll
    for (int et = 0; et < 4; ++et)
      *(u32x2*)(rp + et * 16) = MK2(pack2(res[et][qt][0], res[et][qt][1]), pack2(res[et][qt][2], res[et][qt][3]));
  }
}

__device__ void run_phase(const Params& p, int ph, int bid, int nb, char* lds) {
#ifndef CM
#define CM 0xff
#endif
#ifndef PH_MASK
#define PH_MASK 0xfffff
#endif
  if (ph == 0) { if (PH_MASK & (1<<9)) prologue_phase(p, bid, nb, lds); return; }
  if (ph == 37) { if (PH_MASK & (1<<10)) final_norm_phase(p, bid, nb); return; }
  const int l = (ph - 1) / 9, sp = (ph - 1) % 9;
  const bf16_t* W = p.W + (size_t)l * W_LAYER;
  if (!((PH_MASK >> sp) & 1)) return;
  switch (sp) {
    case 0: norm_phase(p, l, 0, bid, nb); break;
    case 1: {
      EpiWin epi{p.P};
      for (int t = bid; t < 260 * 24; t += nb) { int pm, pn; tile_coord(t, 24, pm, pn); gemm_tile(p.ACT, 1024, W + WO_IN, 1024, 1024, pm * 128, pn * 128, epi, lds); }
    } break;
    case 2: {
      EpiUq eq{&p}; EpiUkv ekv{&p};
      const int n0 = 260 * 4, n1 = n0 + 260 * 4, n2 = n1 + 260 * 3, n3 = n2 + 256;
      for (int t = bid; t < n3; t += nb) {
        if (t < n0) ret_prep_item(p, l, t >> 2, t & 3, lds);
        else if (t < n1) { int u = t - n0, pm = u >> 2, h = u & 3; gemm_tile(p.P + C_CKV, PW, W + WO_UKV, 128, 128, pm * 128, h * 128, ekv, lds); mla_krope_item(p, pm * 128, h); }
        else if (t < n2) { int u = t - n1, pm = u / 3, pn = u % 3; gemm_tile(p.P + C_CQ, PW, W + WO_UQ, 256, 256, pm * 128, pn * 128, eq, lds); }
        else swa_rope_item(p, t - n2);
      }
    } break;
    case 3: {
      const int n0 = 1024, n1 = n0 + 64, n2 = n1 + 16, n3 = n2 + 1024, n4 = n3 + 16, n5 = n4 + 1024, n6 = n5 + 16;
      for (int t = bid; t < n6; t += nb) {
        if (t < n0) { int b = t >> 9, h = (t >> 7) & 3, q = t & 127; if (CM & 1) mla_item(p, b, h, q, false, lds); }
        else if (t < n1) { int u = t - n0; if (CM & 2) ret_scan_item(p, l, u >> 2, u & 3); }
        else if (t < n2) { int u = t - n1; if (CM & 1) mla_item(p, u >> 3, (u >> 1) & 3, u & 1, true, lds); }
        else if (t < n3) { int u = t - n2; if (CM & 4) na_item(p, l, u >> 9, (u >> 7) & 3, u & 127, lds); }
        else if (t < n4) { int u = t - n3; if (CM & 8) na_ctx_item(p, u >> 3, (u >> 1) & 3, u & 1, lds); }
        else if (t < n5) { int u = t - n4; if (CM & 16) swa_item(p, l, u >> 9, (u >> 7) & 3, u & 127, false, lds); }
        else { int u = t - n5; if (CM & 16) swa_item(p, l, u >> 3, (u >> 1) & 3, u & 1, true, lds); }
      }
    } break;
    case 4: for (int t = bid; t < 260 * 4; t += nb) ret_out_item(p, l, t >> 2, t & 3, lds); break;
    case 5: {
      EpiResid epi{&p, l, 2048, 1};
      for (int t = bid; t < 260 * 8; t += nb) { int pm, pn; tile_coord(t, 8, pm, pn); gemm_tile(p.ACT, 1024, W + WO_OUT, 1024, 1024, pm * 128, pn * 128, epi, lds); }
    } break;
    case 6: norm_phase(p, l, 1, bid, nb); break;
    case 7: {
      EpiFfn1 epi{p.P};
      for (int t = bid; t < 260 * 44; t += nb) { int pm, pn; tile_coord(t, 44, pm, pn); gemm_tile(p.ACT, 1024, W + WO_13, 1024, 1024, pm * 128, pn * 128, epi, lds); }
    } break;
    case 8: {
      EpiResid epi{&p, l, 5120, 0};
      for (int t = bid; t < 260 * 8; t += nb) { int pm, pn; tile_coord(t, 8, pm, pn); gemm_tile(p.P, 2816, W + WO_2, 2816, 2816, pm * 128, pn * 128, epi, lds); }
    } break;
  }
}

__global__ void __launch_bounds__(256, 2) mega_kernel(Params p, int ph_lo, int ph_hi) {
  __shared__ __attribute__((aligned(16))) char lds[LDS_BYTES];
  for (int ph = ph_lo; ph < ph_hi; ++ph) {
    run_phase(p, ph, blockIdx.x, gridDim.x, lds);
    if (ph + 1 < ph_hi) cg::this_grid().sync();
  }
}

extern "C" void kernel_launch(void* const* d_in, const int* in_sizes, int n_in, void* d_out, int out_size, void* d_ws, size_t ws_size,
                              hipStream_t stream) {
  Params p{};
  const float** f = (const float**)&p;
  for (int i = 0; i < 21; ++i) f[i] = (const float*)d_in[i];
  p.out = (float*)d_out;
  char* w = (char*)d_ws; size_t off = 0;
  auto take = [&](size_t bytes) { char* r = w + off; off += (bytes + 255) & ~(size_t)255; return r; };
  p.Y = (float*)take((size_t)512 * 1024 * 4);
  p.ACT = (bf16_t*)take((size_t)NROWS * 1024 * 2);
  p.P = (bf16_t*)take((size_t)NROWS * PW * 2);
  p.Qm = (bf16_t*)take((size_t)NROWS * 384 * 2);
  p.Km = (bf16_t*)take((size_t)8 * 16640 * 96 * 2);
  p.Vm = (bf16_t*)take((size_t)8 * 16640 * 64 * 2);
  p.Ksum = (float*)take((size_t)2 * 260 * 4 * 4096 * 4);
  p.St = (bf16_t*)take((size_t)2 * 260 * 4 * 4096 * 2);
  p.W = (bf16_t*)take((size_t)4 * W_LAYER * 2);
  p.mod = (float*)take((size_t)4 * 3 * 6144 * 4);
  p.rope64 = (float*)take(256 * 16 * 2 * 4);
  p.rope32 = (float*)take(256 * 8 * 2 * 4);
  if (off > ws_size) { fprintf(stderr, "workspace too small: need %zu have %zu\n", off, ws_size); return; }
#if MULTI_LAUNCH
  for (int ph = 0; ph < 38; ++ph) hipLaunchKernelGGL(mega_kernel, dim3(512), dim3(256), 0, stream, p, ph, ph + 1);
#else
  static int grid_blocks = 0;
  if (!grid_blocks) {
    int dev = 0, cus = 0, per_cu = 0;
    hipGetDevice(&dev);
    hipDeviceGetAttribute(&cus, hipDeviceAttributeMultiprocessorCount, dev);
    hipOccupancyMaxActiveBlocksPerMultiprocessor(&per_cu, mega_kernel, 256, 0);
    if (per_cu > 2) per_cu = 2;
    grid_blocks = cus * per_cu;
  }
  int lo = 0, hi = 38;
  void* args[] = {&p, &lo, &hi};
  hipError_t e = hipLaunchCooperativeKernel((void*)mega_kernel, dim3(grid_blocks), dim3(256), args, 0, stream);
  if (e != hipSuccess) fprintf(stderr, "cooperative launch failed: %s (grid %d)\n", hipGetErrorString(e), grid_blocks);
#endif
}
```

```cpp
#include <hip/hip_runtime.h>
#include <hip/hip_cooperative_groups.h>
#include <cstdio>
#include <cstdint>
namespace cg = cooperative_groups;

#ifndef MULTI_LAUNCH
#define MULTI_LAUNCH 0
#endif

typedef unsigned short bf16_t;
typedef short bf16x8 __attribute__((ext_vector_type(8)));
typedef short s16x4 __attribute__((ext_vector_type(4)));
typedef float f32x4 __attribute__((ext_vector_type(4)));
typedef float f32x2 __attribute__((ext_vector_type(2)));
typedef __bf16 bf2_t __attribute__((ext_vector_type(2)));
typedef unsigned u32x4 __attribute__((ext_vector_type(4)));
typedef unsigned u32x2 __attribute__((ext_vector_type(2)));
#define MK4(a,b,c,d) ((u32x4){(a),(b),(c),(d)})
#define MK2(a,b) ((u32x2){(a),(b)})

#define NROWS 33280
#define NLAT 32768
#define PW 3072
#define LOG2E 1.4426950408889634f
#define LDS_BYTES 73728

#define C_CQ 0
#define C_CKV 256
#define C_KR 384
#define C_RQ 416
#define C_RK 672
#define C_RV 928
#define C_RGF 1184
#define C_RGB 1440
#define C_NQ 1696
#define C_NK 1952
#define C_NV 2208
#define C_SQ 2464
#define C_SK 2720
#define C_SV 2848

#define WO_IN 0
#define WO_UQ 3145728
#define WO_UKV 3244032
#define WO_OUT 3309568
#define WO_13 4358144
#define WO_2 10125312
#define W_LAYER 13008896

struct Params {
  const float *x, *c, *ctx, *c_ctx, *ada_w, *ada_b, *norm1_g, *w_in, *mla_q_norm, *mla_w_uq, *mla_kv_norm, *mla_w_ukv,
      *ret_decay, *na_rpb, *swa_sink, *w_out, *norm2_g, *ffn_w1, *ffn_w3, *ffn_w2, *final_g;
  float* out;
  float* Y;
  bf16_t* ACT;
  bf16_t* P;
  bf16_t *Qm, *Km, *Vm;
  float* Ksum;
  bf16_t* St;
  bf16_t* W;
  float* mod;
  float* rope64;
  float* rope32;
  unsigned* bar;
};

__device__ __forceinline__ int otid() { int t = threadIdx.x; asm volatile("" : "+v"(t)); return t; }
typedef __amdgpu_buffer_rsrc_t rsrc_t;
__device__ __forceinline__ rsrc_t mkbuf(const void* base) { return __builtin_amdgcn_make_buffer_rsrc((void*)base, 0, 0x7fffffff, 0x00020000); }
__device__ __forceinline__ u32x4 bload16(rsrc_t r, unsigned voff, unsigned soff) { return __builtin_amdgcn_raw_buffer_load_b128(r, voff, soff, 0); }
__device__ __forceinline__ u32x2 bload8(rsrc_t r, unsigned voff, unsigned soff) { return __builtin_amdgcn_raw_buffer_load_b64(r, voff, soff, 0); }
__device__ __forceinline__ float bf2f(bf16_t h) { return __uint_as_float(((unsigned)h) << 16); }
__device__ __forceinline__ unsigned pack2(float a, float b) { f32x2 v = {a, b}; bf2_t r = __builtin_convertvector(v, bf2_t); return __builtin_bit_cast(unsigned, r); }
__device__ __forceinline__ bf16_t f2bf(float a) { return (bf16_t)(pack2(a, 0.f) & 0xffffu); }
__device__ __forceinline__ float lo_f(unsigned u) { return __uint_as_float(u << 16); }
__device__ __forceinline__ float hi_f(unsigned u) { return __uint_as_float(u & 0xffff0000u); }
__device__ __forceinline__ f32x4 mfma16(bf16x8 a, bf16x8 b, f32x4 c) { return __builtin_amdgcn_mfma_f32_16x16x32_bf16(a, b, c, 0, 0, 0); }
typedef __attribute__((address_space(3))) s16x4 lds_s16x4;
__device__ __forceinline__ s16x4 tr_read(const bf16_t* p) { return __builtin_amdgcn_ds_read_tr16_b64_v4i16((lds_s16x4*)p); }
__device__ __forceinline__ bf16x8 cat8(s16x4 a, s16x4 b) { bf16x8 r; r[0]=a[0]; r[1]=a[1]; r[2]=a[2]; r[3]=a[3]; r[4]=b[0]; r[5]=b[1]; r[6]=b[2]; r[7]=b[3]; return r; }
__device__ __forceinline__ float wave_sum(float v) {
  v += __shfl_xor(v, 32); v += __shfl_xor(v, 16); v += __shfl_xor(v, 8); v += __shfl_xor(v, 4); v += __shfl_xor(v, 2); v += __shfl_xor(v, 1); return v;
}
__device__ __forceinline__ float silu_f(float a) { return a / (1.f + __expf(-a)); }

__device__ __forceinline__ float* xrow(const Params& p, int row) { return row < NLAT ? p.out + (size_t)row * 1024 : p.Y + (size_t)(row - NLAT) * 1024; }
__device__ __forceinline__ const float* xsrc(const Params& p, int l, int row) {
  if (l == 0) return row < NLAT ? p.x + (size_t)row * 1024 : p.ctx + (size_t)(row - NLAT) * 1024;
  return xrow(p, row);
}
__device__ __forceinline__ int modv(int row) { return row < 16384 ? 0 : (row < NLAT ? 1 : 2); }

__device__ void transpose_tile(const float* __restrict__ src, int N, int k0, int n0, bf16_t* __restrict__ dst, int ldd, int mode,
                               const float* __restrict__ kscale, char* lds) {
  bf16_t(*t)[66] = (bf16_t(*)[66])lds;
  const int tid = otid();
  __syncthreads();
#pragma unroll 4
  for (int i = 0; i < 16; ++i) {
    int kk = i * 4 + (tid >> 6), nn = tid & 63;
    float v = (n0 + nn < N) ? src[(size_t)(k0 + kk) * N + n0 + nn] : 0.f;
    if (kscale) v *= kscale[k0 + kk];
    t[kk][nn] = f2bf(v);
  }
  __syncthreads();
  int nn = tid >> 2, kq = tid & 3;
  int n = n0 + nn;
  if (n < N) {
    int row = mode == 0 ? n : ((n >> 4) * 32 + (n & 15) + (mode == 2 ? 16 : 0));
    unsigned w[8];
#pragma unroll
    for (int e = 0; e < 8; ++e) w[e] = (unsigned)t[kq * 16 + 2 * e][nn] | ((unsigned)t[kq * 16 + 2 * e + 1][nn] << 16);
    u32x4* d = (u32x4*)(dst + (size_t)row * ldd + k0 + kq * 16);
    d[0] = MK4(w[0], w[1], w[2], w[3]);
    d[1] = MK4(w[4], w[5], w[6], w[7]);
  }
}

__device__ void prologue_phase(const Params& p, int bid, int nb, char* lds) {
  const int tid = otid();
  for (int it = bid; it < 4 * 3160; it += nb) {
    int l = it / 3160, r = it % 3160;
    bf16_t* W = p.W + (size_t)l * W_LAYER;
    if (r < 752) { int kt = r / 47, nt = r % 47; transpose_tile(p.w_in + (size_t)l * 1024 * 2976, 2976, kt * 64, nt * 64, W + WO_IN, 1024, 0, nullptr, lds); continue; }
    r -= 752;
    if (r < 24) { int kt = r / 6, nt = r % 6; transpose_tile(p.mla_w_uq + (size_t)l * 256 * 384, 384, kt * 64, nt * 64, W + WO_UQ, 256, 0, p.mla_q_norm + l * 256, lds); continue; }
    r -= 24;
    if (r < 16) { int kt = r / 8, nt = r % 8; transpose_tile(p.mla_w_ukv + (size_t)l * 128 * 512, 512, kt * 64, nt * 64, W + WO_UKV, 128, 0, p.mla_kv_norm + l * 128, lds); continue; }
    r -= 16;
    if (r < 256) { int kt = r / 16, nt = r % 16; transpose_tile(p.w_out + (size_t)l * 1024 * 1024, 1024, kt * 64, nt * 64, W + WO_OUT, 1024, 0, nullptr, lds); continue; }
    r -= 256;
    if (r < 704) { int kt = r / 44, nt = r % 44; transpose_tile(p.ffn_w1 + (size_t)l * 1024 * 2816, 2816, kt * 64, nt * 64, W + WO_13, 1024, 1, nullptr, lds); continue; }
    r -= 704;
    if (r < 704) { int kt = r / 44, nt = r % 44; transpose_tile(p.ffn_w3 + (size_t)l * 1024 * 2816, 2816, kt * 64, nt * 64, W + WO_13, 1024, 2, nullptr, lds); continue; }
    r -= 704;
    { int kt = r / 16, nt = r % 16; transpose_tile(p.ffn_w2 + (size_t)l * 2816 * 1024, 1024, kt * 64, nt * 64, W + WO_2, 2816, 0, nullptr, lds); }
  }
  for (int it = bid; it < 4 * 48; it += nb) {
    int l = it / 48, part = it % 48;
    u32x4* d = (u32x4*)(p.W + (size_t)l * W_LAYER + WO_IN + (size_t)2976 * 1024);
    d[part * 256 + tid] = MK4(0, 0, 0, 0);
  }
  for (int it = bid; it < 4 * 96; it += nb) {
    int l = it / 96, cb = it % 96;
    float* s = (float*)lds;
    float* red = s + 3 * 1024;
    __syncthreads();
    for (int i = tid; i < 3072; i += 256) {
      int v = i >> 10, k = i & 1023;
      float cv = v < 2 ? p.c[v * 1024 + k] : p.c_ctx[k];
      s[i] = silu_f(cv);
    }
    __syncthreads();
    int col = cb * 64 + (tid & 63), kp = tid >> 6;
    const float* w = p.ada_w + (size_t)l * 1024 * 6144 + (size_t)(kp * 256) * 6144 + col;
    float a0 = 0.f, a1 = 0.f, a2 = 0.f;
#pragma unroll 8
    for (int k = 0; k < 256; ++k) {
      float wv = w[(size_t)k * 6144];
      a0 += s[kp * 256 + k] * wv; a1 += s[1024 + kp * 256 + k] * wv; a2 += s[2048 + kp * 256 + k] * wv;
    }
    red[(kp * 3 + 0) * 64 + (tid & 63)] = a0; red[(kp * 3 + 1) * 64 + (tid & 63)] = a1; red[(kp * 3 + 2) * 64 + (tid & 63)] = a2;
    __syncthreads();
    if (tid < 192) {
      int v = tid >> 6, cc = tid & 63;
      float sum = red[(0 * 3 + v) * 64 + cc] + red[(1 * 3 + v) * 64 + cc] + red[(2 * 3 + v) * 64 + cc] + red[(3 * 3 + v) * 64 + cc];
      p.mod[(size_t)(l * 3 + v) * 6144 + cb * 64 + cc] = sum + p.ada_b[l * 6144 + cb * 64 + cc];
    }
  }
  if (bid == (nb > 1 ? 1 : 0)) {
    int pos = tid;
    for (int i = 0; i < 16; ++i) {
      float inv = exp2f(-(float)(2 * i) / 32.f * 13.287712379549449f);
      float ang = (float)pos * inv;
      float n = rintf(ang * 0.15915494309189535f);
      float r = fmaf(-n, 6.28318548202514648f, ang); r = fmaf(-n, -1.74845553146951715e-07f, r);
      p.rope64[(pos * 16 + i) * 2] = cosf(r); p.rope64[(pos * 16 + i) * 2 + 1] = sinf(r);
    }
    for (int i = 0; i < 8; ++i) {
      float inv = exp2f(-(float)(2 * i) / 16.f * 13.287712379549449f);
      float ang = (float)pos * inv;
      float n = rintf(ang * 0.15915494309189535f);
      float r = fmaf(-n, 6.28318548202514648f, ang); r = fmaf(-n, -1.74845553146951715e-07f, r);
      p.rope32[(pos * 8 + i) * 2] = cosf(r); p.rope32[(pos * 8 + i) * 2 + 1] = sinf(r);
    }
  }
}

__device__ void norm_phase(const Params& p, int l, int which, int bid, int nb) {
  const int wave = otid() >> 6, lane = otid() & 63;
  const float* g = (which == 0 ? p.norm1_g : p.norm2_g) + l * 1024;
  for (int row = bid * 4 + wave; row < NROWS; row += nb * 4) {
    const float* src = which == 0 ? xsrc(p, l, row) : xrow(p, row);
    const float* md = p.mod + (size_t)(l * 3 + modv(row)) * 6144 + which * 3072;
    f32x4 v[4]; float ss = 0.f;
#pragma unroll
    for (int i = 0; i < 4; ++i) { v[i] = *(const f32x4*)(src + i * 256 + lane * 4); ss += v[i][0] * v[i][0] + v[i][1] * v[i][1] + v[i][2] * v[i][2] + v[i][3] * v[i][3]; }
    ss = wave_sum(ss);
    float rinv = rsqrtf(ss * (1.f / 1024.f) + 1e-6f);
#pragma unroll
    for (int i = 0; i < 4; ++i) {
      int col = i * 256 + lane * 4;
      f32x4 g4 = *(const f32x4*)(g + col), sh = *(const f32x4*)(md + col), sc = *(const f32x4*)(md + 1024 + col);
      f32x4 y;
#pragma unroll
      for (int j = 0; j < 4; ++j) y[j] = (v[i][j] * rinv * g4[j]) * (1.f + sc[j]) + sh[j];
      *(u32x2*)(p.ACT + (size_t)row * 1024 + col) = MK2(pack2(y[0], y[1]), pack2(y[2], y[3]));
    }
  }
}

__device__ void final_norm_phase(const Params& p, int bid, int nb) {
  const int wave = otid() >> 6, lane = otid() & 63;
  for (int row = bid * 4 + wave; row < NLAT; row += nb * 4) {
    float* src = p.out + (size_t)row * 1024;
    f32x4 v[4]; float ss = 0.f;
#pragma unroll
    for (int i = 0; i < 4; ++i) { v[i] = *(const f32x4*)(src + i * 256 + lane * 4); ss += v[i][0] * v[i][0] + v[i][1] * v[i][1] + v[i][2] * v[i][2] + v[i][3] * v[i][3]; }
    ss = wave_sum(ss);
    float rinv = rsqrtf(ss * (1.f / 1024.f) + 1e-6f);
#pragma unroll
    for (int i = 0; i < 4; ++i) {
      int col = i * 256 + lane * 4;
      f32x4 g4 = *(const f32x4*)(p.final_g + col);
      f32x4 y;
#pragma unroll
      for (int j = 0; j < 4; ++j) y[j] = v[i][j] * rinv * g4[j];
      *(f32x4*)(src + col) = y;
    }
  }
}

#define GSTR 72
template <class Epi>
__device__ __forceinline__ void gemm_tile(const bf16_t* __restrict__ A, int lda, const bf16_t* __restrict__ Bt, int ldb, int K, int m0, int n0,
                                          const Epi& epi, char* lds) {
  bf16_t* As = (bf16_t*)lds;
  bf16_t* Bs = As + 2 * 128 * GSTR;
  const int tid = otid(), wave = tid >> 6, lane = tid & 63, wm = wave >> 1, wn = wave & 1, lr = lane & 15, quad = lane >> 4;
  const int lrow = tid >> 3, lch = tid & 7;
  rsrc_t gar = mkbuf(A + (size_t)m0 * lda), gbr = mkbuf(Bt + (size_t)n0 * ldb);
  unsigned aoff[4], boff[4];
#pragma unroll
  for (int i = 0; i < 4; ++i) { aoff[i] = (unsigned)((lrow + 32 * i) * lda + lch * 8) * 2u; boff[i] = (unsigned)((lrow + 32 * i) * ldb + lch * 8) * 2u; }
  u32x4 ra0[4], rb0[4], ra1[4], rb1[4];
  f32x4 acc[4][4];
#pragma unroll
  for (int i = 0; i < 4; ++i)
#pragma unroll
    for (int j = 0; j < 4; ++j) acc[i][j] = (f32x4){0.f, 0.f, 0.f, 0.f};
  const int nk = K >> 6;
#pragma unroll
  for (int i = 0; i < 4; ++i) { ra0[i] = bload16(gar, aoff[i], 0); rb0[i] = bload16(gbr, boff[i], 0); }
#pragma unroll
  for (int i = 0; i < 4; ++i) { ra1[i] = bload16(gar, aoff[i], 128u); rb1[i] = bload16(gbr, boff[i], 128u); }
  __syncthreads();
#pragma unroll
  for (int i = 0; i < 4; ++i) { *(u32x4*)(As + (lrow + 32 * i) * GSTR + lch * 8) = ra0[i]; *(u32x4*)(Bs + (lrow + 32 * i) * GSTR + lch * 8) = rb0[i]; }
  __syncthreads();
  const bf16_t* as0 = As + (wm * 64 + lr) * GSTR + quad * 8;
  const bf16_t* bs0 = Bs + (wn * 64 + lr) * GSTR + quad * 8;
#define GEMM_COMPUTE(BUF)                                                                                         \
  {                                                                                                               \
    const bf16_t* as = as0 + (BUF) * 128 * GSTR;                                                                  \
    const bf16_t* bs = bs0 + (BUF) * 128 * GSTR;                                                                  \
    _Pragma("unroll") for (int ks = 0; ks < 2; ++ks) {                                                            \
      bf16x8 af[4], bfr[4];                                                                                       \
      _Pragma("unroll") for (int i = 0; i < 4; ++i) {                                                             \
        af[i] = *(const bf16x8*)(as + i * 16 * GSTR + ks * 32);                                                   \
        bfr[i] = *(const bf16x8*)(bs + i * 16 * GSTR + ks * 32);                                                  \
      }                                                                                                           \
      _Pragma("unroll") for (int mi = 0; mi < 4; ++mi)                                                            \
        _Pragma("unroll") for (int ni = 0; ni < 4; ++ni) acc[mi][ni] = mfma16(bfr[ni], af[mi], acc[mi][ni]);      \
    }                                                                                                             \
  }
  for (int kt = 0; kt < nk; kt += 2) {
    if (kt + 2 < nk) {
      const unsigned so = (unsigned)(kt + 2) * 128u;
#pragma unroll
      for (int i = 0; i < 4; ++i) { ra0[i] = bload16(gar, aoff[i], so); rb0[i] = bload16(gbr, boff[i], so); }
    }
    GEMM_COMPUTE(0)
#pragma unroll
    for (int i = 0; i < 4; ++i) { *(u32x4*)(As + 128 * GSTR + (lrow + 32 * i) * GSTR + lch * 8) = ra1[i]; *(u32x4*)(Bs + 128 * GSTR + (lrow + 32 * i) * GSTR + lch * 8) = rb1[i]; }
    __syncthreads();
    if (kt + 3 < nk) {
      const unsigned so = (unsigned)(kt + 3) * 128u;
#pragma unroll
      for (int i = 0; i < 4; ++i) { ra1[i] = bload16(gar, aoff[i], so); rb1[i] = bload16(gbr, boff[i], so); }
    }
    GEMM_COMPUTE(1)
    if (kt + 2 < nk) {
#pragma unroll
      for (int i = 0; i < 4; ++i) { *(u32x4*)(As + (lrow + 32 * i) * GSTR + lch * 8) = ra0[i]; *(u32x4*)(Bs + (lrow + 32 * i) * GSTR + lch * 8) = rb0[i]; }
    }
    __syncthreads();
  }
#undef GEMM_COMPUTE
  epi(acc, m0 + wm * 64, n0 + wn * 64, lr, quad);
}

__device__ __forceinline__ void tile_coord(int t, int nN, int& pm, int& pn) {
  int gsz = 20 * nN; int g = t / gsz, r = t % gsz; pm = g * 20 + (r % 20); pn = r / 20;
}

struct EpiWin {
  bf16_t* P;
  __device__ __forceinline__ void operator()(f32x4 (&acc)[4][4], int mb, int nbs, int lr, int quad) const {
#pragma unroll
    for (int mi = 0; mi < 4; ++mi) {
      bf16_t* rp = P + (size_t)(mb + mi * 16 + lr) * PW + nbs + quad * 4;
#pragma unroll
      for (int ni = 0; ni < 4; ++ni) *(u32x2*)(rp + ni * 16) = MK2(pack2(acc[mi][ni][0], acc[mi][ni][1]), pack2(acc[mi][ni][2], acc[mi][ni][3]));
    }
  }
};

struct EpiResid {
  const Params* p; int l; int goff; int use_src;
  __device__ __forceinline__ void operator()(f32x4 (&acc)[4][4], int mb, int nbs, int lr, int quad) const {
#pragma unroll
    for (int mi = 0; mi < 4; ++mi) {
      int row = mb + mi * 16 + lr;
      const float* gate = p->mod + (size_t)(l * 3 + modv(row)) * 6144 + goff;
      const float* src = use_src ? xsrc(*p, l, row) : xrow(*p, row);
      float* dst = xrow(*p, row);
#pragma unroll
      for (int ni = 0; ni < 4; ++ni) {
        int col = nbs + ni * 16 + quad * 4;
        f32x4 g4 = *(const f32x4*)(gate + col), x4 = *(const f32x4*)(src + col);
#pragma unroll
        for (int j = 0; j < 4; ++j) x4[j] += g4[j] * acc[mi][ni][j];
        *(f32x4*)(dst + col) = x4;
      }
    }
  }
};

struct EpiFfn1 {
  bf16_t* U;
  __device__ __forceinline__ void operator()(f32x4 (&acc)[4][4], int mb, int nbs, int lr, int quad) const {
#pragma unroll
    for (int mi = 0; mi < 4; ++mi) {
      int row = mb + mi * 16 + lr;
#pragma unroll
      for (int pr = 0; pr < 2; ++pr) {
        int ucol = ((nbs + pr * 32) >> 5) * 16 + quad * 4;
        float u[4];
#pragma unroll
        for (int j = 0; j < 4; ++j) u[j] = silu_f(acc[mi][2 * pr][j]) * acc[mi][2 * pr + 1][j];
        *(u32x2*)(U + (size_t)row * 2816 + ucol) = MK2(pack2(u[0], u[1]), pack2(u[2], u[3]));
      }
    }
  }
};

struct EpiUq {
  const Params* p;
  __device__ __forceinline__ void operator()(f32x4 (&acc)[4][4], int mb, int nbs, int lr, int quad) const {
#pragma unroll
    for (int mi = 0; mi < 4; ++mi) {
      int row = mb + mi * 16 + lr;
      const bf16_t* cq = p->P + (size_t)row * PW + C_CQ + quad * 64;
      float ss = 0.f;
#pragma unroll
      for (int i = 0; i < 8; ++i) {
        u32x4 w = *(const u32x4*)(cq + i * 8);
        float a;
        a = lo_f(w.x); ss += a * a; a = hi_f(w.x); ss += a * a; a = lo_f(w.y); ss += a * a; a = hi_f(w.y); ss += a * a;
        a = lo_f(w.z); ss += a * a; a = hi_f(w.z); ss += a * a; a = lo_f(w.w); ss += a * a; a = hi_f(w.w); ss += a * a;
      }
      ss += __shfl_xor(ss, 16); ss += __shfl_xor(ss, 32);
      float rinv = rsqrtf(ss * (1.f / 256.f) + 1e-6f);
      bool latent = row < NLAT;
      int tok = row & 16383, prow = tok >> 6, pcol = tok & 63;
#pragma unroll
      for (int ni = 0; ni < 4; ++ni) {
        int col = nbs + ni * 16 + quad * 4;
        int sub = ((nbs >> 4) + ni) % 6;
        float v[4];
#pragma unroll
        for (int j = 0; j < 4; ++j) v[j] = acc[mi][ni][j] * rinv;
        if (sub >= 4) {
          float o[4];
#pragma unroll
          for (int j = 0; j < 4; ++j) o[j] = __shfl_xor(v[j], 32);
          if (latent) {
            int pos = sub == 4 ? prow : pcol;
#pragma unroll
            for (int j = 0; j < 4; ++j) {
              int i = (quad & 1) * 4 + j;
              float cs = p->rope32[(pos * 8 + i) * 2], sn = p->rope32[(pos * 8 + i) * 2 + 1];
              v[j] = quad < 2 ? v[j] * cs - o[j] * sn : v[j] * cs + o[j] * sn;
            }
          }
        }
        *(u32x2*)(p->Qm + (size_t)row * 384 + col) = MK2(pack2(v[0], v[1]), pack2(v[2], v[3]));
      }
    }
  }
};

__device__ __forceinline__ void mla_key_of_row(int row, int& b, int& key) {
  if (row < NLAT) { b = row >> 14; key = row & 16383; } else { b = (row - NLAT) >> 8; key = 16384 + ((row - NLAT) & 255); }
}

struct EpiUkv {
  const Params* p;
  __device__ __forceinline__ void operator()(f32x4 (&acc)[4][4], int mb, int nbs, int lr, int quad) const {
    int h = nbs >> 7, isv = (nbs >> 6) & 1;
#pragma unroll
    for (int mi = 0; mi < 4; ++mi) {
      int row = mb + mi * 16 + lr;
      const bf16_t* ck = p->P + (size_t)row * PW + C_CKV + quad * 32;
      float ss = 0.f;
#pragma unroll
      for (int i = 0; i < 4; ++i) {
        u32x4 w = *(const u32x4*)(ck + i * 8);
        float a;
        a = lo_f(w.x); ss += a * a; a = hi_f(w.x); ss += a * a; a = lo_f(w.y); ss += a * a; a = hi_f(w.y); ss += a * a;
        a = lo_f(w.z); ss += a * a; a = hi_f(w.z); ss += a * a; a = lo_f(w.w); ss += a * a; a = hi_f(w.w); ss += a * a;
      }
      ss += __shfl_xor(ss, 16); ss += __shfl_xor(ss, 32);
      float rinv = rsqrtf(ss * (1.f / 128.f) + 1e-6f);
      int b, key; mla_key_of_row(row, b, key);
      size_t kidx = (size_t)(b * 4 + h) * 16640 + key;
      bf16_t* dst = isv ? p->Vm + kidx * 64 : p->Km + kidx * 96;
#pragma unroll
      for (int ni = 0; ni < 4; ++ni) {
        f32x4 a = acc[mi][ni];
        *(u32x2*)(dst + ni * 16 + quad * 4) = MK2(pack2(a[0] * rinv, a[1] * rinv), pack2(a[2] * rinv, a[3] * rinv));
      }
    }
  }
};

__device__ __forceinline__ void rope64_pair_vals(const bf16_t* base, int pr, int prow, int pcol, const float* rope64, bool rotate, float (&o1)[8], float (&o2)[8], int& c0) {
  c0 = pr < 2 ? pr : pr + 2;
  int pos = pr < 2 ? prow : pcol, i0 = (pr & 1) * 8;
  u32x4 a = *(const u32x4*)(base + c0 * 8), b = *(const u32x4*)(base + (c0 + 2) * 8);
  unsigned aw[4] = {a.x, a.y, a.z, a.w}, bw[4] = {b.x, b.y, b.z, b.w};
#pragma unroll
  for (int e = 0; e < 8; ++e) {
    float x1 = (e & 1) ? hi_f(aw[e >> 1]) : lo_f(aw[e >> 1]);
    float x2 = (e & 1) ? hi_f(bw[e >> 1]) : lo_f(bw[e >> 1]);
    if (rotate) {
      float cs = rope64[(pos * 16 + i0 + e) * 2], sn = rope64[(pos * 16 + i0 + e) * 2 + 1];
      o1[e] = x1 * cs - x2 * sn; o2[e] = x2 * cs + x1 * sn;
    } else { o1[e] = x1; o2[e] = x2; }
  }
}
__device__ __forceinline__ u32x4 pack8(const float (&o)[8]) { return MK4(pack2(o[0], o[1]), pack2(o[2], o[3]), pack2(o[4], o[5]), pack2(o[6], o[7])); }

#define VSTR 80
__device__ void ret_prep_item(const Params& p, int l, int c, int h, char* lds) {
  bf16_t* vL = (bf16_t*)lds;
  bf16_t* kfL = vL + 128 * VSTR;
  bf16_t* kbL = kfL + 128 * VSTR;
  const int tid = otid(), wave = tid >> 6, lane = tid & 63, lr = lane & 15, quad = lane >> 4;
  const bool latent = c < 256;
  const int r0 = c * 128;
  float df = p.ret_decay[l * 8 + h], db = p.ret_decay[l * 8 + 4 + h];
  float lgf = -log1pf(__expf(-df)) * LOG2E, lgb = -log1pf(__expf(-db)) * LOG2E;
  __syncthreads();
#pragma unroll
  for (int i = 0; i < 2; ++i) {
    int idx = tid + 256 * i, r = idx >> 2, pr = idx & 3;
    int row = r0 + r, tok = row & 16383, prow = tok >> 6, pcol = tok & 63;
    bf16_t* kb = p.P + (size_t)row * PW + C_RK + h * 64;
    float o1[8], o2[8]; int c0;
    rope64_pair_vals(kb, pr, prow, pcol, p.rope64, latent, o1, o2, c0);
    if (latent) { *(u32x4*)(kb + c0 * 8) = pack8(o1); *(u32x4*)(kb + (c0 + 2) * 8) = pack8(o2); }
    float wf = exp2f(lgf * (float)(127 - r)) * 0.125f, wb = exp2f(lgb * (float)r) * 0.125f;
    float t1[8], t2[8];
#pragma unroll
    for (int e = 0; e < 8; ++e) { t1[e] = o1[e] * wf; t2[e] = o2[e] * wf; }
    *(u32x4*)(kfL + r * VSTR + c0 * 8) = pack8(t1); *(u32x4*)(kfL + r * VSTR + (c0 + 2) * 8) = pack8(t2);
#pragma unroll
    for (int e = 0; e < 8; ++e) { t1[e] = o1[e] * wb; t2[e] = o2[e] * wb; }
    *(u32x4*)(kbL + r * VSTR + c0 * 8) = pack8(t1); *(u32x4*)(kbL + r * VSTR + (c0 + 2) * 8) = pack8(t2);
    if (latent) {
      bf16_t* qb = p.P + (size_t)row * PW + C_RQ + h * 64;
      rope64_pair_vals(qb, pr, prow, pcol, p.rope64, true, o1, o2, c0);
      *(u32x4*)(qb + c0 * 8) = pack8(o1); *(u32x4*)(qb + (c0 + 2) * 8) = pack8(o2);
    }
  }
#pragma unroll
  for (int i = 0; i < 4; ++i) {
    int idx = tid + 256 * i, r = idx >> 3, ch = idx & 7;
    *(u32x4*)(vL + r * VSTR + ch * 8) = *(const u32x4*)(p.P + (size_t)(r0 + r) * PW + C_RV + h * 64 + ch * 8);
  }
  __syncthreads();
  f32x4 acc[2][4];
#pragma unroll
  for (int d = 0; d < 2; ++d)
#pragma unroll
    for (int j = 0; j < 4; ++j) acc[d][j] = (f32x4){0.f, 0.f, 0.f, 0.f};
  const int roff = (quad * 4 + (lr >> 2)) * VSTR + (lr & 3) * 4;
#pragma unroll
  for (int ks = 0; ks < 4; ++ks) {
    bf16x8 af = cat8(tr_read(vL + ks * 32 * VSTR + roff + wave * 16), tr_read(vL + (ks * 32 + 16) * VSTR + roff + wave * 16));
#pragma unroll
    for (int dt = 0; dt < 4; ++dt) {
      bf16x8 b0 = cat8(tr_read(kfL + ks * 32 * VSTR + roff + dt * 16), tr_read(kfL + (ks * 32 + 16) * VSTR + roff + dt * 16));
      acc[0][dt] = mfma16(af, b0, acc[0][dt]);
      bf16x8 b1 = cat8(tr_read(kbL + ks * 32 * VSTR + roff + dt * 16), tr_read(kbL + (ks * 32 + 16) * VSTR + roff + dt * 16));
      acc[1][dt] = mfma16(af, b1, acc[1][dt]);
    }
  }
#pragma unroll
  for (int dir = 0; dir < 2; ++dir) {
    float* ks = p.Ksum + ((size_t)(dir * 260 + c) * 4 + h) * 4096;
#pragma unroll
    for (int dt = 0; dt < 4; ++dt)
#pragma unroll
      for (int j = 0; j < 4; ++j) ks[(wave * 16 + quad * 4 + j) * 64 + dt * 16 + lr] = acc[dir][dt][j];
  }
}

__device__ void swa_rope_item(const Params& p, int mt) {
  const int tid = otid();
  for (int idx = tid; idx < 128 * 24; idx += 256) {
    int r = idx / 24, pp = idx % 24;
    int row = mt * 128 + r, tok = row & 16383, prow = tok >> 6, pcol = tok & 63;
    int hd = pp >> 2, pr = pp & 3;
    bf16_t* base = p.P + (size_t)row * PW + (hd < 4 ? C_SQ + hd * 64 : C_SK + (hd - 4) * 64);
    float o1[8], o2[8]; int c0;
    rope64_pair_vals(base, pr, prow, pcol, p.rope64, true, o1, o2, c0);
    *(u32x4*)(base + c0 * 8) = pack8(o1); *(u32x4*)(base + (c0 + 2) * 8) = pack8(o2);
  }
}

__device__ void mla_krope_item(const Params& p, int m0, int h) {
  const int tid = otid();
  int row = m0 + (tid >> 1), part = tid & 1;
  bool latent = row < NLAT;
  int tok = row & 16383, pos = part == 0 ? (tok >> 6) : (tok & 63);
  const bf16_t* src = p.P + (size_t)row * PW + C_KR + part * 16;
  u32x4 a = *(const u32x4*)src, b = *(const u32x4*)(src + 8);
  unsigned aw[4] = {a.x, a.y, a.z, a.w}, bw[4] = {b.x, b.y, b.z, b.w};
  float o1[8], o2[8];
#pragma unroll
  for (int e = 0; e < 8; ++e) {
    float x1 = (e & 1) ? hi_f(aw[e >> 1]) : lo_f(aw[e >> 1]);
    float x2 = (e & 1) ? hi_f(bw[e >> 1]) : lo_f(bw[e >> 1]);
    if (latent) {
      float cs = p.rope32[(pos * 8 + e) * 2], sn = p.rope32[(pos * 8 + e) * 2 + 1];
      o1[e] = x1 * cs - x2 * sn; o2[e] = x2 * cs + x1 * sn;
    } else { o1[e] = x1; o2[e] = x2; }
  }
  int b_, key; mla_key_of_row(row, b_, key);
  bf16_t* dst = p.Km + ((size_t)(b_ * 4 + h) * 16640 + key) * 96 + 64 + part * 16;
  *(u32x4*)dst = pack8(o1); *(u32x4*)(dst + 8) = pack8(o2);
}

struct KVT { const bf16_t* k; const bf16_t* v; };

template <int DQK, bool SOFTMAX, bool PLAIN, class TileFn, class MaskFn>
__device__ __forceinline__ void attn_core(const bf16x8 (&qf)[2][DQK / 32], int ntiles, const TileFn& tf, int ldk, int ldv, const MaskFn& mk,
                                          f32x4 (&o)[4][2], float (&m)[2], float (&l)[2], char* lds) {
  constexpr int KSTR = DQK + 8, NKS = DQK / 32, KCH = DQK / 8, NKL = (64 * KCH) / 256;
  bf16_t* Kl = (bf16_t*)lds;
  bf16_t* Vl = Kl + 2 * 64 * KSTR;
  const int tid = otid(), wave = tid >> 6, lane = tid & 63, lr = lane & 15, quad = lane >> 4;
  u32x4 rk[NKL], rv[2];
  unsigned koff[NKL], voff[2];
#pragma unroll
  for (int i = 0; i < NKL; ++i) { int c = tid + i * 256, r = c / KCH, ch = c % KCH; koff[i] = (unsigned)(r * ldk + ch * 8) * 2u; }
#pragma unroll
  for (int i = 0; i < 2; ++i) { int c = tid + i * 256, r = c >> 3, ch = c & 7; voff[i] = (unsigned)(r * ldv + ch * 8) * 2u; }
  __syncthreads();
  {
    KVT kv = tf(0);
    rsrc_t kr = mkbuf(kv.k), vr = mkbuf(kv.v);
#pragma unroll
    for (int i = 0; i < NKL; ++i) rk[i] = bload16(kr, koff[i], 0);
#pragma unroll
    for (int i = 0; i < 2; ++i) rv[i] = bload16(vr, voff[i], 0);
#pragma unroll
    for (int i = 0; i < NKL; ++i) { int c = tid + i * 256, r = c / KCH, ch = c % KCH; *(u32x4*)(Kl + r * KSTR + ch * 8) = rk[i]; }
#pragma unroll
    for (int i = 0; i < 2; ++i) { int c = tid + i * 256, r = c >> 3, ch = c & 7; *(u32x4*)(Vl + r * VSTR + ch * 8) = rv[i]; }
  }
  __syncthreads();
  for (int t = 0; t < ntiles; ++t) {
    const int cur = t & 1;
    if (t + 1 < ntiles) {
      KVT kv = tf(t + 1);
      rsrc_t kr = mkbuf(kv.k), vr = mkbuf(kv.v);
#pragma unroll
      for (int i = 0; i < NKL; ++i) rk[i] = bload16(kr, koff[i], 0);
#pragma unroll
      for (int i = 0; i < 2; ++i) rv[i] = bload16(vr, voff[i], 0);
    }
    f32x4 s[4][2];
#pragma unroll
    for (int kt = 0; kt < 4; ++kt) { s[kt][0] = (f32x4){0.f, 0.f, 0.f, 0.f}; s[kt][1] = (f32x4){0.f, 0.f, 0.f, 0.f}; }
    const bf16_t* kb = Kl + cur * 64 * KSTR + lr * KSTR + quad * 8;
    {
      bf16x8 kfa[NKS][4];
#pragma unroll
      for (int ks = 0; ks < NKS; ++ks)
#pragma unroll
        for (int kt = 0; kt < 4; ++kt) kfa[ks][kt] = *(const bf16x8*)(kb + kt * 16 * KSTR + ks * 32);
#pragma unroll
      for (int ks = 0; ks < NKS; ++ks)
#pragma unroll
        for (int kt = 0; kt < 4; ++kt) {
          s[kt][0] = mfma16(kfa[ks][kt], qf[0][ks], s[kt][0]);
          s[kt][1] = mfma16(kfa[ks][kt], qf[1][ks], s[kt][1]);
        }
    }
    if (!PLAIN) {
#pragma unroll
      for (int kt = 0; kt < 4; ++kt)
#pragma unroll
        for (int qt = 0; qt < 2; ++qt)
#pragma unroll
          for (int j = 0; j < 4; ++j) s[kt][qt][j] = mk(t, wave * 32 + qt * 16 + lr, kt * 16 + quad * 4 + j, s[kt][qt][j]);
    }
    if (SOFTMAX) {
      const float sl2 = PLAIN ? mk(0, 0, 0, 1.0f) : 1.0f;
      float mnew[2], alpha[2];
#pragma unroll
      for (int qt = 0; qt < 2; ++qt) {
        float mx = fmaxf(fmaxf(s[0][qt][0], s[0][qt][1]), fmaxf(s[0][qt][2], s[0][qt][3]));
#pragma unroll
        for (int kt = 1; kt < 4; ++kt) mx = fmaxf(fmaxf(mx, s[kt][qt][0]), fmaxf(fmaxf(s[kt][qt][1], s[kt][qt][2]), s[kt][qt][3]));
        mx = fmaxf(mx, __shfl_xor(mx, 16)); mx = fmaxf(mx, __shfl_xor(mx, 32));
        if (PLAIN) mx *= sl2;
        mnew[qt] = fmaxf(m[qt], mx);
        alpha[qt] = __builtin_amdgcn_exp2f(m[qt] - mnew[qt]);
        m[qt] = mnew[qt];
      }
      if (__any((alpha[0] < 1.f) | (alpha[1] < 1.f))) {
#pragma unroll
        for (int qt = 0; qt < 2; ++qt) {
          l[qt] *= alpha[qt];
#pragma unroll
          for (int dt = 0; dt < 4; ++dt)
#pragma unroll
            for (int j = 0; j < 4; ++j) o[dt][qt][j] *= alpha[qt];
        }
      }
#pragma unroll
      for (int qt = 0; qt < 2; ++qt) {
        float ls = 0.f;
        const float nm = -mnew[qt];
#pragma unroll
        for (int kt = 0; kt < 4; ++kt)
#pragma unroll
          for (int j = 0; j < 4; ++j) {
            float pv = __builtin_amdgcn_exp2f(PLAIN ? fmaf(s[kt][qt][j], sl2, nm) : s[kt][qt][j] + nm);
            s[kt][qt][j] = pv; ls += pv;
          }
        l[qt] += ls;
      }
    }
    bf16x8 pf[2][2];
#pragma unroll
    for (int qt = 0; qt < 2; ++qt)
#pragma unroll
      for (int kk = 0; kk < 2; ++kk) {
        unsigned w0 = pack2(s[2 * kk][qt][0], s[2 * kk][qt][1]), w1 = pack2(s[2 * kk][qt][2], s[2 * kk][qt][3]);
        unsigned w2 = pack2(s[2 * kk + 1][qt][0], s[2 * kk + 1][qt][1]), w3 = pack2(s[2 * kk + 1][qt][2], s[2 * kk + 1][qt][3]);
        u32x4 u = MK4(w0, w1, w2, w3);
        pf[qt][kk] = __builtin_bit_cast(bf16x8, u);
      }
    const bf16_t* vb = Vl + cur * 64 * VSTR + (quad * 4 + (lr >> 2)) * VSTR + (lr & 3) * 4;
    {
      bf16x8 vfa[2][4];
#pragma unroll
      for (int kk = 0; kk < 2; ++kk)
#pragma unroll
        for (int dt = 0; dt < 4; ++dt) vfa[kk][dt] = cat8(tr_read(vb + (kk * 32) * VSTR + dt * 16), tr_read(vb + (kk * 32 + 16) * VSTR + dt * 16));
#pragma unroll
      for (int kk = 0; kk < 2; ++kk)
#pragma unroll
        for (int dt = 0; dt < 4; ++dt) {
          o[dt][0] = mfma16(vfa[kk][dt], pf[0][kk], o[dt][0]);
          o[dt][1] = mfma16(vfa[kk][dt], pf[1][kk], o[dt][1]);
        }
    }
    if (t + 1 < ntiles) {
      const int nx = cur ^ 1;
#pragma unroll
      for (int i = 0; i < NKL; ++i) { int c = tid + i * 256, r = c / KCH, ch = c % KCH; *(u32x4*)(Kl + nx * 64 * KSTR + r * KSTR + ch * 8) = rk[i]; }
#pragma unroll
      for (int i = 0; i < 2; ++i) { int c = tid + i * 256, r = c >> 3, ch = c & 7; *(u32x4*)(Vl + nx * 64 * VSTR + r * VSTR + ch * 8) = rv[i]; }
    }
    __syncthreads();
  }
}

__device__ __forceinline__ void attn_store(f32x4 (&o)[4][2], float (&m)[2], float (&l)[2], bool has_sink, float sink_l2, bf16_t* dst  , int ldo) {
  const int lane = otid() & 63, wave = otid() >> 6, lr = lane & 15, quad = lane >> 4;
#pragma unroll
  for (int qt = 0; qt < 2; ++qt) {
    float lt = l[qt]; lt += __shfl_xor(lt, 16); lt += __shfl_xor(lt, 32);
    if (has_sink) lt += exp2f(sink_l2 - m[qt]);
    float inv = 1.f / lt;
    bf16_t* rp = dst + (size_t)(wave * 32 + qt * 16 + lr) * ldo + quad * 4;
#pragma unroll
    for (int dt = 0; dt < 4; ++dt)
      *(u32x2*)(rp + dt * 16) = MK2(pack2(o[dt][qt][0] * inv, o[dt][qt][1] * inv), pack2(o[dt][qt][2] * inv, o[dt][qt][3] * inv));
  }
}

template <int NKS>
__device__ __forceinline__ void load_q(bf16x8 (&qf)[2][NKS], const bf16_t* q  , int ldq) {
  const int lane = otid() & 63, wave = otid() >> 6, lr = lane & 15, quad = lane >> 4;
#pragma unroll
  for (int qt = 0; qt < 2; ++qt)
#pragma unroll
    for (int ks = 0; ks < NKS; ++ks) qf[qt][ks] = *(const bf16x8*)(q + (size_t)(wave * 32 + qt * 16 + lr) * ldq + ks * 32 + quad * 8);
}

struct TileContig { const bf16_t* k; const bf16_t* v; size_t ks, vs;
  __device__ __forceinline__ KVT operator()(int t) const { return KVT{k + (size_t)t * ks, v + (size_t)t * vs}; } };
struct MaskScale { float sl2; __device__ __forceinline__ float operator()(int, int, int, float s) const { return s * sl2; } };

__device__ void mla_item(const Params& p, int b, int h, int qt128, bool ctxq, char* lds) {
  int r0 = ctxq ? NLAT + b * 256 + qt128 * 128 : b * 16384 + qt128 * 128;
  bf16x8 qf[2][3];
  load_q<3>(qf, p.Qm + (size_t)r0 * 384 + h * 96, 384);
  f32x4 o[4][2]; float m[2] = {-1e30f, -1e30f}, l[2] = {0.f, 0.f};
#pragma unroll
  for (int dt = 0; dt < 4; ++dt) { o[dt][0] = (f32x4){0.f, 0.f, 0.f, 0.f}; o[dt][1] = (f32x4){0.f, 0.f, 0.f, 0.f}; }
  int t0 = ctxq ? 256 : 0, nt = ctxq ? 4 : 260;
  size_t kbase = (size_t)(b * 4 + h) * 16640 + (size_t)t0 * 64;
  TileContig tf{p.Km + kbase * 96, p.Vm + kbase * 64, (size_t)64 * 96, (size_t)64 * 64};
  MaskScale mk{0.10206207261596575f * LOG2E};
  attn_core<96, true, true>(qf, nt, tf, 96, 64, mk, o, m, l, lds);
  attn_store(o, m, l, false, 0.f, p.ACT + (size_t)r0 * 1024 + h * 64, 1024);
}

struct NaTiles { const bf16_t* P; int b, h, lo, nw;
  __device__ __forceinline__ KVT operator()(int t) const {
    size_t row = t < nw ? (size_t)b * 16384 + (size_t)(lo + t) * 64 : (size_t)NLAT + b * 256 + (size_t)(t - nw) * 64;
    return KVT{P + row * PW + C_NK + h * 64, P + row * PW + C_NV + h * 64}; } };
struct NaMask { const float* rpb; int nw, lo, qr0; float sl2;
  __device__ __forceinline__ float operator()(int t, int qi, int kj, float s) const {
    if (t >= nw) return s * sl2;
    int qr = qr0 + (qi >> 6), qc = qi & 63, kr = lo + t;
    int r0q = min(max(qr - 4, 0), 248), c0 = min(max(qc - 8, 0), 48);
    bool ok = (kr >= r0q) & (kr < r0q + 8) & (kj >= c0) & (kj < c0 + 16);
    int dr = min(max(kr - qr + 7, 0), 14), dc = min(max(kj - qc, -15), 15) + 15;
    float bias = rpb[dr * 31 + dc];
    return ok ? s * sl2 + bias * LOG2E : -INFINITY; } };

__device__ void na_item(const Params& p, int l, int b, int h, int pair, char* lds) {
  float* rpbL = (float*)(lds + 60000);
  __syncthreads();
  for (int i = otid(); i < 465; i += 256) rpbL[i] = p.na_rpb[(size_t)(l * 4 + h) * 465 + i];
  int r0 = b * 16384 + pair * 128;
  bf16x8 qf[2][2];
  load_q<2>(qf, p.P + (size_t)r0 * PW + C_NQ + h * 64, PW);
  f32x4 o[4][2]; float m[2] = {-1e30f, -1e30f}, ls[2] = {0.f, 0.f};
#pragma unroll
  for (int dt = 0; dt < 4; ++dt) { o[dt][0] = (f32x4){0.f, 0.f, 0.f, 0.f}; o[dt][1] = (f32x4){0.f, 0.f, 0.f, 0.f}; }
  int qr0 = pair * 2;
  int lo = min(max(qr0 - 4, 0), 248), hi = min(max(qr0 + 1 - 4, 0), 248) + 7;
  int nw = hi - lo + 1;
  NaTiles tf{p.P, b, h, lo, nw};
  NaMask mk{rpbL, nw, lo, qr0, 0.125f * LOG2E};
  attn_core<64, true, false>(qf, nw + 4, tf, PW, PW, mk, o, m, ls, lds);
  attn_store(o, m, ls, false, 0.f, p.ACT + (size_t)r0 * 1024 + 512 + h * 64, 1024);
}

struct SwaTiles { const bf16_t* P; int b, kvh, nlo, nwt;
  __device__ __forceinline__ KVT operator()(int t) const {
    size_t row = t < nwt ? (size_t)b * 16384 + (size_t)(nlo * 128 + t * 64) : (size_t)NLAT + b * 256 + (size_t)(t - nwt) * 64;
    return KVT{P + row * PW + C_SK + kvh * 64, P + row * PW + C_SV + kvh * 64}; } };
struct SwaMask { int nwt, koff  ; float sl2;
  __device__ __forceinline__ float operator()(int t, int qi, int kj, float s) const {
    if (t >= nwt) return s * sl2;
    int delta = koff + t * 64 + kj - qi;
    return (delta <= 128 && delta >= -128) ? s * sl2 : -INFINITY; } };

__device__ void swa_item(const Params& p, int l, int b, int hq, int n, bool ctxq, char* lds) {
  int r0 = ctxq ? NLAT + b * 256 + n * 128 : b * 16384 + n * 128;
  bf16x8 qf[2][2];
  load_q<2>(qf, p.P + (size_t)r0 * PW + C_SQ + hq * 64, PW);
  f32x4 o[4][2]; float m[2] = {-1e30f, -1e30f}, ls[2] = {0.f, 0.f};
#pragma unroll
  for (int dt = 0; dt < 4; ++dt) { o[dt][0] = (f32x4){0.f, 0.f, 0.f, 0.f}; o[dt][1] = (f32x4){0.f, 0.f, 0.f, 0.f}; }
  int nlo = 0, nwt = 0;
  if (!ctxq) { nlo = max(n - 1, 0); int nhi = min(n + 1, 127); nwt = (nhi - nlo + 1) * 2; }
  SwaTiles tf{p.P, b, hq >> 1, nlo, nwt};
  SwaMask mk{nwt, (nlo - n) * 128, 0.125f * LOG2E};
  attn_core<64, true, false>(qf, nwt + 4, tf, PW, PW, mk, o, m, ls, lds);
  float sink = p.swa_sink[l * 4 + hq] * LOG2E;
  attn_store(o, m, ls, true, sink, p.ACT + (size_t)r0 * 1024 + 768 + hq * 64, 1024);
}

__device__ void na_ctx_item(const Params& p, int b, int h, int n, char* lds) {
  int r0 = NLAT + b * 256 + n * 128;
  bf16x8 qf[2][2];
  load_q<2>(qf, p.P + (size_t)r0 * PW + C_NQ + h * 64, PW);
  f32x4 o[4][2]; float m[2] = {-1e30f, -1e30f}, ls[2] = {0.f, 0.f};
#pragma unroll
  for (int dt = 0; dt < 4; ++dt) { o[dt][0] = (f32x4){0.f, 0.f, 0.f, 0.f}; o[dt][1] = (f32x4){0.f, 0.f, 0.f, 0.f}; }
  NaTiles tf{p.P, b, h, 0, 0};
  MaskScale mk{0.125f * LOG2E};
  attn_core<64, true, true>(qf, 4, tf, PW, PW, mk, o, m, ls, lds);
  attn_store(o, m, ls, false, 0.f, p.ACT + (size_t)r0 * 1024 + 512 + h * 64, 1024);
}

__device__ void ret_scan_item(const Params& p, int l, int combo, int part) {
  int dir = combo >> 3, b = (combo >> 2) & 1, h = combo & 3;
  float d = p.ret_decay[l * 8 + dir * 4 + h];
  float lg = -log1pf(__expf(-d)) * LOG2E;
  float gC = exp2f(lg * 128.f);
  int idx = part * 1024 + otid() * 4;
  f32x4 S = (f32x4){0.f, 0.f, 0.f, 0.f};
#pragma unroll 4
  for (int step = 0; step < 130; ++step) {
    int chunk;
    if (dir == 0) chunk = step < 2 ? 256 + 2 * b + step : b * 128 + (step - 2);
    else chunk = step < 2 ? 256 + 2 * b + 1 - step : b * 128 + 127 - (step - 2);
    size_t off = ((size_t)(dir * 260 + chunk) * 4 + h) * 4096 + idx;
    *(u32x2*)(p.St + off) = MK2(pack2(S[0], S[1]), pack2(S[2], S[3]));
    f32x4 kv = *(const f32x4*)(p.Ksum + off);
#pragma unroll
    for (int j = 0; j < 4; ++j) S[j] = S[j] * gC + kv[j];
  }
}

struct RetMask { float lg; int dir;
  __device__ __forceinline__ float operator()(int t, int qi, int kj, float s) const {
    int j = t * 64 + kj; int df = dir == 0 ? qi - j : j - qi;
    return df >= 0 ? s * 0.125f * __builtin_amdgcn_exp2f(lg * (float)df) : 0.f; } };

__device__ void ret_out_item(const Params& p, int l, int c, int h, char* lds) {
  const int lane = otid() & 63, wave = otid() >> 6, lr = lane & 15, quad = lane >> 4;
  int r0 = c * 128;
  bf16x8 qf[2][2];
  load_q<2>(qf, p.P + (size_t)r0 * PW + C_RQ + h * 64, PW);
  f32x4 res[4][2];
#pragma unroll
  for (int dt = 0; dt < 4; ++dt) { res[dt][0] = (f32x4){0.f, 0.f, 0.f, 0.f}; res[dt][1] = (f32x4){0.f, 0.f, 0.f, 0.f}; }
  TileContig tf{p.P + (size_t)r0 * PW + C_RK + h * 64, p.P + (size_t)r0 * PW + C_RV + h * 64, (size_t)64 * PW, (size_t)64 * PW};
#pragma unroll 1
  for (int dir = 0; dir < 2; ++dir) {
    float d = p.ret_decay[l * 8 + dir * 4 + h];
    float lg = -log1pf(__expf(-d)) * LOG2E;
    f32x4 o[4][2]; float m[2] = {0.f, 0.f}, ls[2] = {0.f, 0.f};
#pragma unroll
    for (int dt = 0; dt < 4; ++dt) { o[dt][0] = (f32x4){0.f, 0.f, 0.f, 0.f}; o[dt][1] = (f32x4){0.f, 0.f, 0.f, 0.f}; }
    rsrc_t str = mkbuf(p.St + ((size_t)(dir * 260 + c) * 4 + h) * 4096);
#pragma unroll
    for (int ks = 0; ks < 2; ++ks)
#pragma unroll
      for (int et = 0; et < 4; ++et) {
        bf16x8 af = __builtin_bit_cast(bf16x8, bload16(str, (unsigned)(lr * 64 + quad * 8) * 2u, (unsigned)(et * 16 * 64 + ks * 32) * 2u));
        o[et][0] = mfma16(af, qf[0][ks], o[et][0]);
        o[et][1] = mfma16(af, qf[1][ks], o[et][1]);
      }
#pragma unroll
    for (int qt = 0; qt < 2; ++qt) {
      int i = wave * 32 + qt * 16 + lr;
      float qdec = exp2f(lg * (float)(dir == 0 ? i + 1 : 128 - i));
#pragma unroll
      for (int et = 0; et < 4; ++et)
#pragma unroll
        for (int j = 0; j < 4; ++j) o[et][qt][j] *= qdec;
    }
    __builtin_amdgcn_sched_barrier(0);
    RetMask mk{lg, dir};
    attn_core<64, false, false>(qf, 2, tf, PW, PW, mk, o, m, ls, lds);
    __builtin_amdgcn_sched_barrier(0);
#pragma unroll
    for (int qt = 0; qt < 2; ++qt) {
      int i = wave * 32 + qt * 16 + lr;
      float ss = 0.f;
#pragma unroll
      for (int et = 0; et < 4; ++et)
#pragma unroll
        for (int j = 0; j < 4; ++j) { float v = o[et][qt][j]; ss += v * v; }
      ss += __shfl_xor(ss, 16); ss += __shfl_xor(ss, 32);
      float rinv = rsqrtf(ss * (1.f / 64.f) + 1e-6f);
      rsrc_t gpr = mkbuf(p.P + (size_t)r0 * PW + (dir == 0 ? C_RGF : C_RGB) + h * 64);
      unsigned goff = (unsigned)(i * PW + quad * 4) * 2u;
#pragma unroll
      for (int et = 0; et < 4; ++et) {
        u32x2 gw = bload8(gpr, goff, et * 32);
        float g0 = lo_f(gw.x), g1 = hi_f(gw.x), g2 = lo_f(gw.y), g3 = hi_f(gw.y);
        res[et][qt][0] += o[et][qt][0] * rinv * silu_f(g0);
        res[et][qt][1] += o[et][qt][1] * rinv * silu_f(g1);
        res[et][qt][2] += o[et][qt][2] * rinv * silu_f(g2);
        res[et][qt][3] += o[et][qt][3] * rinv * silu_f(g3);
      }
    }
  }
#pragma unroll
  for (int qt = 0; qt < 2; ++qt) {
    bf16_t* rp = p.ACT + (size_t)(r0 + wave * 32 + qt * 16 + lr) * 1024 + 256 + h * 64 + quad * 4;
#pragma unroll
    for (int et = 0; et < 4; ++et)
      *(u32x2*)(rp + et * 16) = MK2(pack2(res[et][qt][0], res[et][qt][1]), pack2(res[et][qt][2], res[et][qt][3]));
  }
}


#define XB_TMO      128
#define XB_XCNT(j)  (256  + 64 * (j))
#define XB_XSUB(j)  (1280 + 64 * (j))
#define XB_XGEN(j)  (2304 + 64 * (j))
#define XB_TOP      3328
#define XB_TOPGEN   3392
#define XCD_BAR_WORDS 3456
#define XB_SPIN_CAP (1u << 20)
#define LAS __attribute__((address_space(3)))
__device__ __forceinline__ unsigned xb_ld(unsigned* p)              { return __hip_atomic_load(p, __ATOMIC_RELAXED, __HIP_MEMORY_SCOPE_AGENT); }
__device__ __forceinline__ unsigned xb_add(unsigned* p, unsigned v) { return __hip_atomic_fetch_add(p, v, __ATOMIC_RELAXED, __HIP_MEMORY_SCOPE_AGENT); }
__device__ __forceinline__ unsigned xb_xcc_id() { return (unsigned)__builtin_amdgcn_s_getreg((3 << 11) | 20) & 0xFu; }
#define XB_SPIN(cond, bar) do { unsigned _sp = 0; while (cond) { __builtin_amdgcn_s_sleep(1); \
    if ((++_sp & 255u) == 0u) { if (xb_ld(&(bar)[XB_TMO])) break; if (_sp > XB_SPIN_CAP) { atomicAdd(&(bar)[XB_TMO], 1u); break; } } } } while (0)
struct XcdBarrier { unsigned* bar; unsigned x; volatile LAS unsigned* st; };
__device__ __forceinline__ XcdBarrier xcd_barrier_post(unsigned* bar, volatile LAS unsigned* st) {
    XcdBarrier b; b.bar = bar; b.x = xb_xcc_id(); b.st = st;
    if (threadIdx.x == 0) (void)xb_add(&bar[XB_XCNT(b.x)], 1u);
    return b;
}
__device__ __forceinline__ void xcd_barrier_complete(unsigned* bar, unsigned x, unsigned& nloc, unsigned& nx) {
    const unsigned G = gridDim.x * gridDim.y * gridDim.z;
    unsigned sum, cnt, mine, sp = 0u;
    for (;;) {
        sum = 0u; cnt = 0u; mine = 0u;
#pragma unroll
        for (unsigned j = 0; j < 16; ++j) { const unsigned c = xb_ld(&bar[XB_XCNT(j)]); sum += c; cnt += (c > 0u) ? 1u : 0u; mine = (j == x) ? c : mine; }
        if (sum == G) break;
        __builtin_amdgcn_s_sleep(1);
        if ((++sp & 255u) == 0u) { if (xb_ld(&bar[XB_TMO])) break; if (sp > XB_SPIN_CAP) { atomicAdd(&bar[XB_TMO], 1u); break; } }
    }
    nloc = mine > 0u ? mine : 1u; nx = cnt > 0u ? cnt : 1u;
}
__device__ __forceinline__ void xcd_barrier(const XcdBarrier& b) {
    asm volatile("s_waitcnt vmcnt(0)" ::: "memory");
    __syncthreads();
    if (threadIdx.x == 0) {
        unsigned* bar = b.bar;
        __builtin_amdgcn_s_waitcnt(0);
        unsigned nloc = b.st[0], nx = b.st[1];
        if (nloc == 0u) { xcd_barrier_complete(bar, b.x, nloc, nx); b.st[0] = nloc; b.st[1] = nx; }
        const unsigned old = xb_add(&bar[XB_XSUB(b.x)], 1u);
        const unsigned gen = old / nloc;
        if (old + 1u == (gen + 1u) * nloc) {
            __builtin_amdgcn_fence(__ATOMIC_RELEASE, "agent");
            asm volatile("s_waitcnt vmcnt(0)" ::: "memory");
            const unsigned og = xb_add(&bar[XB_TOP], 1u);
            const unsigned tg = og / nx;
            if (og + 1u == (tg + 1u) * nx) xb_add(&bar[XB_TOPGEN], 1u);
            else XB_SPIN(xb_ld(&bar[XB_TOPGEN]) == tg, bar);
            __builtin_amdgcn_fence(__ATOMIC_ACQUIRE, "agent");
            xb_add(&bar[XB_XGEN(b.x)], 1u);
            asm volatile("s_waitcnt vmcnt(0)" ::: "memory");
        } else {
            XB_SPIN(xb_ld(&bar[XB_XGEN(b.x)]) == gen, bar);
            __builtin_amdgcn_fence(__ATOMIC_ACQUIRE, "agent");
            asm volatile("s_waitcnt vmcnt(0)" ::: "memory");
        }
    }
    __syncthreads();
}

__device__ void run_phase(const Params& p, int ph, int bid, int nb, char* lds) {
#ifndef CM
#define CM 0xff
#endif
#ifndef PH_MASK
#define PH_MASK 0xfffff
#endif
  if (ph == 0) { if (PH_MASK & (1<<9)) prologue_phase(p, bid, nb, lds); return; }
  if (ph == 37) { if (PH_MASK & (1<<10)) final_norm_phase(p, bid, nb); return; }
  const int l = (ph - 1) / 9, sp = (ph - 1) % 9;
  const bf16_t* W = p.W + (size_t)l * W_LAYER;
  if (!((PH_MASK >> sp) & 1)) return;
  switch (sp) {
    case 0: norm_phase(p, l, 0, bid, nb); break;
    case 1: {
      EpiWin epi{p.P};
      for (int t = bid; t < 260 * 24; t += nb) { int pm, pn; tile_coord(t, 24, pm, pn); gemm_tile(p.ACT, 1024, W + WO_IN, 1024, 1024, pm * 128, pn * 128, epi, lds); }
    } break;
    case 2: {
      EpiUq eq{&p}; EpiUkv ekv{&p};
      const int n0 = 260 * 4, n1 = n0 + 260 * 4, n2 = n1 + 260 * 3, n3 = n2 + 256;
      for (int t = bid; t < n3; t += nb) {
        if (t < n0) ret_prep_item(p, l, t >> 2, t & 3, lds);
        else if (t < n1) { int u = t - n0, pm = u >> 2, h = u & 3; gemm_tile(p.P + C_CKV, PW, W + WO_UKV, 128, 128, pm * 128, h * 128, ekv, lds); mla_krope_item(p, pm * 128, h); }
        else if (t < n2) { int u = t - n1, pm = u / 3, pn = u % 3; gemm_tile(p.P + C_CQ, PW, W + WO_UQ, 256, 256, pm * 128, pn * 128, eq, lds); }
        else swa_rope_item(p, t - n2);
      }
    } break;
    case 3: {
      const int n0 = 1024, n1 = n0 + 64, n2 = n1 + 16, n3 = n2 + 1024, n4 = n3 + 16, n5 = n4 + 1024, n6 = n5 + 16;
      for (int t = bid; t < n6; t += nb) {
        if (t < n0) { int b = t >> 9, h = (t >> 7) & 3, q = t & 127; if (CM & 1) mla_item(p, b, h, q, false, lds); }
        else if (t < n1) { int u = t - n0; if (CM & 2) ret_scan_item(p, l, u >> 2, u & 3); }
        else if (t < n2) { int u = t - n1; if (CM & 1) mla_item(p, u >> 3, (u >> 1) & 3, u & 1, true, lds); }
        else if (t < n3) { int u = t - n2; if (CM & 4) na_item(p, l, u >> 9, (u >> 7) & 3, u & 127, lds); }
        else if (t < n4) { int u = t - n3; if (CM & 8) na_ctx_item(p, u >> 3, (u >> 1) & 3, u & 1, lds); }
        else if (t < n5) { int u = t - n4; if (CM & 16) swa_item(p, l, u >> 9, (u >> 7) & 3, u & 127, false, lds); }
        else { int u = t - n5; if (CM & 16) swa_item(p, l, u >> 3, (u >> 1) & 3, u & 1, true, lds); }
      }
    } break;
    case 4: for (int t = bid; t < 260 * 4; t += nb) ret_out_item(p, l, t >> 2, t & 3, lds); break;
    case 5: {
      EpiResid epi{&p, l, 2048, 1};
      for (int t = bid; t < 260 * 8; t += nb) { int pm, pn; tile_coord(t, 8, pm, pn); gemm_tile(p.ACT, 1024, W + WO_OUT, 1024, 1024, pm * 128, pn * 128, epi, lds); }
    } break;
    case 6: norm_phase(p, l, 1, bid, nb); break;
    case 7: {
      EpiFfn1 epi{p.P};
      for (int t = bid; t < 260 * 44; t += nb) { int pm, pn; tile_coord(t, 44, pm, pn); gemm_tile(p.ACT, 1024, W + WO_13, 1024, 1024, pm * 128, pn * 128, epi, lds); }
    } break;
    case 8: {
      EpiResid epi{&p, l, 5120, 0};
      for (int t = bid; t < 260 * 8; t += nb) { int pm, pn; tile_coord(t, 8, pm, pn); gemm_tile(p.P, 2816, W + WO_2, 2816, 2816, pm * 128, pn * 128, epi, lds); }
    } break;
  }
}

__global__ void __launch_bounds__(256, 2) mega_kernel(Params p, int ph_lo, int ph_hi) {
  __shared__ __attribute__((aligned(16))) char lds[LDS_BYTES];
  __shared__ u32x4 xb_words;
#ifndef REP_MASK
#define REP_MASK 0
#endif
  if (ph_lo < 0) cg::this_grid().sync();
  if (threadIdx.x == 0) xb_words = (u32x4){0u, 0u, 0u, 0u};
  __syncthreads();
  XcdBarrier xb; xb.bar = p.bar; xb.x = 0; xb.st = (volatile LAS unsigned*)&xb_words;
  if (ph_hi - ph_lo > 1) xb = xcd_barrier_post(p.bar, (volatile LAS unsigned*)&xb_words);
  for (int ph = ph_lo; ph < ph_hi; ++ph) {
    const int reps = (REP_MASK && ph >= 1 && ph <= 36 && ((REP_MASK >> ((ph - 1) % 9)) & 1)) ? 2 : 1;
    for (int r = 0; r < reps; ++r) {
      run_phase(p, ph, blockIdx.x, gridDim.x, lds);
      if (r + 1 < reps || ph + 1 < ph_hi) xcd_barrier(xb);
#ifdef EXTRA_SYNC
      for (int e = 0; e < EXTRA_SYNC; ++e) xcd_barrier(xb);
#endif
    }
  }
}

extern "C" void kernel_launch(void* const* d_in, const int* in_sizes, int n_in, void* d_out, int out_size, void* d_ws, size_t ws_size,
                              hipStream_t stream) {
  Params p{};
  const float** f = (const float**)&p;
  for (int i = 0; i < 21; ++i) f[i] = (const float*)d_in[i];
  p.out = (float*)d_out;
  char* w = (char*)d_ws; size_t off = 0;
  auto take = [&](size_t bytes) { char* r = w + off; off += (bytes + 255) & ~(size_t)255; return r; };
  p.Y = (float*)take((size_t)512 * 1024 * 4);
  p.ACT = (bf16_t*)take((size_t)NROWS * 1024 * 2);
  p.P = (bf16_t*)take((size_t)NROWS * PW * 2);
  p.Qm = (bf16_t*)take((size_t)NROWS * 384 * 2);
  p.Km = (bf16_t*)take((size_t)8 * 16640 * 96 * 2);
  p.Vm = (bf16_t*)take((size_t)8 * 16640 * 64 * 2);
  p.Ksum = (float*)take((size_t)2 * 260 * 4 * 4096 * 4);
  p.St = (bf16_t*)take((size_t)2 * 260 * 4 * 4096 * 2);
  p.W = (bf16_t*)take((size_t)4 * W_LAYER * 2);
  p.mod = (float*)take((size_t)4 * 3 * 6144 * 4);
  p.rope64 = (float*)take(256 * 16 * 2 * 4);
  p.rope32 = (float*)take(256 * 8 * 2 * 4);
  p.bar = (unsigned*)take(XCD_BAR_WORDS * 4);
  if (off > ws_size) { fprintf(stderr, "workspace too small: need %zu have %zu\n", off, ws_size); return; }
#if MULTI_LAUNCH
  for (int ph = 0; ph < 38; ++ph) hipLaunchKernelGGL(mega_kernel, dim3(512), dim3(256), 0, stream, p, ph, ph + 1);
#else
  static int grid_blocks = 0;
  if (!grid_blocks) {
    int dev = 0, cus = 0, per_cu = 0;
    hipGetDevice(&dev);
    hipDeviceGetAttribute(&cus, hipDeviceAttributeMultiprocessorCount, dev);
    hipOccupancyMaxActiveBlocksPerMultiprocessor(&per_cu, mega_kernel, 256, 0);
    if (per_cu > 2) per_cu = 2;
    grid_blocks = cus * per_cu;
  }
  hipMemsetAsync(p.bar, 0, XCD_BAR_WORDS * 4, stream);
  int lo = 0, hi = 38;
  void* args[] = {&p, &lo, &hi};
  hipError_t e = hipLaunchCooperativeKernel((void*)mega_kernel, dim3(grid_blocks), dim3(256), args, 0, stream);
  if (e != hipSuccess) fprintf(stderr, "cooperative launch failed: %s (grid %d)\n", hipGetErrorString(e), grid_blocks);
#endif
}
```

```cpp
#include <hip/hip_runtime.h>
#include <hip/hip_cooperative_groups.h>
#include <cstdio>
#include <cstdint>
namespace cg = cooperative_groups;

#ifndef MULTI_LAUNCH
#define MULTI_LAUNCH 0
#endif

typedef unsigned short bf16_t;
typedef short bf16x8 __attribute__((ext_vector_type(8)));
typedef short s16x4 __attribute__((ext_vector_type(4)));
typedef float f32x4 __attribute__((ext_vector_type(4)));
typedef float f32x2 __attribute__((ext_vector_type(2)));
typedef __bf16 bf2_t __attribute__((ext_vector_type(2)));
typedef unsigned u32x4 __attribute__((ext_vector_type(4)));
typedef unsigned u32x2 __attribute__((ext_vector_type(2)));
#define MK4(a,b,c,d) ((u32x4){(a),(b),(c),(d)})
#define MK2(a,b) ((u32x2){(a),(b)})

#define NROWS 33280
#define NLAT 32768
#define PW 3072
#define LOG2E 1.4426950408889634f
#define LDS_BYTES 73728

#define C_CQ 0
#define C_CKV 256
#define C_KR 384
#define C_RQ 416
#define C_RK 672
#define C_RV 928
#define C_RGF 1184
#define C_RGB 1440
#define C_NQ 1696
#define C_NK 1952
#define C_NV 2208
#define C_SQ 2464
#define C_SK 2720
#define C_SV 2848

#define WO_IN 0
#define WO_UQ 3145728
#define WO_UKV 3244032
#define WO_OUT 3309568
#define WO_13 4358144
#define WO_2 10125312
#define W_LAYER 13008896

struct Params {
  const float *x, *c, *ctx, *c_ctx, *ada_w, *ada_b, *norm1_g, *w_in, *mla_q_norm, *mla_w_uq, *mla_kv_norm, *mla_w_ukv,
      *ret_decay, *na_rpb, *swa_sink, *w_out, *norm2_g, *ffn_w1, *ffn_w3, *ffn_w2, *final_g;
  float* out;
  float* Y;
  bf16_t* ACT;
  bf16_t* P;
  bf16_t *Qm, *Km, *Vm;
  float* Ksum;
  bf16_t* St;
  bf16_t* W;
  float* mod;
  float* rope64;
  float* rope32;
  unsigned* bar;
};

__device__ __forceinline__ int otid() { int t = threadIdx.x; asm volatile("" : "+v"(t)); return t; }
typedef __amdgpu_buffer_rsrc_t rsrc_t;
__device__ __forceinline__ rsrc_t mkbuf(const void* base) { return __builtin_amdgcn_make_buffer_rsrc((void*)base, 0, 0x7fffffff, 0x00020000); }
__device__ __forceinline__ u32x4 bload16(rsrc_t r, unsigned voff, unsigned soff) { return __builtin_amdgcn_raw_buffer_load_b128(r, voff, soff, 0); }
__device__ __forceinline__ u32x2 bload8(rsrc_t r, unsigned voff, unsigned soff) { return __builtin_amdgcn_raw_buffer_load_b64(r, voff, soff, 0); }
__device__ __forceinline__ float bf2f(bf16_t h) { return __uint_as_float(((unsigned)h) << 16); }
__device__ __forceinline__ unsigned pack2(float a, float b) { f32x2 v = {a, b}; bf2_t r = __builtin_convertvector(v, bf2_t); return __builtin_bit_cast(unsigned, r); }
__device__ __forceinline__ bf16_t f2bf(float a) { return (bf16_t)(pack2(a, 0.f) & 0xffffu); }
__device__ __forceinline__ float lo_f(unsigned u) { return __uint_as_float(u << 16); }
__device__ __forceinline__ float hi_f(unsigned u) { return __uint_as_float(u & 0xffff0000u); }
__device__ __forceinline__ f32x4 mfma16(bf16x8 a, bf16x8 b, f32x4 c) { return __builtin_amdgcn_mfma_f32_16x16x32_bf16(a, b, c, 0, 0, 0); }
typedef __attribute__((address_space(3))) s16x4 lds_s16x4;
__device__ __forceinline__ s16x4 tr_read(const bf16_t* p) { return __builtin_amdgcn_ds_read_tr16_b64_v4i16((lds_s16x4*)p); }
__device__ __forceinline__ bf16x8 cat8(s16x4 a, s16x4 b) { bf16x8 r; r[0]=a[0]; r[1]=a[1]; r[2]=a[2]; r[3]=a[3]; r[4]=b[0]; r[5]=b[1]; r[6]=b[2]; r[7]=b[3]; return r; }
__device__ __forceinline__ float wave_sum(float v) {
  v += __shfl_xor(v, 32); v += __shfl_xor(v, 16); v += __shfl_xor(v, 8); v += __shfl_xor(v, 4); v += __shfl_xor(v, 2); v += __shfl_xor(v, 1); return v;
}
__device__ __forceinline__ float silu_f(float a) { return a / (1.f + __expf(-a)); }

__device__ __forceinline__ float* xrow(const Params& p, int row) { return row < NLAT ? p.out + (size_t)row * 1024 : p.Y + (size_t)(row - NLAT) * 1024; }
__device__ __forceinline__ const float* xsrc(const Params& p, int l, int row) {
  if (l == 0) return row < NLAT ? p.x + (size_t)row * 1024 : p.ctx + (size_t)(row - NLAT) * 1024;
  return xrow(p, row);
}
__device__ __forceinline__ int modv(int row) { return row < 16384 ? 0 : (row < NLAT ? 1 : 2); }

__device__ void transpose_tile(const float* __restrict__ src, int N, int k0, int n0, bf16_t* __restrict__ dst, int ldd, int mode,
                               const float* __restrict__ kscale, char* lds) {
  bf16_t(*t)[66] = (bf16_t(*)[66])lds;
  const int tid = otid();
  __syncthreads();
#pragma unroll 4
  for (int i = 0; i < 16; ++i) {
    int kk = i * 4 + (tid >> 6), nn = tid & 63;
    float v = (n0 + nn < N) ? src[(size_t)(k0 + kk) * N + n0 + nn] : 0.f;
    if (kscale) v *= kscale[k0 + kk];
    t[kk][nn] = f2bf(v);
  }
  __syncthreads();
  int nn = tid >> 2, kq = tid & 3;
  int n = n0 + nn;
  if (n < N) {
    int row = mode == 0 ? n : ((n >> 4) * 32 + (n & 15) + (mode == 2 ? 16 : 0));
    unsigned w[8];
#pragma unroll
    for (int e = 0; e < 8; ++e) w[e] = (unsigned)t[kq * 16 + 2 * e][nn] | ((unsigned)t[kq * 16 + 2 * e + 1][nn] << 16);
    u32x4* d = (u32x4*)(dst + (size_t)row * ldd + k0 + kq * 16);
    d[0] = MK4(w[0], w[1], w[2], w[3]);
    d[1] = MK4(w[4], w[5], w[6], w[7]);
  }
}

__device__ void prologue_phase(const Params& p, int bid, int nb, char* lds) {
  const int tid = otid();
  for (int it = bid; it < 4 * 3160; it += nb) {
    int l = it / 3160, r = it % 3160;
    bf16_t* W = p.W + (size_t)l * W_LAYER;
    if (r < 752) { int kt = r / 47, nt = r % 47; transpose_tile(p.w_in + (size_t)l * 1024 * 2976, 2976, kt * 64, nt * 64, W + WO_IN, 1024, 0, nullptr, lds); continue; }
    r -= 752;
    if (r < 24) { int kt = r / 6, nt = r % 6; transpose_tile(p.mla_w_uq + (size_t)l * 256 * 384, 384, kt * 64, nt * 64, W + WO_UQ, 256, 0, p.mla_q_norm + l * 256, lds); continue; }
    r -= 24;
    if (r < 16) { int kt = r / 8, nt = r % 8; transpose_tile(p.mla_w_ukv + (size_t)l * 128 * 512, 512, kt * 64, nt * 64, W + WO_UKV, 128, 0, p.mla_kv_norm + l * 128, lds); continue; }
    r -= 16;
    if (r < 256) { int kt = r / 16, nt = r % 16; transpose_tile(p.w_out + (size_t)l * 1024 * 1024, 1024, kt * 64, nt * 64, W + WO_OUT, 1024, 0, nullptr, lds); continue; }
    r -= 256;
    if (r < 704) { int kt = r / 44, nt = r % 44; transpose_tile(p.ffn_w1 + (size_t)l * 1024 * 2816, 2816, kt * 64, nt * 64, W + WO_13, 1024, 1, nullptr, lds); continue; }
    r -= 704;
    if (r < 704) { int kt = r / 44, nt = r % 44; transpose_tile(p.ffn_w3 + (size_t)l * 1024 * 2816, 2816, kt * 64, nt * 64, W + WO_13, 1024, 2, nullptr, lds); continue; }
    r -= 704;
    { int kt = r / 16, nt = r % 16; transpose_tile(p.ffn_w2 + (size_t)l * 2816 * 1024, 1024, kt * 64, nt * 64, W + WO_2, 2816, 0, nullptr, lds); }
  }
  for (int it = bid; it < 4 * 48; it += nb) {
    int l = it / 48, part = it % 48;
    u32x4* d = (u32x4*)(p.W + (size_t)l * W_LAYER + WO_IN + (size_t)2976 * 1024);
    d[part * 256 + tid] = MK4(0, 0, 0, 0);
  }
  for (int it = bid; it < 4 * 96; it += nb) {
    int l = it / 96, cb = it % 96;
    float* s = (float*)lds;
    float* red = s + 3 * 1024;
    __syncthreads();
    for (int i = tid; i < 3072; i += 256) {
      int v = i >> 10, k = i & 1023;
      float cv = v < 2 ? p.c[v * 1024 + k] : p.c_ctx[k];
      s[i] = silu_f(cv);
    }
    __syncthreads();
    int col = cb * 64 + (tid & 63), kp = tid >> 6;
    const float* w = p.ada_w + (size_t)l * 1024 * 6144 + (size_t)(kp * 256) * 6144 + col;
    float a0 = 0.f, a1 = 0.f, a2 = 0.f;
#pragma unroll 8
    for (int k = 0; k < 256; ++k) {
      float wv = w[(size_t)k * 6144];
      a0 += s[kp * 256 + k] * wv; a1 += s[1024 + kp * 256 + k] * wv; a2 += s[2048 + kp * 256 + k] * wv;
    }
    red[(kp * 3 + 0) * 64 + (tid & 63)] = a0; red[(kp * 3 + 1) * 64 + (tid & 63)] = a1; red[(kp * 3 + 2) * 64 + (tid & 63)] = a2;
    __syncthreads();
    if (tid < 192) {
      int v = tid >> 6, cc = tid & 63;
      float sum = red[(0 * 3 + v) * 64 + cc] + red[(1 * 3 + v) * 64 + cc] + red[(2 * 3 + v) * 64 + cc] + red[(3 * 3 + v) * 64 + cc];
      p.mod[(size_t)(l * 3 + v) * 6144 + cb * 64 + cc] = sum + p.ada_b[l * 6144 + cb * 64 + cc];
    }
  }
  if (bid == (nb > 1 ? 1 : 0)) {
    int pos = tid;
    for (int i = 0; i < 16; ++i) {
      float inv = exp2f(-(float)(2 * i) / 32.f * 13.287712379549449f);
      float ang = (float)pos * inv;
      float n = rintf(ang * 0.15915494309189535f);
      float r = fmaf(-n, 6.28318548202514648f, ang); r = fmaf(-n, -1.74845553146951715e-07f, r);
      p.rope64[(pos * 16 + i) * 2] = cosf(r); p.rope64[(pos * 16 + i) * 2 + 1] = sinf(r);
    }
    for (int i = 0; i < 8; ++i) {
      float inv = exp2f(-(float)(2 * i) / 16.f * 13.287712379549449f);
      float ang = (float)pos * inv;
      float n = rintf(ang * 0.15915494309189535f);
      float r = fmaf(-n, 6.28318548202514648f, ang); r = fmaf(-n, -1.74845553146951715e-07f, r);
      p.rope32[(pos * 8 + i) * 2] = cosf(r); p.rope32[(pos * 8 + i) * 2 + 1] = sinf(r);
    }
  }
}

__device__ void norm_phase(const Params& p, int l, int which, int bid, int nb) {
  const int wave = otid() >> 6, lane = otid() & 63;
  const float* g = (which == 0 ? p.norm1_g : p.norm2_g) + l * 1024;
  for (int row = bid * 4 + wave; row < NROWS; row += nb * 4) {
    const float* src = which == 0 ? xsrc(p, l, row) : xrow(p, row);
    const float* md = p.mod + (size_t)(l * 3 + modv(row)) * 6144 + which * 3072;
    f32x4 v[4]; float ss = 0.f;
#pragma unroll
    for (int i = 0; i < 4; ++i) { v[i] = *(const f32x4*)(src + i * 256 + lane * 4); ss += v[i][0] * v[i][0] + v[i][1] * v[i][1] + v[i][2] * v[i][2] + v[i][3] * v[i][3]; }
    ss = wave_sum(ss);
    float rinv = rsqrtf(ss * (1.f / 1024.f) + 1e-6f);
#pragma unroll
    for (int i = 0; i < 4; ++i) {
      int col = i * 256 + lane * 4;
      f32x4 g4 = *(const f32x4*)(g + col), sh = *(const f32x4*)(md + col), sc = *(const f32x4*)(md + 1024 + col);
      f32x4 y;
#pragma unroll
      for (int j = 0; j < 4; ++j) y[j] = (v[i][j] * rinv * g4[j]) * (1.f + sc[j]) + sh[j];
      *(u32x2*)(p.ACT + (size_t)row * 1024 + col) = MK2(pack2(y[0], y[1]), pack2(y[2], y[3]));
    }
  }
}

__device__ void final_norm_phase(const Params& p, int bid, int nb) {
  const int wave = otid() >> 6, lane = otid() & 63;
  for (int row = bid * 4 + wave; row < NLAT; row += nb * 4) {
    float* src = p.out + (size_t)row * 1024;
    f32x4 v[4]; float ss = 0.f;
#pragma unroll
    for (int i = 0; i < 4; ++i) { v[i] = *(const f32x4*)(src + i * 256 + lane * 4); ss += v[i][0] * v[i][0] + v[i][1] * v[i][1] + v[i][2] * v[i][2] + v[i][3] * v[i][3]; }
    ss = wave_sum(ss);
    float rinv = rsqrtf(ss * (1.f / 1024.f) + 1e-6f);
#pragma unroll
    for (int i = 0; i < 4; ++i) {
      int col = i * 256 + lane * 4;
      f32x4 g4 = *(const f32x4*)(p.final_g + col);
      f32x4 y;
#pragma unroll
      for (int j = 0; j < 4; ++j) y[j] = v[i][j] * rinv * g4[j];
      *(f32x4*)(src + col) = y;
    }
  }
}

#define GSTR 64
template <class Epi>
__device__ __forceinline__ void gemm_tile(const bf16_t* __restrict__ A, int lda, const bf16_t* __restrict__ Bt, int ldb, int K, int m0, int n0,
                                          const Epi& epi, char* lds) {
  bf16_t* As = (bf16_t*)lds;
  bf16_t* Bs = As + 2 * 128 * GSTR;
  const int tid = otid(), wave = tid >> 6, lane = tid & 63, wm = wave >> 1, wn = wave & 1, lr = lane & 15, quad = lane >> 4;
  const int lrow = tid >> 3, lch = tid & 7, wch = lch ^ (lrow & 7);
  rsrc_t gar = mkbuf(A + (size_t)m0 * lda), gbr = mkbuf(Bt + (size_t)n0 * ldb);
  unsigned aoff[4], boff[4];
#pragma unroll
  for (int i = 0; i < 4; ++i) { aoff[i] = (unsigned)((lrow + 32 * i) * lda + lch * 8) * 2u; boff[i] = (unsigned)((lrow + 32 * i) * ldb + lch * 8) * 2u; }
  u32x4 ra0[4], rb0[4], ra1[4], rb1[4];
  f32x4 acc[4][4];
#pragma unroll
  for (int i = 0; i < 4; ++i)
#pragma unroll
    for (int j = 0; j < 4; ++j) acc[i][j] = (f32x4){0.f, 0.f, 0.f, 0.f};
  const int nk = K >> 6;
#pragma unroll
  for (int i = 0; i < 4; ++i) { ra0[i] = bload16(gar, aoff[i], 0); rb0[i] = bload16(gbr, boff[i], 0); }
#pragma unroll
  for (int i = 0; i < 4; ++i) { ra1[i] = bload16(gar, aoff[i], 128u); rb1[i] = bload16(gbr, boff[i], 128u); }
  __syncthreads();
#pragma unroll
  for (int i = 0; i < 4; ++i) { *(u32x4*)(As + (lrow + 32 * i) * GSTR + wch * 8) = ra0[i]; *(u32x4*)(Bs + (lrow + 32 * i) * GSTR + wch * 8) = rb0[i]; }
  __syncthreads();
  const int rsw = (quad ^ (lr & 7)) * 8;
  const bf16_t* as0 = As + (wm * 64 + lr) * GSTR;
  const bf16_t* bs0 = Bs + (wn * 64 + lr) * GSTR;
#define GEMM_COMPUTE(BUF)                                                                                         \
  {                                                                                                               \
    const bf16_t* as = as0 + (BUF) * 128 * GSTR;                                                                  \
    const bf16_t* bs = bs0 + (BUF) * 128 * GSTR;                                                                  \
    _Pragma("unroll") for (int ks = 0; ks < 2; ++ks) {                                                            \
      bf16x8 af[4], bfr[4];                                                                                       \
      _Pragma("unroll") for (int i = 0; i < 4; ++i) {                                                             \
        af[i] = *(const bf16x8*)(as + i * 16 * GSTR + (rsw ^ (ks * 32)));                                         \
        bfr[i] = *(const bf16x8*)(bs + i * 16 * GSTR + (rsw ^ (ks * 32)));                                        \
      }                                                                                                           \
      _Pragma("unroll") for (int mi = 0; mi < 4; ++mi)                                                            \
        _Pragma("unroll") for (int ni = 0; ni < 4; ++ni) acc[mi][ni] = mfma16(bfr[ni], af[mi], acc[mi][ni]);      \
    }                                                                                                             \
  }
  for (int kt = 0; kt < nk; kt += 2) {
    if (kt + 2 < nk) {
      const unsigned so = (unsigned)(kt + 2) * 128u;
#pragma unroll
      for (int i = 0; i < 4; ++i) { ra0[i] = bload16(gar, aoff[i], so); rb0[i] = bload16(gbr, boff[i], so); }
    }
    GEMM_COMPUTE(0)
#pragma unroll
    for (int i = 0; i < 4; ++i) { *(u32x4*)(As + 128 * GSTR + (lrow + 32 * i) * GSTR + wch * 8) = ra1[i]; *(u32x4*)(Bs + 128 * GSTR + (lrow + 32 * i) * GSTR + wch * 8) = rb1[i]; }
    __syncthreads();
    if (kt + 3 < nk) {
      const unsigned so = (unsigned)(kt + 3) * 128u;
#pragma unroll
      for (int i = 0; i < 4; ++i) { ra1[i] = bload16(gar, aoff[i], so); rb1[i] = bload16(gbr, boff[i], so); }
    }
    GEMM_COMPUTE(1)
    if (kt + 2 < nk) {
#pragma unroll
      for (int i = 0; i < 4; ++i) { *(u32x4*)(As + (lrow + 32 * i) * GSTR + wch * 8) = ra0[i]; *(u32x4*)(Bs + (lrow + 32 * i) * GSTR + wch * 8) = rb0[i]; }
    }
    __syncthreads();
  }
#undef GEMM_COMPUTE
  epi(acc, m0 + wm * 64, n0 + wn * 64, lr, quad);
}

__device__ __forceinline__ void tile_coord(int t, int nN, int& pm, int& pn) {
  const int nM = 260, GM = 8;
  int gsz = GM * nN; int g = t / gsz, r = t % gsz; int fm = g * GM; int gm = min(GM, nM - fm);
  pm = fm + (r % gm); pn = r / gm;
}
__device__ __forceinline__ int xcd_tile(int round, int bid, int nb) { return round * nb + (bid & 7) * (nb >> 3) + (bid >> 3); }

struct EpiWin {
  bf16_t* P;
  __device__ __forceinline__ void operator()(f32x4 (&acc)[4][4], int mb, int nbs, int lr, int quad) const {
#pragma unroll
    for (int mi = 0; mi < 4; ++mi) {
      bf16_t* rp = P + (size_t)(mb + mi * 16 + lr) * PW + nbs + quad * 4;
#pragma unroll
      for (int ni = 0; ni < 4; ++ni) *(u32x2*)(rp + ni * 16) = MK2(pack2(acc[mi][ni][0], acc[mi][ni][1]), pack2(acc[mi][ni][2], acc[mi][ni][3]));
    }
  }
};

struct EpiResid {
  const Params* p; int l; int goff; int use_src;
  __device__ __forceinline__ void operator()(f32x4 (&acc)[4][4], int mb, int nbs, int lr, int quad) const {
#pragma unroll
    for (int mi = 0; mi < 4; ++mi) {
      int row = mb + mi * 16 + lr;
      const float* gate = p->mod + (size_t)(l * 3 + modv(row)) * 6144 + goff;
      const float* src = use_src ? xsrc(*p, l, row) : xrow(*p, row);
      float* dst = xrow(*p, row);
#pragma unroll
      for (int ni = 0; ni < 4; ++ni) {
        int col = nbs + ni * 16 + quad * 4;
        f32x4 g4 = *(const f32x4*)(gate + col), x4 = *(const f32x4*)(src + col);
#pragma unroll
        for (int j = 0; j < 4; ++j) x4[j] += g4[j] * acc[mi][ni][j];
        *(f32x4*)(dst + col) = x4;
      }
    }
  }
};

struct EpiFfn1 {
  bf16_t* U;
  __device__ __forceinline__ void operator()(f32x4 (&acc)[4][4], int mb, int nbs, int lr, int quad) const {
#pragma unroll
    for (int mi = 0; mi < 4; ++mi) {
      int row = mb + mi * 16 + lr;
#pragma unroll
      for (int pr = 0; pr < 2; ++pr) {
        int ucol = ((nbs + pr * 32) >> 5) * 16 + quad * 4;
        float u[4];
#pragma unroll
        for (int j = 0; j < 4; ++j) u[j] = silu_f(acc[mi][2 * pr][j]) * acc[mi][2 * pr + 1][j];
        *(u32x2*)(U + (size_t)row * 2816 + ucol) = MK2(pack2(u[0], u[1]), pack2(u[2], u[3]));
      }
    }
  }
};

struct EpiUq {
  const Params* p;
  __device__ __forceinline__ void operator()(f32x4 (&acc)[4][4], int mb, int nbs, int lr, int quad) const {
#pragma unroll
    for (int mi = 0; mi < 4; ++mi) {
      int row = mb + mi * 16 + lr;
      const bf16_t* cq = p->P + (size_t)row * PW + C_CQ + quad * 64;
      float ss = 0.f;
#pragma unroll
      for (int i = 0; i < 8; ++i) {
        u32x4 w = *(const u32x4*)(cq + i * 8);
        float a;
        a = lo_f(w.x); ss += a * a; a = hi_f(w.x); ss += a * a; a = lo_f(w.y); ss += a * a; a = hi_f(w.y); ss += a * a;
        a = lo_f(w.z); ss += a * a; a = hi_f(w.z); ss += a * a; a = lo_f(w.w); ss += a * a; a = hi_f(w.w); ss += a * a;
      }
      ss += __shfl_xor(ss, 16); ss += __shfl_xor(ss, 32);
      float rinv = rsqrtf(ss * (1.f / 256.f) + 1e-6f);
      bool latent = row < NLAT;
      int tok = row & 16383, prow = tok >> 6, pcol = tok & 63;
#pragma unroll
      for (int ni = 0; ni < 4; ++ni) {
        int col = nbs + ni * 16 + quad * 4;
        int sub = ((nbs >> 4) + ni) % 6;
        float v[4];
#pragma unroll
        for (int j = 0; j < 4; ++j) v[j] = acc[mi][ni][j] * rinv;
        if (sub >= 4) {
          float o[4];
#pragma unroll
          for (int j = 0; j < 4; ++j) o[j] = __shfl_xor(v[j], 32);
          if (latent) {
            int pos = sub == 4 ? prow : pcol;
#pragma unroll
            for (int j = 0; j < 4; ++j) {
              int i = (quad & 1) * 4 + j;
              float cs = p->rope32[(pos * 8 + i) * 2], sn = p->rope32[(pos * 8 + i) * 2 + 1];
              v[j] = quad < 2 ? v[j] * cs - o[j] * sn : v[j] * cs + o[j] * sn;
            }
          }
        }
        *(u32x2*)(p->Qm + (size_t)row * 384 + col) = MK2(pack2(v[0], v[1]), pack2(v[2], v[3]));
      }
    }
  }
};

__device__ __forceinline__ void mla_key_of_row(int row, int& b, int& key) {
  if (row < NLAT) { b = row >> 14; key = row & 16383; } else { b = (row - NLAT) >> 8; key = 16384 + ((row - NLAT) & 255); }
}

struct EpiUkv {
  const Params* p;
  __device__ __forceinline__ void operator()(f32x4 (&acc)[4][4], int mb, int nbs, int lr, int quad) const {
    int h = nbs >> 7, isv = (nbs >> 6) & 1;
#pragma unroll
    for (int mi = 0; mi < 4; ++mi) {
      int row = mb + mi * 16 + lr;
      const bf16_t* ck = p->P + (size_t)row * PW + C_CKV + quad * 32;
      float ss = 0.f;
#pragma unroll
      for (int i = 0; i < 4; ++i) {
        u32x4 w = *(const u32x4*)(ck + i * 8);
        float a;
        a = lo_f(w.x); ss += a * a; a = hi_f(w.x); ss += a * a; a = lo_f(w.y); ss += a * a; a = hi_f(w.y); ss += a * a;
        a = lo_f(w.z); ss += a * a; a = hi_f(w.z); ss += a * a; a = lo_f(w.w); ss += a * a; a = hi_f(w.w); ss += a * a;
      }
      ss += __shfl_xor(ss, 16); ss += __shfl_xor(ss, 32);
      float rinv = rsqrtf(ss * (1.f / 128.f) + 1e-6f);
      int b, key; mla_key_of_row(row, b, key);
      size_t kidx = (size_t)(b * 4 + h) * 16640 + key;
      bf16_t* dst = isv ? p->Vm + kidx * 64 : p->Km + kidx * 96;
#pragma unroll
      for (int ni = 0; ni < 4; ++ni) {
        f32x4 a = acc[mi][ni];
        *(u32x2*)(dst + ni * 16 + quad * 4) = MK2(pack2(a[0] * rinv, a[1] * rinv), pack2(a[2] * rinv, a[3] * rinv));
      }
    }
  }
};

__device__ __forceinline__ void rope64_pair_vals(const bf16_t* base, int pr, int prow, int pcol, const float* rope64, bool rotate, float (&o1)[8], float (&o2)[8], int& c0) {
  c0 = pr < 2 ? pr : pr + 2;
  int pos = pr < 2 ? prow : pcol, i0 = (pr & 1) * 8;
  u32x4 a = *(const u32x4*)(base + c0 * 8), b = *(const u32x4*)(base + (c0 + 2) * 8);
  unsigned aw[4] = {a.x, a.y, a.z, a.w}, bw[4] = {b.x, b.y, b.z, b.w};
#pragma unroll
  for (int e = 0; e < 8; ++e) {
    float x1 = (e & 1) ? hi_f(aw[e >> 1]) : lo_f(aw[e >> 1]);
    float x2 = (e & 1) ? hi_f(bw[e >> 1]) : lo_f(bw[e >> 1]);
    if (rotate) {
      float cs = rope64[(pos * 16 + i0 + e) * 2], sn = rope64[(pos * 16 + i0 + e) * 2 + 1];
      o1[e] = x1 * cs - x2 * sn; o2[e] = x2 * cs + x1 * sn;
    } else { o1[e] = x1; o2[e] = x2; }
  }
}
__device__ __forceinline__ u32x4 pack8(const float (&o)[8]) { return MK4(pack2(o[0], o[1]), pack2(o[2], o[3]), pack2(o[4], o[5]), pack2(o[6], o[7])); }

#define VSTR 80
__device__ void ret_prep_item(const Params& p, int l, int c, int h, char* lds) {
  bf16_t* vL = (bf16_t*)lds;
  bf16_t* kfL = vL + 128 * VSTR;
  bf16_t* kbL = kfL + 128 * VSTR;
  const int tid = otid(), wave = tid >> 6, lane = tid & 63, lr = lane & 15, quad = lane >> 4;
  const bool latent = c < 256;
  const int r0 = c * 128;
  float df = p.ret_decay[l * 8 + h], db = p.ret_decay[l * 8 + 4 + h];
  float lgf = -log1pf(__expf(-df)) * LOG2E, lgb = -log1pf(__expf(-db)) * LOG2E;
  __syncthreads();
#pragma unroll
  for (int i = 0; i < 2; ++i) {
    int idx = tid + 256 * i, r = idx >> 2, pr = idx & 3;
    int row = r0 + r, tok = row & 16383, prow = tok >> 6, pcol = tok & 63;
    bf16_t* kb = p.P + (size_t)row * PW + C_RK + h * 64;
    float o1[8], o2[8]; int c0;
    rope64_pair_vals(kb, pr, prow, pcol, p.rope64, latent, o1, o2, c0);
    if (latent) { *(u32x4*)(kb + c0 * 8) = pack8(o1); *(u32x4*)(kb + (c0 + 2) * 8) = pack8(o2); }
    float wf = exp2f(lgf * (float)(127 - r)) * 0.125f, wb = exp2f(lgb * (float)r) * 0.125f;
    float t1[8], t2[8];
#pragma unroll
    for (int e = 0; e < 8; ++e) { t1[e] = o1[e] * wf; t2[e] = o2[e] * wf; }
    *(u32x4*)(kfL + r * VSTR + c0 * 8) = pack8(t1); *(u32x4*)(kfL + r * VSTR + (c0 + 2) * 8) = pack8(t2);
#pragma unroll
    for (int e = 0; e < 8; ++e) { t1[e] = o1[e] * wb; t2[e] = o2[e] * wb; }
    *(u32x4*)(kbL + r * VSTR + c0 * 8) = pack8(t1); *(u32x4*)(kbL + r * VSTR + (c0 + 2) * 8) = pack8(t2);
    if (latent) {
      bf16_t* qb = p.P + (size_t)row * PW + C_RQ + h * 64;
      rope64_pair_vals(qb, pr, prow, pcol, p.rope64, true, o1, o2, c0);
      *(u32x4*)(qb + c0 * 8) = pack8(o1); *(u32x4*)(qb + (c0 + 2) * 8) = pack8(o2);
    }
  }
#pragma unroll
  for (int i = 0; i < 4; ++i) {
    int idx = tid + 256 * i, r = idx >> 3, ch = idx & 7;
    *(u32x4*)(vL + r * VSTR + ch * 8) = *(const u32x4*)(p.P + (size_t)(r0 + r) * PW + C_RV + h * 64 + ch * 8);
  }
  __syncthreads();
  f32x4 acc[2][4];
#pragma unroll
  for (int d = 0; d < 2; ++d)
#pragma unroll
    for (int j = 0; j < 4; ++j) acc[d][j] = (f32x4){0.f, 0.f, 0.f, 0.f};
  const int roff = (quad * 4 + (lr >> 2)) * VSTR + (lr & 3) * 4;
#pragma unroll
  for (int ks = 0; ks < 4; ++ks) {
    bf16x8 af = cat8(tr_read(vL + ks * 32 * VSTR + roff + wave * 16), tr_read(vL + (ks * 32 + 16) * VSTR + roff + wave * 16));
#pragma unroll
    for (int dt = 0; dt < 4; ++dt) {
      bf16x8 b0 = cat8(tr_read(kfL + ks * 32 * VSTR + roff + dt * 16), tr_read(kfL + (ks * 32 + 16) * VSTR + roff + dt * 16));
      acc[0][dt] = mfma16(af, b0, acc[0][dt]);
      bf16x8 b1 = cat8(tr_read(kbL + ks * 32 * VSTR + roff + dt * 16), tr_read(kbL + (ks * 32 + 16) * VSTR + roff + dt * 16));
      acc[1][dt] = mfma16(af, b1, acc[1][dt]);
    }
  }
#pragma unroll
  for (int dir = 0; dir < 2; ++dir) {
    float* ks = p.Ksum + ((size_t)(dir * 260 + c) * 4 + h) * 4096;
#pragma unroll
    for (int dt = 0; dt < 4; ++dt)
#pragma unroll
      for (int j = 0; j < 4; ++j) ks[(wave * 16 + quad * 4 + j) * 64 + dt * 16 + lr] = acc[dir][dt][j];
  }
}

__device__ void swa_rope_item(const Params& p, int mt) {
  const int tid = otid();
  for (int idx = tid; idx < 128 * 24; idx += 256) {
    int r = idx / 24, pp = idx % 24;
    int row = mt * 128 + r, tok = row & 16383, prow = tok >> 6, pcol = tok & 63;
    int hd = pp >> 2, pr = pp & 3;
    bf16_t* base = p.P + (size_t)row * PW + (hd < 4 ? C_SQ + hd * 64 : C_SK + (hd - 4) * 64);
    float o1[8], o2[8]; int c0;
    rope64_pair_vals(base, pr, prow, pcol, p.rope64, true, o1, o2, c0);
    *(u32x4*)(base + c0 * 8) = pack8(o1); *(u32x4*)(base + (c0 + 2) * 8) = pack8(o2);
  }
}

__device__ void mla_krope_item(const Params& p, int m0, int h) {
  const int tid = otid();
  int row = m0 + (tid >> 1), part = tid & 1;
  bool latent = row < NLAT;
  int tok = row & 16383, pos = part == 0 ? (tok >> 6) : (tok & 63);
  const bf16_t* src = p.P + (size_t)row * PW + C_KR + part * 16;
  u32x4 a = *(const u32x4*)src, b = *(const u32x4*)(src + 8);
  unsigned aw[4] = {a.x, a.y, a.z, a.w}, bw[4] = {b.x, b.y, b.z, b.w};
  float o1[8], o2[8];
#pragma unroll
  for (int e = 0; e < 8; ++e) {
    float x1 = (e & 1) ? hi_f(aw[e >> 1]) : lo_f(aw[e >> 1]);
    float x2 = (e & 1) ? hi_f(bw[e >> 1]) : lo_f(bw[e >> 1]);
    if (latent) {
      float cs = p.rope32[(pos * 8 + e) * 2], sn = p.rope32[(pos * 8 + e) * 2 + 1];
      o1[e] = x1 * cs - x2 * sn; o2[e] = x2 * cs + x1 * sn;
    } else { o1[e] = x1; o2[e] = x2; }
  }
  int b_, key; mla_key_of_row(row, b_, key);
  bf16_t* dst = p.Km + ((size_t)(b_ * 4 + h) * 16640 + key) * 96 + 64 + part * 16;
  *(u32x4*)dst = pack8(o1); *(u32x4*)(dst + 8) = pack8(o2);
}

struct KVT { const bf16_t* k; const bf16_t* v; };

template <int DQK, bool SOFTMAX, bool PLAIN, class TileFn, class MaskFn>
__device__ __forceinline__ void attn_core(const bf16x8 (&qf)[2][DQK / 32], int ntiles, const TileFn& tf, int ldk, int ldv, const MaskFn& mk,
                                          f32x4 (&o)[4][2], float (&m)[2], float (&l)[2], char* lds) {
  constexpr int KSTR = DQK + 16, NKS = DQK / 32, KCH = DQK / 8, NKL = (64 * KCH) / 256;
  bf16_t* Kl = (bf16_t*)lds;
  bf16_t* Vl = Kl + 2 * 64 * KSTR;
  const int tid = otid(), wave = tid >> 6, lane = tid & 63, lr = lane & 15, quad = lane >> 4;
  u32x4 rk[NKL], rv[2];
  unsigned koff[NKL], voff[2];
#pragma unroll
  for (int i = 0; i < NKL; ++i) { int c = tid + i * 256, r = c / KCH, ch = c % KCH; koff[i] = (unsigned)(r * ldk + ch * 8) * 2u; }
#pragma unroll
  for (int i = 0; i < 2; ++i) { int c = tid + i * 256, r = c >> 3, ch = c & 7; voff[i] = (unsigned)(r * ldv + ch * 8) * 2u; }
  __syncthreads();
  {
    KVT kv = tf(0);
    rsrc_t kr = mkbuf(kv.k), vr = mkbuf(kv.v);
#pragma unroll
    for (int i = 0; i < NKL; ++i) rk[i] = bload16(kr, koff[i], 0);
#pragma unroll
    for (int i = 0; i < 2; ++i) rv[i] = bload16(vr, voff[i], 0);
#pragma unroll
    for (int i = 0; i < NKL; ++i) { int c = tid + i * 256, r = c / KCH, ch = c % KCH; *(u32x4*)(Kl + r * KSTR + ch * 8) = rk[i]; }
#pragma unroll
    for (int i = 0; i < 2; ++i) { int c = tid + i * 256, r = c >> 3, ch = c & 7; *(u32x4*)(Vl + r * VSTR + ch * 8) = rv[i]; }
  }
  __syncthreads();
  for (int t = 0; t < ntiles; ++t) {
    const int cur = t & 1;
    if (t + 1 < ntiles) {
      KVT kv = tf(t + 1);
      rsrc_t kr = mkbuf(kv.k), vr = mkbuf(kv.v);
#pragma unroll
      for (int i = 0; i < NKL; ++i) rk[i] = bload16(kr, koff[i], 0);
#pragma unroll
      for (int i = 0; i < 2; ++i) rv[i] = bload16(vr, voff[i], 0);
    }
    f32x4 s[4][2];
#pragma unroll
    for (int kt = 0; kt < 4; ++kt) { s[kt][0] = (f32x4){0.f, 0.f, 0.f, 0.f}; s[kt][1] = (f32x4){0.f, 0.f, 0.f, 0.f}; }
    const bf16_t* kb = Kl + cur * 64 * KSTR + lr * KSTR + quad * 8;
    {
      bf16x8 kfa[NKS][4];
#pragma unroll
      for (int ks = 0; ks < NKS; ++ks)
#pragma unroll
        for (int kt = 0; kt < 4; ++kt) kfa[ks][kt] = *(const bf16x8*)(kb + kt * 16 * KSTR + ks * 32);
#pragma unroll
      for (int ks = 0; ks < NKS; ++ks)
#pragma unroll
        for (int kt = 0; kt < 4; ++kt) {
          s[kt][0] = mfma16(kfa[ks][kt], qf[0][ks], s[kt][0]);
          s[kt][1] = mfma16(kfa[ks][kt], qf[1][ks], s[kt][1]);
        }
    }
    if (!PLAIN) {
#pragma unroll
      for (int kt = 0; kt < 4; ++kt)
#pragma unroll
        for (int qt = 0; qt < 2; ++qt)
#pragma unroll
          for (int j = 0; j < 4; ++j) s[kt][qt][j] = mk(t, wave * 32 + qt * 16 + lr, kt * 16 + quad * 4 + j, s[kt][qt][j]);
    }
    if (SOFTMAX) {
      const float sl2 = PLAIN ? mk(0, 0, 0, 1.0f) : 1.0f;
      float mnew[2], alpha[2];
#pragma unroll
      for (int qt = 0; qt < 2; ++qt) {
        float mx = fmaxf(fmaxf(s[0][qt][0], s[0][qt][1]), fmaxf(s[0][qt][2], s[0][qt][3]));
#pragma unroll
        for (int kt = 1; kt < 4; ++kt) mx = fmaxf(fmaxf(mx, s[kt][qt][0]), fmaxf(fmaxf(s[kt][qt][1], s[kt][qt][2]), s[kt][qt][3]));
        mx = fmaxf(mx, __shfl_xor(mx, 16)); mx = fmaxf(mx, __shfl_xor(mx, 32));
        if (PLAIN) mx *= sl2;
        mnew[qt] = fmaxf(m[qt], mx);
        alpha[qt] = __builtin_amdgcn_exp2f(m[qt] - mnew[qt]);
        m[qt] = mnew[qt];
      }
      if (__any((alpha[0] < 1.f) | (alpha[1] < 1.f))) {
#pragma unroll
        for (int qt = 0; qt < 2; ++qt) {
          l[qt] *= alpha[qt];
#pragma unroll
          for (int dt = 0; dt < 4; ++dt)
#pragma unroll
            for (int j = 0; j < 4; ++j) o[dt][qt][j] *= alpha[qt];
        }
      }
#pragma unroll
      for (int qt = 0; qt < 2; ++qt) {
        float ls = 0.f;
        const float nm = -mnew[qt];
#pragma unroll
        for (int kt = 0; kt < 4; ++kt)
#pragma unroll
          for (int j = 0; j < 4; ++j) {
            float pv = __builtin_amdgcn_exp2f(PLAIN ? fmaf(s[kt][qt][j], sl2, nm) : s[kt][qt][j] + nm);
            s[kt][qt][j] = pv; ls += pv;
          }
        l[qt] += ls;
      }
    }
    bf16x8 pf[2][2];
#pragma unroll
    for (int qt = 0; qt < 2; ++qt)
#pragma unroll
      for (int kk = 0; kk < 2; ++kk) {
        unsigned w0 = pack2(s[2 * kk][qt][0], s[2 * kk][qt][1]), w1 = pack2(s[2 * kk][qt][2], s[2 * kk][qt][3]);
        unsigned w2 = pack2(s[2 * kk + 1][qt][0], s[2 * kk + 1][qt][1]), w3 = pack2(s[2 * kk + 1][qt][2], s[2 * kk + 1][qt][3]);
        u32x4 u = MK4(w0, w1, w2, w3);
        pf[qt][kk] = __builtin_bit_cast(bf16x8, u);
      }
    const bf16_t* vb = Vl + cur * 64 * VSTR + (quad * 4 + (lr >> 2)) * VSTR + (lr & 3) * 4;
    {
      bf16x8 vfa[2][4];
#pragma unroll
      for (int kk = 0; kk < 2; ++kk)
#pragma unroll
        for (int dt = 0; dt < 4; ++dt) vfa[kk][dt] = cat8(tr_read(vb + (kk * 32) * VSTR + dt * 16), tr_read(vb + (kk * 32 + 16) * VSTR + dt * 16));
#pragma unroll
      for (int kk = 0; kk < 2; ++kk)
#pragma unroll
        for (int dt = 0; dt < 4; ++dt) {
          o[dt][0] = mfma16(vfa[kk][dt], pf[0][kk], o[dt][0]);
          o[dt][1] = mfma16(vfa[kk][dt], pf[1][kk], o[dt][1]);
        }
    }
    if (t + 1 < ntiles) {
      const int nx = cur ^ 1;
#pragma unroll
      for (int i = 0; i < NKL; ++i) { int c = tid + i * 256, r = c / KCH, ch = c % KCH; *(u32x4*)(Kl + nx * 64 * KSTR + r * KSTR + ch * 8) = rk[i]; }
#pragma unroll
      for (int i = 0; i < 2; ++i) { int c = tid + i * 256, r = c >> 3, ch = c & 7; *(u32x4*)(Vl + nx * 64 * VSTR + r * VSTR + ch * 8) = rv[i]; }
    }
    __syncthreads();
  }
}

__device__ __forceinline__ void attn_store(f32x4 (&o)[4][2], float (&m)[2], float (&l)[2], bool has_sink, float sink_l2, bf16_t* dst  , int ldo) {
  const int lane = otid() & 63, wave = otid() >> 6, lr = lane & 15, quad = lane >> 4;
#pragma unroll
  for (int qt = 0; qt < 2; ++qt) {
    float lt = l[qt]; lt += __shfl_xor(lt, 16); lt += __shfl_xor(lt, 32);
    if (has_sink) lt += exp2f(sink_l2 - m[qt]);
    float inv = 1.f / lt;
    bf16_t* rp = dst + (size_t)(wave * 32 + qt * 16 + lr) * ldo + quad * 4;
#pragma unroll
    for (int dt = 0; dt < 4; ++dt)
      *(u32x2*)(rp + dt * 16) = MK2(pack2(o[dt][qt][0] * inv, o[dt][qt][1] * inv), pack2(o[dt][qt][2] * inv, o[dt][qt][3] * inv));
  }
}

template <int NKS>
__device__ __forceinline__ void load_q(bf16x8 (&qf)[2][NKS], const bf16_t* q  , int ldq) {
  const int lane = otid() & 63, wave = otid() >> 6, lr = lane & 15, quad = lane >> 4;
#pragma unroll
  for (int qt = 0; qt < 2; ++qt)
#pragma unroll
    for (int ks = 0; ks < NKS; ++ks) qf[qt][ks] = *(const bf16x8*)(q + (size_t)(wave * 32 + qt * 16 + lr) * ldq + ks * 32 + quad * 8);
}

struct TileContig { const bf16_t* k; const bf16_t* v; size_t ks, vs;
  __device__ __forceinline__ KVT operator()(int t) const { return KVT{k + (size_t)t * ks, v + (size_t)t * vs}; } };
struct MaskScale { float sl2; __device__ __forceinline__ float operator()(int, int, int, float s) const { return s * sl2; } };

__device__ void mla_item(const Params& p, int b, int h, int qt128, bool ctxq, char* lds) {
  int r0 = ctxq ? NLAT + b * 256 + qt128 * 128 : b * 16384 + qt128 * 128;
  bf16x8 qf[2][3];
  load_q<3>(qf, p.Qm + (size_t)r0 * 384 + h * 96, 384);
  f32x4 o[4][2]; float m[2] = {-1e30f, -1e30f}, l[2] = {0.f, 0.f};
#pragma unroll
  for (int dt = 0; dt < 4; ++dt) { o[dt][0] = (f32x4){0.f, 0.f, 0.f, 0.f}; o[dt][1] = (f32x4){0.f, 0.f, 0.f, 0.f}; }
  int t0 = ctxq ? 256 : 0, nt = ctxq ? 4 : 260;
  size_t kbase = (size_t)(b * 4 + h) * 16640 + (size_t)t0 * 64;
  TileContig tf{p.Km + kbase * 96, p.Vm + kbase * 64, (size_t)64 * 96, (size_t)64 * 64};
  MaskScale mk{0.10206207261596575f * LOG2E};
  attn_core<96, true, true>(qf, nt, tf, 96, 64, mk, o, m, l, lds);
  attn_store(o, m, l, false, 0.f, p.ACT + (size_t)r0 * 1024 + h * 64, 1024);
}

struct NaTiles { const bf16_t* P; int b, h, lo, nw;
  __device__ __forceinline__ KVT operator()(int t) const {
    size_t row = t < nw ? (size_t)b * 16384 + (size_t)(lo + t) * 64 : (size_t)NLAT + b * 256 + (size_t)(t - nw) * 64;
    return KVT{P + row * PW + C_NK + h * 64, P + row * PW + C_NV + h * 64}; } };
struct NaMask { const float* rpb; int nw, lo, qr0; float sl2;
  __device__ __forceinline__ float operator()(int t, int qi, int kj, float s) const {
    if (t >= nw) return s * sl2;
    int qr = qr0 + (qi >> 6), qc = qi & 63, kr = lo + t;
    int r0q = min(max(qr - 4, 0), 248), c0 = min(max(qc - 8, 0), 48);
    bool ok = (kr >= r0q) & (kr < r0q + 8) & (kj >= c0) & (kj < c0 + 16);
    int dr = min(max(kr - qr + 7, 0), 14), dc = min(max(kj - qc, -15), 15) + 15;
    float bias = rpb[dr * 31 + dc];
    return ok ? s * sl2 + bias * LOG2E : -INFINITY; } };

__device__ void na_item(const Params& p, int l, int b, int h, int pair, char* lds) {
  float* rpbL = (float*)(lds + 60000);
  __syncthreads();
  for (int i = otid(); i < 465; i += 256) rpbL[i] = p.na_rpb[(size_t)(l * 4 + h) * 465 + i];
  int r0 = b * 16384 + pair * 128;
  bf16x8 qf[2][2];
  load_q<2>(qf, p.P + (size_t)r0 * PW + C_NQ + h * 64, PW);
  f32x4 o[4][2]; float m[2] = {-1e30f, -1e30f}, ls[2] = {0.f, 0.f};
#pragma unroll
  for (int dt = 0; dt < 4; ++dt) { o[dt][0] = (f32x4){0.f, 0.f, 0.f, 0.f}; o[dt][1] = (f32x4){0.f, 0.f, 0.f, 0.f}; }
  int qr0 = pair * 2;
  int lo = min(max(qr0 - 4, 0), 248), hi = min(max(qr0 + 1 - 4, 0), 248) + 7;
  int nw = hi - lo + 1;
  NaTiles tf{p.P, b, h, lo, nw};
  NaMask mk{rpbL, nw, lo, qr0, 0.125f * LOG2E};
  attn_core<64, true, false>(qf, nw + 4, tf, PW, PW, mk, o, m, ls, lds);
  attn_store(o, m, ls, false, 0.f, p.ACT + (size_t)r0 * 1024 + 512 + h * 64, 1024);
}

struct SwaTiles { const bf16_t* P; int b, kvh, nlo, nwt;
  __device__ __forceinline__ KVT operator()(int t) const {
    size_t row = t < nwt ? (size_t)b * 16384 + (size_t)(nlo * 128 + t * 64) : (size_t)NLAT + b * 256 + (size_t)(t - nwt) * 64;
    return KVT{P + row * PW + C_SK + kvh * 64, P + row * PW + C_SV + kvh * 64}; } };
struct SwaMask { int nwt, koff  ; float sl2;
  __device__ __forceinline__ float operator()(int t, int qi, int kj, float s) const {
    if (t >= nwt) return s * sl2;
    int delta = koff + t * 64 + kj - qi;
    return (delta <= 128 && delta >= -128) ? s * sl2 : -INFINITY; } };

__device__ void swa_item(const Params& p, int l, int b, int hq, int n, bool ctxq, char* lds) {
  int r0 = ctxq ? NLAT + b * 256 + n * 128 : b * 16384 + n * 128;
  bf16x8 qf[2][2];
  load_q<2>(qf, p.P + (size_t)r0 * PW + C_SQ + hq * 64, PW);
  f32x4 o[4][2]; float m[2] = {-1e30f, -1e30f}, ls[2] = {0.f, 0.f};
#pragma unroll
  for (int dt = 0; dt < 4; ++dt) { o[dt][0] = (f32x4){0.f, 0.f, 0.f, 0.f}; o[dt][1] = (f32x4){0.f, 0.f, 0.f, 0.f}; }
  int nlo = 0, nwt = 0;
  if (!ctxq) { nlo = max(n - 1, 0); int nhi = min(n + 1, 127); nwt = (nhi - nlo + 1) * 2; }
  SwaTiles tf{p.P, b, hq >> 1, nlo, nwt};
  SwaMask mk{nwt, (nlo - n) * 128, 0.125f * LOG2E};
  attn_core<64, true, false>(qf, nwt + 4, tf, PW, PW, mk, o, m, ls, lds);
  float sink = p.swa_sink[l * 4 + hq] * LOG2E;
  attn_store(o, m, ls, true, sink, p.ACT + (size_t)r0 * 1024 + 768 + hq * 64, 1024);
}

__device__ void na_ctx_item(const Params& p, int b, int h, int n, char* lds) {
  int r0 = NLAT + b * 256 + n * 128;
  bf16x8 qf[2][2];
  load_q<2>(qf, p.P + (size_t)r0 * PW + C_NQ + h * 64, PW);
  f32x4 o[4][2]; float m[2] = {-1e30f, -1e30f}, ls[2] = {0.f, 0.f};
#pragma unroll
  for (int dt = 0; dt < 4; ++dt) { o[dt][0] = (f32x4){0.f, 0.f, 0.f, 0.f}; o[dt][1] = (f32x4){0.f, 0.f, 0.f, 0.f}; }
  NaTiles tf{p.P, b, h, 0, 0};
  MaskScale mk{0.125f * LOG2E};
  attn_core<64, true, true>(qf, 4, tf, PW, PW, mk, o, m, ls, lds);
  attn_store(o, m, ls, false, 0.f, p.ACT + (size_t)r0 * 1024 + 512 + h * 64, 1024);
}

__device__ void ret_scan_item(const Params& p, int l, int combo, int part) {
  int dir = combo >> 3, b = (combo >> 2) & 1, h = combo & 3;
  float d = p.ret_decay[l * 8 + dir * 4 + h];
  float lg = -log1pf(__expf(-d)) * LOG2E;
  float gC = exp2f(lg * 128.f);
  int idx = part * 1024 + otid() * 4;
  f32x4 S = (f32x4){0.f, 0.f, 0.f, 0.f};
  const size_t dbase = ((size_t)dir * 260 * 4 + h) * 4096 + idx;
#pragma unroll 1
  for (int s0 = 0; s0 < 130; s0 += 13) {
    f32x4 kv[13]; int ch[13];
#pragma unroll
    for (int u = 0; u < 13; ++u) {
      int step = s0 + u;
      if (dir == 0) ch[u] = step < 2 ? 256 + 2 * b + step : b * 128 + (step - 2);
      else ch[u] = step < 2 ? 256 + 2 * b + 1 - step : b * 128 + 127 - (step - 2);
      kv[u] = *(const f32x4*)(p.Ksum + dbase + (size_t)ch[u] * 16384);
    }
#pragma unroll
    for (int u = 0; u < 13; ++u) {
      *(u32x2*)(p.St + dbase + (size_t)ch[u] * 16384) = MK2(pack2(S[0], S[1]), pack2(S[2], S[3]));
#pragma unroll
      for (int j = 0; j < 4; ++j) S[j] = S[j] * gC + kv[u][j];
    }
  }
}

struct RetMask { float lg; int dir;
  __device__ __forceinline__ float operator()(int t, int qi, int kj, float s) const {
    int j = t * 64 + kj; int df = dir == 0 ? qi - j : j - qi;
    return df >= 0 ? s * 0.125f * __builtin_amdgcn_exp2f(lg * (float)df) : 0.f; } };

__device__ void ret_out_item(const Params& p, int l, int c, int h, char* lds) {
  const int lane = otid() & 63, wave = otid() >> 6, lr = lane & 15, quad = lane >> 4;
  int r0 = c * 128;
  bf16x8 qf[2][2];
  load_q<2>(qf, p.P + (size_t)r0 * PW + C_RQ + h * 64, PW);
  f32x4 res[4][2];
#pragma unroll
  for (int dt = 0; dt < 4; ++dt) { res[dt][0] = (f32x4){0.f, 0.f, 0.f, 0.f}; res[dt][1] = (f32x4){0.f, 0.f, 0.f, 0.f}; }
  TileContig tf{p.P + (size_t)r0 * PW + C_RK + h * 64, p.P + (size_t)r0 * PW + C_RV + h * 64, (size_t)64 * PW, (size_t)64 * PW};
#pragma unroll 1
  for (int dir = 0; dir < 2; ++dir) {
    float d = p.ret_decay[l * 8 + dir * 4 + h];
    float lg = -log1pf(__expf(-d)) * LOG2E;
    f32x4 o[4][2]; float m[2] = {0.f, 0.f}, ls[2] = {0.f, 0.f};
#pragma unroll
    for (int dt = 0; dt < 4; ++dt) { o[dt][0] = (f32x4){0.f, 0.f, 0.f, 0.f}; o[dt][1] = (f32x4){0.f, 0.f, 0.f, 0.f}; }
    rsrc_t str = mkbuf(p.St + ((size_t)(dir * 260 + c) * 4 + h) * 4096);
#pragma unroll
    for (int ks = 0; ks < 2; ++ks)
#pragma unroll
      for (int et = 0; et < 4; ++et) {
        bf16x8 af = __builtin_bit_cast(bf16x8, bload16(str, (unsigned)(lr * 64 + quad * 8) * 2u, (unsigned)(et * 16 * 64 + ks * 32) * 2u));
        o[et][0] = mfma16(af, qf[0][ks], o[et][0]);
        o[et][1] = mfma16(af, qf[1][ks], o[et][1]);
      }
#pragma unroll
    for (int qt = 0; qt < 2; ++qt) {
      int i = wave * 32 + qt * 16 + lr;
      float qdec = exp2f(lg * (float)(dir == 0 ? i + 1 : 128 - i));
#pragma unroll
      for (int et = 0; et < 4; ++et)
#pragma unroll
        for (int j = 0; j < 4; ++j) o[et][qt][j] *= qdec;
    }
    __builtin_amdgcn_sched_barrier(0);
    RetMask mk{lg, dir};
    attn_core<64, false, false>(qf, 2, tf, PW, PW, mk, o, m, ls, lds);
    __builtin_amdgcn_sched_barrier(0);
#pragma unroll
    for (int qt = 0; qt < 2; ++qt) {
      int i = wave * 32 + qt * 16 + lr;
      float ss = 0.f;
#pragma unroll
      for (int et = 0; et < 4; ++et)
#pragma unroll
        for (int j = 0; j < 4; ++j) { float v = o[et][qt][j]; ss += v * v; }
      ss += __shfl_xor(ss, 16); ss += __shfl_xor(ss, 32);
      float rinv = rsqrtf(ss * (1.f / 64.f) + 1e-6f);
      rsrc_t gpr = mkbuf(p.P + (size_t)r0 * PW + (dir == 0 ? C_RGF : C_RGB) + h * 64);
      unsigned goff = (unsigned)(i * PW + quad * 4) * 2u;
#pragma unroll
      for (int et = 0; et < 4; ++et) {
        u32x2 gw = bload8(gpr, goff, et * 32);
        float g0 = lo_f(gw.x), g1 = hi_f(gw.x), g2 = lo_f(gw.y), g3 = hi_f(gw.y);
        res[et][qt][0] += o[et][qt][0] * rinv * silu_f(g0);
        res[et][qt][1] += o[et][qt][1] * rinv * silu_f(g1);
        res[et][qt][2] += o[et][qt][2] * rinv * silu_f(g2);
        res[et][qt][3] += o[et][qt][3] * rinv * silu_f(g3);
      }
    }
  }
#pragma unroll
  for (int qt = 0; qt < 2; ++qt) {
    bf16_t* rp = p.ACT + (size_t)(r0 + wave * 32 + qt * 16 + lr) * 1024 + 256 + h * 64 + quad * 4;
#pragma unroll
    for (int et = 0; et < 4; ++et)
      *(u32x2*)(rp + et * 16) = MK2(pack2(res[et][qt][0], res[et][qt][1]), pack2(res[et][qt][2], res[et][qt][3]));
  }
}


#define XB_TMO      128
#define XB_XCNT(j)  (256  + 64 * (j))
#define XB_XSUB(j)  (1280 + 64 * (j))
#define XB_XGEN(j)  (2304 + 64 * (j))
#define XB_TOP      3328
#define XB_TOPGEN   3392
#define XCD_BAR_WORDS 3456
#define XB_SPIN_CAP (1u << 20)
#define LAS __attribute__((address_space(3)))
__device__ __forceinline__ unsigned xb_ld(unsigned* p)              { return __hip_atomic_load(p, __ATOMIC_RELAXED, __HIP_MEMORY_SCOPE_AGENT); }
__device__ __forceinline__ unsigned xb_add(unsigned* p, unsigned v) { return __hip_atomic_fetch_add(p, v, __ATOMIC_RELAXED, __HIP_MEMORY_SCOPE_AGENT); }
__device__ __forceinline__ unsigned xb_xcc_id() { return (unsigned)__builtin_amdgcn_s_getreg((3 << 11) | 20) & 0xFu; }
#define XB_SPIN(cond, bar) do { unsigned _sp = 0; while (cond) { __builtin_amdgcn_s_sleep(1); \
    if ((++_sp & 255u) == 0u) { if (xb_ld(&(bar)[XB_TMO])) break; if (_sp > XB_SPIN_CAP) { atomicAdd(&(bar)[XB_TMO], 1u); break; } } } } while (0)
struct XcdBarrier { unsigned* bar; unsigned x; volatile LAS unsigned* st; };
__device__ __forceinline__ XcdBarrier xcd_barrier_post(unsigned* bar, volatile LAS unsigned* st) {
    XcdBarrier b; b.bar = bar; b.x = xb_xcc_id(); b.st = st;
    if (threadIdx.x == 0) (void)xb_add(&bar[XB_XCNT(b.x)], 1u);
    return b;
}
__device__ __forceinline__ void xcd_barrier_complete(unsigned* bar, unsigned x, unsigned& nloc, unsigned& nx) {
    const unsigned G = gridDim.x * gridDim.y * gridDim.z;
    unsigned sum, cnt, mine, sp = 0u;
    for (;;) {
        sum = 0u; cnt = 0u; mine = 0u;
#pragma unroll
        for (unsigned j = 0; j < 16; ++j) { const unsigned c = xb_ld(&bar[XB_XCNT(j)]); sum += c; cnt += (c > 0u) ? 1u : 0u; mine = (j == x) ? c : mine; }
        if (sum == G) break;
        __builtin_amdgcn_s_sleep(1);
        if ((++sp & 255u) == 0u) { if (xb_ld(&bar[XB_TMO])) break; if (sp > XB_SPIN_CAP) { atomicAdd(&bar[XB_TMO], 1u); break; } }
    }
    nloc = mine > 0u ? mine : 1u; nx = cnt > 0u ? cnt : 1u;
}
__device__ __forceinline__ void xcd_barrier(const XcdBarrier& b) {
    asm volatile("s_waitcnt vmcnt(0)" ::: "memory");
    __syncthreads();
    if (threadIdx.x == 0) {
        unsigned* bar = b.bar;
        __builtin_amdgcn_s_waitcnt(0);
        unsigned nloc = b.st[0], nx = b.st[1];
        if (nloc == 0u) { xcd_barrier_complete(bar, b.x, nloc, nx); b.st[0] = nloc; b.st[1] = nx; }
        const unsigned old = xb_add(&bar[XB_XSUB(b.x)], 1u);
        const unsigned gen = old / nloc;
        if (old + 1u == (gen + 1u) * nloc) {
            __builtin_amdgcn_fence(__ATOMIC_RELEASE, "agent");
            asm volatile("s_waitcnt vmcnt(0)" ::: "memory");
            const unsigned og = xb_add(&bar[XB_TOP], 1u);
            const unsigned tg = og / nx;
            if (og + 1u == (tg + 1u) * nx) xb_add(&bar[XB_TOPGEN], 1u);
            else XB_SPIN(xb_ld(&bar[XB_TOPGEN]) == tg, bar);
            __builtin_amdgcn_fence(__ATOMIC_ACQUIRE, "agent");
            xb_add(&bar[XB_XGEN(b.x)], 1u);
            asm volatile("s_waitcnt vmcnt(0)" ::: "memory");
        } else {
            XB_SPIN(xb_ld(&bar[XB_XGEN(b.x)]) == gen, bar);
            __builtin_amdgcn_fence(__ATOMIC_ACQUIRE, "agent");
            asm volatile("s_waitcnt vmcnt(0)" ::: "memory");
        }
    }
    __syncthreads();
}

__device__ void run_phase(const Params& p, int ph, int bid, int nb, char* lds) {
#ifndef CM
#define CM 0xff
#endif
#ifndef PH_MASK
#define PH_MASK 0xfffff
#endif
  if (ph == 0) { if (PH_MASK & (1<<9)) prologue_phase(p, bid, nb, lds); return; }
  if (ph == 37) { if (PH_MASK & (1<<10)) final_norm_phase(p, bid, nb); return; }
  const int l = (ph - 1) / 9, sp = (ph - 1) % 9;
  const bf16_t* W = p.W + (size_t)l * W_LAYER;
  if (!((PH_MASK >> sp) & 1)) return;
  switch (sp) {
    case 0: norm_phase(p, l, 0, bid, nb); break;
    case 1: {
      EpiWin epi{p.P};
      for (int rd = 0;; ++rd) { int t = xcd_tile(rd, bid, nb); if (t >= 260 * 24) break; int pm, pn; tile_coord(t, 24, pm, pn); gemm_tile(p.ACT, 1024, W + WO_IN, 1024, 1024, pm * 128, pn * 128, epi, lds); }
    } break;
    case 2: {
      EpiUq eq{&p}; EpiUkv ekv{&p};
      const int n0 = 260 * 4, n1 = n0 + 260 * 4, n2 = n1 + 260 * 3, n3 = n2 + 256;
      for (int t = bid; t < n3; t += nb) {
        if (t < n0) ret_prep_item(p, l, t >> 2, t & 3, lds);
        else if (t < n1) { int u = t - n0, pm = u >> 2, h = u & 3; gemm_tile(p.P + C_CKV, PW, W + WO_UKV, 128, 128, pm * 128, h * 128, ekv, lds); mla_krope_item(p, pm * 128, h); }
        else if (t < n2) { int u = t - n1, pm = u / 3, pn = u % 3; gemm_tile(p.P + C_CQ, PW, W + WO_UQ, 256, 256, pm * 128, pn * 128, eq, lds); }
        else swa_rope_item(p, t - n2);
      }
    } break;
    case 3: {
      int* slot = (int*)(lds + LDS_BYTES - 16);
      if (bid < 64) { if (CM & 2) ret_scan_item(p, l, bid >> 2, bid & 3); }
      const int x = bid & 7;
      for (int pass = 0; pass < 8; ++pass) {
        const int cmb = (x + pass) & 7;
        for (;;) {
          __syncthreads();
          if (otid() == 0) *slot = (int)atomicAdd(p.bar + 8 + l * 8 + cmb, 1u);
          __syncthreads();
          const int q = *slot;
          if (q >= 128) break;
          if (CM & 1) mla_item(p, cmb >> 2, cmb & 3, q, false, lds);
        }
      }
      const int n1 = 1024, n2 = n1 + 1024, n3 = n2 + 16, n4 = n3 + 16, n5 = n4 + 16;
      for (;;) {
        __syncthreads();
        if (otid() == 0) *slot = (int)atomicAdd(p.bar + l, 1u);
        __syncthreads();
        const int t = *slot;
        if (t >= n5) break;
        if (t < n1) { int u = t; if (CM & 4) na_item(p, l, u >> 9, (u >> 7) & 3, u & 127, lds); }
        else if (t < n2) { int u = t - n1; if (CM & 16) swa_item(p, l, u >> 9, (u >> 7) & 3, u & 127, false, lds); }
        else if (t < n3) { int u = t - n2; if (CM & 1) mla_item(p, u >> 3, (u >> 1) & 3, u & 1, true, lds); }
        else if (t < n4) { int u = t - n3; if (CM & 8) na_ctx_item(p, u >> 3, (u >> 1) & 3, u & 1, lds); }
        else { int u = t - n4; if (CM & 16) swa_item(p, l, u >> 3, (u >> 1) & 3, u & 1, true, lds); }
      }
    } break;
    case 4: for (int t = bid; t < 260 * 4; t += nb) ret_out_item(p, l, t >> 2, t & 3, lds); break;
    case 5: {
      EpiResid epi{&p, l, 2048, 1};
      for (int rd = 0;; ++rd) { int t = xcd_tile(rd, bid, nb); if (t >= 260 * 8) break; int pm, pn; tile_coord(t, 8, pm, pn); gemm_tile(p.ACT, 1024, W + WO_OUT, 1024, 1024, pm * 128, pn * 128, epi, lds); }
    } break;
    case 6: norm_phase(p, l, 1, bid, nb); break;
    case 7: {
      EpiFfn1 epi{p.P};
      for (int rd = 0;; ++rd) { int t = xcd_tile(rd, bid, nb); if (t >= 260 * 44) break; int pm, pn; tile_coord(t, 44, pm, pn); gemm_tile(p.ACT, 1024, W + WO_13, 1024, 1024, pm * 128, pn * 128, epi, lds); }
    } break;
    case 8: {
      EpiResid epi{&p, l, 5120, 0};
      for (int rd = 0;; ++rd) { int t = xcd_tile(rd, bid, nb); if (t >= 260 * 8) break; int pm, pn; tile_coord(t, 8, pm, pn); gemm_tile(p.P, 2816, W + WO_2, 2816, 2816, pm * 128, pn * 128, epi, lds); }
    } break;
  }
}

__global__ void __launch_bounds__(256, 2) mega_kernel(Params p, int ph_lo, int ph_hi) {
  __shared__ __attribute__((aligned(16))) char lds[LDS_BYTES];
  __shared__ u32x4 xb_words;
#ifndef REP_MASK
#define REP_MASK 0
#endif
  if (ph_lo < 0) cg::this_grid().sync();
  if (threadIdx.x == 0) xb_words = (u32x4){0u, 0u, 0u, 0u};
  __syncthreads();
  XcdBarrier xb; xb.bar = p.bar; xb.x = 0; xb.st = (volatile LAS unsigned*)&xb_words;
  if (ph_hi - ph_lo > 1) xb = xcd_barrier_post(p.bar, (volatile LAS unsigned*)&xb_words);
  for (int ph = ph_lo; ph < ph_hi; ++ph) {
    const int reps = (REP_MASK && ph >= 1 && ph <= 36 && ((REP_MASK >> ((ph - 1) % 9)) & 1)) ? 2 : 1;
    for (int r = 0; r < reps; ++r) {
      run_phase(p, ph, blockIdx.x, gridDim.x, lds);
      if (r + 1 < reps || ph + 1 < ph_hi) xcd_barrier(xb);
#ifdef EXTRA_SYNC
      for (int e = 0; e < EXTRA_SYNC; ++e) xcd_barrier(xb);
#endif
    }
  }
}

extern "C" void kernel_launch(void* const* d_in, const int* in_sizes, int n_in, void* d_out, int out_size, void* d_ws, size_t ws_size,
                              hipStream_t stream) {
  Params p{};
  const float** f = (const float**)&p;
  for (int i = 0; i < 21; ++i) f[i] = (const float*)d_in[i];
  p.out = (float*)d_out;
  char* w = (char*)d_ws; size_t off = 0;
  auto take = [&](size_t bytes) { char* r = w + off; off += (bytes + 255) & ~(size_t)255; return r; };
  p.Y = (float*)take((size_t)512 * 1024 * 4);
  p.ACT = (bf16_t*)take((size_t)NROWS * 1024 * 2);
  p.P = (bf16_t*)take((size_t)NROWS * PW * 2);
  p.Qm = (bf16_t*)take((size_t)NROWS * 384 * 2);
  p.Km = (bf16_t*)take((size_t)8 * 16640 * 96 * 2);
  p.Vm = (bf16_t*)take((size_t)8 * 16640 * 64 * 2);
  p.Ksum = (float*)take((size_t)2 * 260 * 4 * 4096 * 4);
  p.St = (bf16_t*)take((size_t)2 * 260 * 4 * 4096 * 2);
  p.W = (bf16_t*)take((size_t)4 * W_LAYER * 2);
  p.mod = (float*)take((size_t)4 * 3 * 6144 * 4);
  p.rope64 = (float*)take(256 * 16 * 2 * 4);
  p.rope32 = (float*)take(256 * 8 * 2 * 4);
  p.bar = (unsigned*)take(XCD_BAR_WORDS * 4);
  if (off > ws_size) { fprintf(stderr, "workspace too small: need %zu have %zu\n", off, ws_size); return; }
#if MULTI_LAUNCH
  for (int ph = 0; ph < 38; ++ph) hipLaunchKernelGGL(mega_kernel, dim3(512), dim3(256), 0, stream, p, ph, ph + 1);
#else
  static int grid_blocks = 0;
  if (!grid_blocks) {
    int dev = 0, cus = 0, per_cu = 0;
    hipGetDevice(&dev);
    hipDeviceGetAttribute(&cus, hipDeviceAttributeMultiprocessorCount, dev);
    hipOccupancyMaxActiveBlocksPerMultiprocessor(&per_cu, mega_kernel, 256, 0);
    if (per_cu > 2) per_cu = 2;
    grid_blocks = cus * per_cu;
  }
  hipMemsetAsync(p.bar, 0, XCD_BAR_WORDS * 4, stream);
  int lo = 0, hi = 38;
  void* args[] = {&p, &lo, &hi};
  hipError_t e = hipLaunchCooperativeKernel((void*)mega_kernel, dim3(grid_blocks), dim3(256), args, 0, stream);
  if (e != hipSuccess) fprintf(stderr, "cooperative launch failed: %s (grid %d)\n", hipGetErrorString(e), grid_blocks);
#endif
}
```

```cpp
#include <hip/hip_runtime.h>
#include <hip/hip_cooperative_groups.h>
#include <cstdio>
#include <cstdint>
namespace cg = cooperative_groups;

#ifndef MULTI_LAUNCH
#define MULTI_LAUNCH 0
#endif

typedef unsigned short bf16_t;
typedef short bf16x8 __attribute__((ext_vector_type(8)));
typedef short s16x4 __attribute__((ext_vector_type(4)));
typedef float f32x4 __attribute__((ext_vector_type(4)));
typedef float f32x2 __attribute__((ext_vector_type(2)));
typedef __bf16 bf2_t __attribute__((ext_vector_type(2)));
typedef unsigned u32x4 __attribute__((ext_vector_type(4)));
typedef unsigned u32x2 __attribute__((ext_vector_type(2)));
#define MK4(a,b,c,d) ((u32x4){(a),(b),(c),(d)})
#define MK2(a,b) ((u32x2){(a),(b)})

#define NROWS 33280
#define NLAT 32768
#define PW 3072
#define LOG2E 1.4426950408889634f
#define LDS_BYTES 73728

#define C_CQ 0
#define C_CKV 256
#define C_KR 384
#define C_RQ 416
#define C_RK 672
#define C_RV 928
#define C_RGF 1184
#define C_RGB 1440
#define C_NQ 1696
#define C_NK 1952
#define C_NV 2208
#define C_SQ 2464
#define C_SK 2720
#define C_SV 2848

#define WO_IN 0
#define WO_UQ 3145728
#define WO_UKV 3244032
#define WO_OUT 3309568
#define WO_13 4358144
#define WO_2 10125312
#define W_LAYER 13008896

struct Params {
  const float *x, *c, *ctx, *c_ctx, *ada_w, *ada_b, *norm1_g, *w_in, *mla_q_norm, *mla_w_uq, *mla_kv_norm, *mla_w_ukv,
      *ret_decay, *na_rpb, *swa_sink, *w_out, *norm2_g, *ffn_w1, *ffn_w3, *ffn_w2, *final_g;
  float* out;
  float* Y;
  bf16_t* ACT;
  bf16_t* P;
  bf16_t *Qm, *Km, *Vm;
  float* Ksum;
  bf16_t* St;
  bf16_t* W;
  float* mod;
  float* rope64;
  float* rope32;
  unsigned* bar;
};

__device__ __forceinline__ int otid() { int t = threadIdx.x; asm volatile("" : "+v"(t)); return t; }
typedef __amdgpu_buffer_rsrc_t rsrc_t;
__device__ __forceinline__ rsrc_t mkbuf(const void* base) { return __builtin_amdgcn_make_buffer_rsrc((void*)base, 0, 0x7fffffff, 0x00020000); }
__device__ __forceinline__ u32x4 bload16(rsrc_t r, unsigned voff, unsigned soff) { return __builtin_amdgcn_raw_buffer_load_b128(r, voff, soff, 0); }
__device__ __forceinline__ u32x2 bload8(rsrc_t r, unsigned voff, unsigned soff) { return __builtin_amdgcn_raw_buffer_load_b64(r, voff, soff, 0); }
__device__ __forceinline__ float bf2f(bf16_t h) { return __uint_as_float(((unsigned)h) << 16); }
__device__ __forceinline__ unsigned pack2(float a, float b) { f32x2 v = {a, b}; bf2_t r = __builtin_convertvector(v, bf2_t); return __builtin_bit_cast(unsigned, r); }
__device__ __forceinline__ bf16_t f2bf(float a) { return (bf16_t)(pack2(a, 0.f) & 0xffffu); }
__device__ __forceinline__ float lo_f(unsigned u) { return __uint_as_float(u << 16); }
__device__ __forceinline__ float hi_f(unsigned u) { return __uint_as_float(u & 0xffff0000u); }
__device__ __forceinline__ f32x4 mfma16(bf16x8 a, bf16x8 b, f32x4 c) { return __builtin_amdgcn_mfma_f32_16x16x32_bf16(a, b, c, 0, 0, 0); }
typedef __attribute__((address_space(3))) s16x4 lds_s16x4;
__device__ __forceinline__ s16x4 tr_read(const bf16_t* p) { return __builtin_amdgcn_ds_read_tr16_b64_v4i16((lds_s16x4*)p); }
__device__ __forceinline__ bf16x8 cat8(s16x4 a, s16x4 b) { bf16x8 r; r[0]=a[0]; r[1]=a[1]; r[2]=a[2]; r[3]=a[3]; r[4]=b[0]; r[5]=b[1]; r[6]=b[2]; r[7]=b[3]; return r; }
__device__ __forceinline__ float wave_sum(float v) {
  v += __shfl_xor(v, 32); v += __shfl_xor(v, 16); v += __shfl_xor(v, 8); v += __shfl_xor(v, 4); v += __shfl_xor(v, 2); v += __shfl_xor(v, 1); return v;
}
__device__ __forceinline__ float silu_f(float a) { return a * __builtin_amdgcn_rcpf(1.f + __expf(-a)); }

__device__ __forceinline__ float* xrow(const Params& p, int row) { return row < NLAT ? p.out + (size_t)row * 1024 : p.Y + (size_t)(row - NLAT) * 1024; }
__device__ __forceinline__ const float* xsrc(const Params& p, int l, int row) {
  if (l == 0) return row < NLAT ? p.x + (size_t)row * 1024 : p.ctx + (size_t)(row - NLAT) * 1024;
  return xrow(p, row);
}
__device__ __forceinline__ int modv(int row) { return row < 16384 ? 0 : (row < NLAT ? 1 : 2); }

__device__ void transpose_tile(const float* __restrict__ src, int N, int k0, int n0, bf16_t* __restrict__ dst, int ldd, int mode,
                               const float* __restrict__ kscale, char* lds) {
  bf16_t(*t)[66] = (bf16_t(*)[66])lds;
  const int tid = otid();
  __syncthreads();
#pragma unroll 4
  for (int i = 0; i < 16; ++i) {
    int kk = i * 4 + (tid >> 6), nn = tid & 63;
    float v = (n0 + nn < N) ? src[(size_t)(k0 + kk) * N + n0 + nn] : 0.f;
    if (kscale) v *= kscale[k0 + kk];
    t[kk][nn] = f2bf(v);
  }
  __syncthreads();
  int nn = tid >> 2, kq = tid & 3;
  int n = n0 + nn;
  if (n < N) {
    int row = mode == 0 ? n : ((n >> 4) * 32 + (n & 15) + (mode == 2 ? 16 : 0));
    unsigned w[8];
#pragma unroll
    for (int e = 0; e < 8; ++e) w[e] = (unsigned)t[kq * 16 + 2 * e][nn] | ((unsigned)t[kq * 16 + 2 * e + 1][nn] << 16);
    u32x4* d = (u32x4*)(dst + (size_t)row * ldd + k0 + kq * 16);
    d[0] = MK4(w[0], w[1], w[2], w[3]);
    d[1] = MK4(w[4], w[5], w[6], w[7]);
  }
}

__device__ void prologue_phase(const Params& p, int bid, int nb, char* lds) {
  const int tid = otid();
  for (int it = bid; it < 4 * 3160; it += nb) {
    int l = it / 3160, r = it % 3160;
    bf16_t* W = p.W + (size_t)l * W_LAYER;
    if (r < 752) { int kt = r / 47, nt = r % 47; transpose_tile(p.w_in + (size_t)l * 1024 * 2976, 2976, kt * 64, nt * 64, W + WO_IN, 1024, 0, nullptr, lds); continue; }
    r -= 752;
    if (r < 24) { int kt = r / 6, nt = r % 6; transpose_tile(p.mla_w_uq + (size_t)l * 256 * 384, 384, kt * 64, nt * 64, W + WO_UQ, 256, 0, p.mla_q_norm + l * 256, lds); continue; }
    r -= 24;
    if (r < 16) { int kt = r / 8, nt = r % 8; transpose_tile(p.mla_w_ukv + (size_t)l * 128 * 512, 512, kt * 64, nt * 64, W + WO_UKV, 128, 0, p.mla_kv_norm + l * 128, lds); continue; }
    r -= 16;
    if (r < 256) { int kt = r / 16, nt = r % 16; transpose_tile(p.w_out + (size_t)l * 1024 * 1024, 1024, kt * 64, nt * 64, W + WO_OUT, 1024, 0, nullptr, lds); continue; }
    r -= 256;
    if (r < 704) { int kt = r / 44, nt = r % 44; transpose_tile(p.ffn_w1 + (size_t)l * 1024 * 2816, 2816, kt * 64, nt * 64, W + WO_13, 1024, 1, nullptr, lds); continue; }
    r -= 704;
    if (r < 704) { int kt = r / 44, nt = r % 44; transpose_tile(p.ffn_w3 + (size_t)l * 1024 * 2816, 2816, kt * 64, nt * 64, W + WO_13, 1024, 2, nullptr, lds); continue; }
    r -= 704;
    { int kt = r / 16, nt = r % 16; transpose_tile(p.ffn_w2 + (size_t)l * 2816 * 1024, 1024, kt * 64, nt * 64, W + WO_2, 2816, 0, nullptr, lds); }
  }
  for (int it = bid; it < 4 * 48; it += nb) {
    int l = it / 48, part = it % 48;
    u32x4* d = (u32x4*)(p.W + (size_t)l * W_LAYER + WO_IN + (size_t)2976 * 1024);
    d[part * 256 + tid] = MK4(0, 0, 0, 0);
  }
  for (int it = bid; it < 4 * 96; it += nb) {
    int l = it / 96, cb = it % 96;
    float* s = (float*)lds;
    float* red = s + 3 * 1024;
    __syncthreads();
    for (int i = tid; i < 3072; i += 256) {
      int v = i >> 10, k = i & 1023;
      float cv = v < 2 ? p.c[v * 1024 + k] : p.c_ctx[k];
      s[i] = silu_f(cv);
    }
    __syncthreads();
    int col = cb * 64 + (tid & 63), kp = tid >> 6;
    const float* w = p.ada_w + (size_t)l * 1024 * 6144 + (size_t)(kp * 256) * 6144 + col;
    float a0 = 0.f, a1 = 0.f, a2 = 0.f;
#pragma unroll 8
    for (int k = 0; k < 256; ++k) {
      float wv = w[(size_t)k * 6144];
      a0 += s[kp * 256 + k] * wv; a1 += s[1024 + kp * 256 + k] * wv; a2 += s[2048 + kp * 256 + k] * wv;
    }
    red[(kp * 3 + 0) * 64 + (tid & 63)] = a0; red[(kp * 3 + 1) * 64 + (tid & 63)] = a1; red[(kp * 3 + 2) * 64 + (tid & 63)] = a2;
    __syncthreads();
    if (tid < 192) {
      int v = tid >> 6, cc = tid & 63;
      float sum = red[(0 * 3 + v) * 64 + cc] + red[(1 * 3 + v) * 64 + cc] + red[(2 * 3 + v) * 64 + cc] + red[(3 * 3 + v) * 64 + cc];
      p.mod[(size_t)(l * 3 + v) * 6144 + cb * 64 + cc] = sum + p.ada_b[l * 6144 + cb * 64 + cc];
    }
  }
  if (bid == (nb > 1 ? 1 : 0)) {
    int pos = tid;
    for (int i = 0; i < 16; ++i) {
      float inv = exp2f(-(float)(2 * i) / 32.f * 13.287712379549449f);
      float ang = (float)pos * inv;
      float n = rintf(ang * 0.15915494309189535f);
      float r = fmaf(-n, 6.28318548202514648f, ang); r = fmaf(-n, -1.74845553146951715e-07f, r);
      p.rope64[(pos * 16 + i) * 2] = cosf(r); p.rope64[(pos * 16 + i) * 2 + 1] = sinf(r);
    }
    for (int i = 0; i < 8; ++i) {
      float inv = exp2f(-(float)(2 * i) / 16.f * 13.287712379549449f);
      float ang = (float)pos * inv;
      float n = rintf(ang * 0.15915494309189535f);
      float r = fmaf(-n, 6.28318548202514648f, ang); r = fmaf(-n, -1.74845553146951715e-07f, r);
      p.rope32[(pos * 8 + i) * 2] = cosf(r); p.rope32[(pos * 8 + i) * 2 + 1] = sinf(r);
    }
  }
}

__device__ void norm_phase(const Params& p, int l, int which, int bid, int nb) {
  const int wave = otid() >> 6, lane = otid() & 63;
  const float* g = (which == 0 ? p.norm1_g : p.norm2_g) + l * 1024;
  for (int row = bid * 4 + wave; row < NROWS; row += nb * 4) {
    const float* src = which == 0 ? xsrc(p, l, row) : xrow(p, row);
    const float* md = p.mod + (size_t)(l * 3 + modv(row)) * 6144 + which * 3072;
    f32x4 v[4]; float ss = 0.f;
#pragma unroll
    for (int i = 0; i < 4; ++i) { v[i] = *(const f32x4*)(src + i * 256 + lane * 4); ss += v[i][0] * v[i][0] + v[i][1] * v[i][1] + v[i][2] * v[i][2] + v[i][3] * v[i][3]; }
    ss = wave_sum(ss);
    float rinv = rsqrtf(ss * (1.f / 1024.f) + 1e-6f);
#pragma unroll
    for (int i = 0; i < 4; ++i) {
      int col = i * 256 + lane * 4;
      f32x4 g4 = *(const f32x4*)(g + col), sh = *(const f32x4*)(md + col), sc = *(const f32x4*)(md + 1024 + col);
      f32x4 y;
#pragma unroll
      for (int j = 0; j < 4; ++j) y[j] = (v[i][j] * rinv * g4[j]) * (1.f + sc[j]) + sh[j];
      *(u32x2*)(p.ACT + (size_t)row * 1024 + col) = MK2(pack2(y[0], y[1]), pack2(y[2], y[3]));
    }
  }
}

__device__ void final_norm_phase(const Params& p, int bid, int nb) {
  const int wave = otid() >> 6, lane = otid() & 63;
  for (int row = bid * 4 + wave; row < NLAT; row += nb * 4) {
    float* src = p.out + (size_t)row * 1024;
    f32x4 v[4]; float ss = 0.f;
#pragma unroll
    for (int i = 0; i < 4; ++i) { v[i] = *(const f32x4*)(src + i * 256 + lane * 4); ss += v[i][0] * v[i][0] + v[i][1] * v[i][1] + v[i][2] * v[i][2] + v[i][3] * v[i][3]; }
    ss = wave_sum(ss);
    float rinv = rsqrtf(ss * (1.f / 1024.f) + 1e-6f);
#pragma unroll
    for (int i = 0; i < 4; ++i) {
      int col = i * 256 + lane * 4;
      f32x4 g4 = *(const f32x4*)(p.final_g + col);
      f32x4 y;
#pragma unroll
      for (int j = 0; j < 4; ++j) y[j] = v[i][j] * rinv * g4[j];
      *(f32x4*)(src + col) = y;
    }
  }
}

#define GSTR 64
template <class Epi>
__device__ __forceinline__ void gemm_tile(const bf16_t* __restrict__ A, int lda, const bf16_t* __restrict__ Bt, int ldb, int K, int m0, int n0,
                                          const Epi& epi, char* lds) {
  bf16_t* As = (bf16_t*)lds;
  bf16_t* Bs = As + 2 * 128 * GSTR;
  const int tid = otid(), wave = tid >> 6, lane = tid & 63, wm = wave >> 1, wn = wave & 1, lr = lane & 15, quad = lane >> 4;
  const int lrow = tid >> 3, lch = tid & 7, wch = lch ^ (lrow & 7);
  rsrc_t gar = mkbuf(A + (size_t)m0 * lda), gbr = mkbuf(Bt + (size_t)n0 * ldb);
  unsigned aoff[4], boff[4];
#pragma unroll
  for (int i = 0; i < 4; ++i) { aoff[i] = (unsigned)((lrow + 32 * i) * lda + lch * 8) * 2u; boff[i] = (unsigned)((lrow + 32 * i) * ldb + lch * 8) * 2u; }
  u32x4 ra0[4], rb0[4], ra1[4], rb1[4];
  f32x4 acc[4][4];
#pragma unroll
  for (int i = 0; i < 4; ++i)
#pragma unroll
    for (int j = 0; j < 4; ++j) acc[i][j] = (f32x4){0.f, 0.f, 0.f, 0.f};
  const int nk = K >> 6;
#pragma unroll
  for (int i = 0; i < 4; ++i) { ra0[i] = bload16(gar, aoff[i], 0); rb0[i] = bload16(gbr, boff[i], 0); }
#pragma unroll
  for (int i = 0; i < 4; ++i) { ra1[i] = bload16(gar, aoff[i], 128u); rb1[i] = bload16(gbr, boff[i], 128u); }
  __syncthreads();
#pragma unroll
  for (int i = 0; i < 4; ++i) { *(u32x4*)(As + (lrow + 32 * i) * GSTR + wch * 8) = ra0[i]; *(u32x4*)(Bs + (lrow + 32 * i) * GSTR + wch * 8) = rb0[i]; }
  __syncthreads();
  const int rsw = (quad ^ (lr & 7)) * 8;
  const bf16_t* as0 = As + (wm * 64 + lr) * GSTR;
  const bf16_t* bs0 = Bs + (wn * 64 + lr) * GSTR;
#define GEMM_COMPUTE(BUF)                                                                                         \
  {                                                                                                               \
    const bf16_t* as = as0 + (BUF) * 128 * GSTR;                                                                  \
    const bf16_t* bs = bs0 + (BUF) * 128 * GSTR;                                                                  \
    _Pragma("unroll") for (int ks = 0; ks < 2; ++ks) {                                                            \
      bf16x8 af[4], bfr[4];                                                                                       \
      _Pragma("unroll") for (int i = 0; i < 4; ++i) {                                                             \
        af[i] = *(const bf16x8*)(as + i * 16 * GSTR + (rsw ^ (ks * 32)));                                         \
        bfr[i] = *(const bf16x8*)(bs + i * 16 * GSTR + (rsw ^ (ks * 32)));                                        \
      }                                                                                                           \
      _Pragma("unroll") for (int mi = 0; mi < 4; ++mi)                                                            \
        _Pragma("unroll") for (int ni = 0; ni < 4; ++ni) acc[mi][ni] = mfma16(bfr[ni], af[mi], acc[mi][ni]);      \
    }                                                                                                             \
  }
  for (int kt = 0; kt < nk; kt += 2) {
    if (kt + 2 < nk) {
      const unsigned so = (unsigned)(kt + 2) * 128u;
#pragma unroll
      for (int i = 0; i < 4; ++i) { ra0[i] = bload16(gar, aoff[i], so); rb0[i] = bload16(gbr, boff[i], so); }
    }
    GEMM_COMPUTE(0)
#pragma unroll
    for (int i = 0; i < 4; ++i) { *(u32x4*)(As + 128 * GSTR + (lrow + 32 * i) * GSTR + wch * 8) = ra1[i]; *(u32x4*)(Bs + 128 * GSTR + (lrow + 32 * i) * GSTR + wch * 8) = rb1[i]; }
    __syncthreads();
    if (kt + 3 < nk) {
      const unsigned so = (unsigned)(kt + 3) * 128u;
#pragma unroll
      for (int i = 0; i < 4; ++i) { ra1[i] = bload16(gar, aoff[i], so); rb1[i] = bload16(gbr, boff[i], so); }
    }
    GEMM_COMPUTE(1)
    if (kt + 2 < nk) {
#pragma unroll
      for (int i = 0; i < 4; ++i) { *(u32x4*)(As + (lrow + 32 * i) * GSTR + wch * 8) = ra0[i]; *(u32x4*)(Bs + (lrow + 32 * i) * GSTR + wch * 8) = rb0[i]; }
    }
    __syncthreads();
  }
#undef GEMM_COMPUTE
  epi(acc, m0 + wm * 64, n0 + wn * 64, lr, quad);
}

__device__ __forceinline__ void tile_coord(int t, int nN, int& pm, int& pn) {
  const int nM = 260, GM = 8;
  int gsz = GM * nN; int g = t / gsz, r = t % gsz; int fm = g * GM; int gm = min(GM, nM - fm);
  pm = fm + (r % gm); pn = r / gm;
}
__device__ __forceinline__ int xcd_tile(int round, int bid, int nb) { return round * nb + (bid & 7) * (nb >> 3) + (bid >> 3); }

struct EpiWin {
  bf16_t* P;
  __device__ __forceinline__ void operator()(f32x4 (&acc)[4][4], int mb, int nbs, int lr, int quad) const {
#pragma unroll
    for (int mi = 0; mi < 4; ++mi) {
      bf16_t* rp = P + (size_t)(mb + mi * 16 + lr) * PW + nbs + quad * 4;
#pragma unroll
      for (int ni = 0; ni < 4; ++ni) *(u32x2*)(rp + ni * 16) = MK2(pack2(acc[mi][ni][0], acc[mi][ni][1]), pack2(acc[mi][ni][2], acc[mi][ni][3]));
    }
  }
};

struct EpiResid {
  const Params* p; int l; int goff; int use_src;
  __device__ __forceinline__ void operator()(f32x4 (&acc)[4][4], int mb, int nbs, int lr, int quad) const {
#pragma unroll
    for (int mi = 0; mi < 4; ++mi) {
      int row = mb + mi * 16 + lr;
      const float* gate = p->mod + (size_t)(l * 3 + modv(row)) * 6144 + goff;
      const float* src = use_src ? xsrc(*p, l, row) : xrow(*p, row);
      float* dst = xrow(*p, row);
#pragma unroll
      for (int ni = 0; ni < 4; ++ni) {
        int col = nbs + ni * 16 + quad * 4;
        f32x4 g4 = *(const f32x4*)(gate + col), x4 = *(const f32x4*)(src + col);
#pragma unroll
        for (int j = 0; j < 4; ++j) x4[j] += g4[j] * acc[mi][ni][j];
        *(f32x4*)(dst + col) = x4;
      }
    }
  }
};

struct EpiFfn1 {
  bf16_t* U;
  __device__ __forceinline__ void operator()(f32x4 (&acc)[4][4], int mb, int nbs, int lr, int quad) const {
#pragma unroll
    for (int mi = 0; mi < 4; ++mi) {
      int row = mb + mi * 16 + lr;
#pragma unroll
      for (int pr = 0; pr < 2; ++pr) {
        int ucol = ((nbs + pr * 32) >> 5) * 16 + quad * 4;
        float u[4];
#pragma unroll
        for (int j = 0; j < 4; ++j) u[j] = silu_f(acc[mi][2 * pr][j]) * acc[mi][2 * pr + 1][j];
        *(u32x2*)(U + (size_t)row * 2816 + ucol) = MK2(pack2(u[0], u[1]), pack2(u[2], u[3]));
      }
    }
  }
};

struct EpiUq {
  const Params* p;
  __device__ __forceinline__ void operator()(f32x4 (&acc)[4][4], int mb, int nbs, int lr, int quad) const {
#pragma unroll
    for (int mi = 0; mi < 4; ++mi) {
      int row = mb + mi * 16 + lr;
      const bf16_t* cq = p->P + (size_t)row * PW + C_CQ + quad * 64;
      float ss = 0.f;
#pragma unroll
      for (int i = 0; i < 8; ++i) {
        u32x4 w = *(const u32x4*)(cq + i * 8);
        float a;
        a = lo_f(w.x); ss += a * a; a = hi_f(w.x); ss += a * a; a = lo_f(w.y); ss += a * a; a = hi_f(w.y); ss += a * a;
        a = lo_f(w.z); ss += a * a; a = hi_f(w.z); ss += a * a; a = lo_f(w.w); ss += a * a; a = hi_f(w.w); ss += a * a;
      }
      ss += __shfl_xor(ss, 16); ss += __shfl_xor(ss, 32);
      float rinv = rsqrtf(ss * (1.f / 256.f) + 1e-6f);
      bool latent = row < NLAT;
      int tok = row & 16383, prow = tok >> 6, pcol = tok & 63;
#pragma unroll
      for (int ni = 0; ni < 4; ++ni) {
        int col = nbs + ni * 16 + quad * 4;
        int sub = ((nbs >> 4) + ni) % 6;
        float v[4];
#pragma unroll
        for (int j = 0; j < 4; ++j) v[j] = acc[mi][ni][j] * rinv;
        if (sub >= 4) {
          float o[4];
#pragma unroll
          for (int j = 0; j < 4; ++j) o[j] = __shfl_xor(v[j], 32);
          if (latent) {
            int pos = sub == 4 ? prow : pcol;
#pragma unroll
            for (int j = 0; j < 4; ++j) {
              int i = (quad & 1) * 4 + j;
              float cs = p->rope32[(pos * 8 + i) * 2], sn = p->rope32[(pos * 8 + i) * 2 + 1];
              v[j] = quad < 2 ? v[j] * cs - o[j] * sn : v[j] * cs + o[j] * sn;
            }
          }
        }
        *(u32x2*)(p->Qm + (size_t)row * 384 + col) = MK2(pack2(v[0], v[1]), pack2(v[2], v[3]));
      }
    }
  }
};

__device__ __forceinline__ void mla_key_of_row(int row, int& b, int& key) {
  if (row < NLAT) { b = row >> 14; key = row & 16383; } else { b = (row - NLAT) >> 8; key = 16384 + ((row - NLAT) & 255); }
}

struct EpiUkv {
  const Params* p;
  __device__ __forceinline__ void operator()(f32x4 (&acc)[4][4], int mb, int nbs, int lr, int quad) const {
    int h = nbs >> 7, isv = (nbs >> 6) & 1;
#pragma unroll
    for (int mi = 0; mi < 4; ++mi) {
      int row = mb + mi * 16 + lr;
      const bf16_t* ck = p->P + (size_t)row * PW + C_CKV + quad * 32;
      float ss = 0.f;
#pragma unroll
      for (int i = 0; i < 4; ++i) {
        u32x4 w = *(const u32x4*)(ck + i * 8);
        float a;
        a = lo_f(w.x); ss += a * a; a = hi_f(w.x); ss += a * a; a = lo_f(w.y); ss += a * a; a = hi_f(w.y); ss += a * a;
        a = lo_f(w.z); ss += a * a; a = hi_f(w.z); ss += a * a; a = lo_f(w.w); ss += a * a; a = hi_f(w.w); ss += a * a;
      }
      ss += __shfl_xor(ss, 16); ss += __shfl_xor(ss, 32);
      float rinv = rsqrtf(ss * (1.f / 128.f) + 1e-6f);
      int b, key; mla_key_of_row(row, b, key);
      size_t kidx = (size_t)(b * 4 + h) * 16640 + key;
      bf16_t* dst = isv ? p->Vm + kidx * 64 : p->Km + kidx * 96;
#pragma unroll
      for (int ni = 0; ni < 4; ++ni) {
        f32x4 a = acc[mi][ni];
        *(u32x2*)(dst + ni * 16 + quad * 4) = MK2(pack2(a[0] * rinv, a[1] * rinv), pack2(a[2] * rinv, a[3] * rinv));
      }
    }
  }
};

__device__ __forceinline__ void rope64_pair_vals(const bf16_t* base, int pr, int prow, int pcol, const float* rope64, bool rotate, float (&o1)[8], float (&o2)[8], int& c0) {
  c0 = pr < 2 ? pr : pr + 2;
  int pos = pr < 2 ? prow : pcol, i0 = (pr & 1) * 8;
  u32x4 a = *(const u32x4*)(base + c0 * 8), b = *(const u32x4*)(base + (c0 + 2) * 8);
  unsigned aw[4] = {a.x, a.y, a.z, a.w}, bw[4] = {b.x, b.y, b.z, b.w};
#pragma unroll
  for (int e = 0; e < 8; ++e) {
    float x1 = (e & 1) ? hi_f(aw[e >> 1]) : lo_f(aw[e >> 1]);
    float x2 = (e & 1) ? hi_f(bw[e >> 1]) : lo_f(bw[e >> 1]);
    if (rotate) {
      float cs = rope64[(pos * 16 + i0 + e) * 2], sn = rope64[(pos * 16 + i0 + e) * 2 + 1];
      o1[e] = x1 * cs - x2 * sn; o2[e] = x2 * cs + x1 * sn;
    } else { o1[e] = x1; o2[e] = x2; }
  }
}
__device__ __forceinline__ u32x4 pack8(const float (&o)[8]) { return MK4(pack2(o[0], o[1]), pack2(o[2], o[3]), pack2(o[4], o[5]), pack2(o[6], o[7])); }

#define VSTR 80
__device__ void ret_prep_item(const Params& p, int l, int c, int h, char* lds) {
  bf16_t* vL = (bf16_t*)lds;
  bf16_t* kfL = vL + 128 * VSTR;
  bf16_t* kbL = kfL + 128 * VSTR;
  const int tid = otid(), wave = tid >> 6, lane = tid & 63, lr = lane & 15, quad = lane >> 4;
  const bool latent = c < 256;
  const int r0 = c * 128;
  float df = p.ret_decay[l * 8 + h], db = p.ret_decay[l * 8 + 4 + h];
  float lgf = -log1pf(__expf(-df)) * LOG2E, lgb = -log1pf(__expf(-db)) * LOG2E;
  __syncthreads();
#pragma unroll
  for (int i = 0; i < 2; ++i) {
    int idx = tid + 256 * i, r = idx >> 2, pr = idx & 3;
    int row = r0 + r, tok = row & 16383, prow = tok >> 6, pcol = tok & 63;
    bf16_t* kb = p.P + (size_t)row * PW + C_RK + h * 64;
    float o1[8], o2[8]; int c0;
    rope64_pair_vals(kb, pr, prow, pcol, p.rope64, latent, o1, o2, c0);
    if (latent) { *(u32x4*)(kb + c0 * 8) = pack8(o1); *(u32x4*)(kb + (c0 + 2) * 8) = pack8(o2); }
    float wf = exp2f(lgf * (float)(127 - r)) * 0.125f, wb = exp2f(lgb * (float)r) * 0.125f;
    float t1[8], t2[8];
#pragma unroll
    for (int e = 0; e < 8; ++e) { t1[e] = o1[e] * wf; t2[e] = o2[e] * wf; }
    *(u32x4*)(kfL + r * VSTR + c0 * 8) = pack8(t1); *(u32x4*)(kfL + r * VSTR + (c0 + 2) * 8) = pack8(t2);
#pragma unroll
    for (int e = 0; e < 8; ++e) { t1[e] = o1[e] * wb; t2[e] = o2[e] * wb; }
    *(u32x4*)(kbL + r * VSTR + c0 * 8) = pack8(t1); *(u32x4*)(kbL + r * VSTR + (c0 + 2) * 8) = pack8(t2);
    if (latent) {
      bf16_t* qb = p.P + (size_t)row * PW + C_RQ + h * 64;
      rope64_pair_vals(qb, pr, prow, pcol, p.rope64, true, o1, o2, c0);
      *(u32x4*)(qb + c0 * 8) = pack8(o1); *(u32x4*)(qb + (c0 + 2) * 8) = pack8(o2);
    }
  }
#pragma unroll
  for (int i = 0; i < 4; ++i) {
    int idx = tid + 256 * i, r = idx >> 3, ch = idx & 7;
    *(u32x4*)(vL + r * VSTR + ch * 8) = *(const u32x4*)(p.P + (size_t)(r0 + r) * PW + C_RV + h * 64 + ch * 8);
  }
  __syncthreads();
  f32x4 acc[2][4];
#pragma unroll
  for (int d = 0; d < 2; ++d)
#pragma unroll
    for (int j = 0; j < 4; ++j) acc[d][j] = (f32x4){0.f, 0.f, 0.f, 0.f};
  const int roff = (quad * 4 + (lr >> 2)) * VSTR + (lr & 3) * 4;
#pragma unroll
  for (int ks = 0; ks < 4; ++ks) {
    bf16x8 af = cat8(tr_read(vL + ks * 32 * VSTR + roff + wave * 16), tr_read(vL + (ks * 32 + 16) * VSTR + roff + wave * 16));
#pragma unroll
    for (int dt = 0; dt < 4; ++dt) {
      bf16x8 b0 = cat8(tr_read(kfL + ks * 32 * VSTR + roff + dt * 16), tr_read(kfL + (ks * 32 + 16) * VSTR + roff + dt * 16));
      acc[0][dt] = mfma16(af, b0, acc[0][dt]);
      bf16x8 b1 = cat8(tr_read(kbL + ks * 32 * VSTR + roff + dt * 16), tr_read(kbL + (ks * 32 + 16) * VSTR + roff + dt * 16));
      acc[1][dt] = mfma16(af, b1, acc[1][dt]);
    }
  }
#pragma unroll
  for (int dir = 0; dir < 2; ++dir) {
    float* ks = p.Ksum + ((size_t)(dir * 260 + c) * 4 + h) * 4096;
#pragma unroll
    for (int dt = 0; dt < 4; ++dt)
#pragma unroll
      for (int j = 0; j < 4; ++j) ks[(wave * 16 + quad * 4 + j) * 64 + dt * 16 + lr] = acc[dir][dt][j];
  }
}

__device__ void swa_rope_item(const Params& p, int mt) {
  const int tid = otid();
  for (int idx = tid; idx < 128 * 24; idx += 256) {
    int r = idx / 24, pp = idx % 24;
    int row = mt * 128 + r, tok = row & 16383, prow = tok >> 6, pcol = tok & 63;
    int hd = pp >> 2, pr = pp & 3;
    bf16_t* base = p.P + (size_t)row * PW + (hd < 4 ? C_SQ + hd * 64 : C_SK + (hd - 4) * 64);
    float o1[8], o2[8]; int c0;
    rope64_pair_vals(base, pr, prow, pcol, p.rope64, true, o1, o2, c0);
    *(u32x4*)(base + c0 * 8) = pack8(o1); *(u32x4*)(base + (c0 + 2) * 8) = pack8(o2);
  }
}

__device__ void mla_krope_item(const Params& p, int m0, int h) {
  const int tid = otid();
  int row = m0 + (tid >> 1), part = tid & 1;
  bool latent = row < NLAT;
  int tok = row & 16383, pos = part == 0 ? (tok >> 6) : (tok & 63);
  const bf16_t* src = p.P + (size_t)row * PW + C_KR + part * 16;
  u32x4 a = *(const u32x4*)src, b = *(const u32x4*)(src + 8);
  unsigned aw[4] = {a.x, a.y, a.z, a.w}, bw[4] = {b.x, b.y, b.z, b.w};
  float o1[8], o2[8];
#pragma unroll
  for (int e = 0; e < 8; ++e) {
    float x1 = (e & 1) ? hi_f(aw[e >> 1]) : lo_f(aw[e >> 1]);
    float x2 = (e & 1) ? hi_f(bw[e >> 1]) : lo_f(bw[e >> 1]);
    if (latent) {
      float cs = p.rope32[(pos * 8 + e) * 2], sn = p.rope32[(pos * 8 + e) * 2 + 1];
      o1[e] = x1 * cs - x2 * sn; o2[e] = x2 * cs + x1 * sn;
    } else { o1[e] = x1; o2[e] = x2; }
  }
  int b_, key; mla_key_of_row(row, b_, key);
  bf16_t* dst = p.Km + ((size_t)(b_ * 4 + h) * 16640 + key) * 96 + 64 + part * 16;
  *(u32x4*)dst = pack8(o1); *(u32x4*)(dst + 8) = pack8(o2);
}

struct KVT { const bf16_t* k; const bf16_t* v; };

template <int DQK, bool SOFTMAX, bool PLAIN, class TileFn, class MaskFn>
__device__ __forceinline__ void attn_core(const bf16x8 (&qf)[2][DQK / 32], int ntiles, const TileFn& tf, int ldk, int ldv, const MaskFn& mk,
                                          f32x4 (&o)[4][2], float (&m)[2], float (&l)[2], char* lds) {
  constexpr int KSTR = DQK + 16, NKS = DQK / 32, KCH = DQK / 8, NKL = (64 * KCH) / 256;
  bf16_t* Kl = (bf16_t*)lds;
  bf16_t* Vl = Kl + 2 * 64 * KSTR;
  const int tid = otid(), wave = tid >> 6, lane = tid & 63, lr = lane & 15, quad = lane >> 4;
  constexpr bool MFMA_SUM = SOFTMAX && PLAIN;
  f32x4 lacc[2] = {(f32x4){0.f, 0.f, 0.f, 0.f}, (f32x4){0.f, 0.f, 0.f, 0.f}};
  u32x4 rk[NKL], rv[2];
  unsigned koff[NKL], voff[2];
#pragma unroll
  for (int i = 0; i < NKL; ++i) { int c = tid + i * 256, r = c / KCH, ch = c % KCH; koff[i] = (unsigned)(r * ldk + ch * 8) * 2u; }
#pragma unroll
  for (int i = 0; i < 2; ++i) { int c = tid + i * 256, r = c >> 3, ch = c & 7; voff[i] = (unsigned)(r * ldv + ch * 8) * 2u; }
  __syncthreads();
  {
    KVT kv = tf(0);
    rsrc_t kr = mkbuf(kv.k), vr = mkbuf(kv.v);
#pragma unroll
    for (int i = 0; i < NKL; ++i) rk[i] = bload16(kr, koff[i], 0);
#pragma unroll
    for (int i = 0; i < 2; ++i) rv[i] = bload16(vr, voff[i], 0);
#pragma unroll
    for (int i = 0; i < NKL; ++i) { int c = tid + i * 256, r = c / KCH, ch = c % KCH; *(u32x4*)(Kl + r * KSTR + ch * 8) = rk[i]; }
#pragma unroll
    for (int i = 0; i < 2; ++i) { int c = tid + i * 256, r = c >> 3, ch = c & 7; *(u32x4*)(Vl + r * VSTR + ch * 8) = rv[i]; }
  }
  __syncthreads();
  for (int t = 0; t < ntiles; ++t) {
    const int cur = t & 1;
    if (t + 1 < ntiles) {
      KVT kv = tf(t + 1);
      rsrc_t kr = mkbuf(kv.k), vr = mkbuf(kv.v);
#pragma unroll
      for (int i = 0; i < NKL; ++i) rk[i] = bload16(kr, koff[i], 0);
#pragma unroll
      for (int i = 0; i < 2; ++i) rv[i] = bload16(vr, voff[i], 0);
    }
    f32x4 s[4][2];
#pragma unroll
    for (int kt = 0; kt < 4; ++kt) { s[kt][0] = (f32x4){0.f, 0.f, 0.f, 0.f}; s[kt][1] = (f32x4){0.f, 0.f, 0.f, 0.f}; }
    const bf16_t* kb = Kl + cur * 64 * KSTR + lr * KSTR + quad * 8;
    {
      bf16x8 kfa[NKS][4];
#pragma unroll
      for (int ks = 0; ks < NKS; ++ks)
#pragma unroll
        for (int kt = 0; kt < 4; ++kt) kfa[ks][kt] = *(const bf16x8*)(kb + kt * 16 * KSTR + ks * 32);
#pragma unroll
      for (int ks = 0; ks < NKS; ++ks)
#pragma unroll
        for (int kt = 0; kt < 4; ++kt) {
          s[kt][0] = mfma16(kfa[ks][kt], qf[0][ks], s[kt][0]);
          s[kt][1] = mfma16(kfa[ks][kt], qf[1][ks], s[kt][1]);
        }
    }
    if (!PLAIN) {
#pragma unroll
      for (int kt = 0; kt < 4; ++kt)
#pragma unroll
        for (int qt = 0; qt < 2; ++qt)
#pragma unroll
          for (int j = 0; j < 4; ++j) s[kt][qt][j] = mk(t, wave * 32 + qt * 16 + lr, kt * 16 + quad * 4 + j, s[kt][qt][j]);
    }
    if (SOFTMAX) {
      const float sl2 = PLAIN ? mk(0, 0, 0, 1.0f) : 1.0f;
      float mnew[2], alpha[2];
#pragma unroll
      for (int qt = 0; qt < 2; ++qt) {
        float mx = fmaxf(fmaxf(s[0][qt][0], s[0][qt][1]), fmaxf(s[0][qt][2], s[0][qt][3]));
#pragma unroll
        for (int kt = 1; kt < 4; ++kt) mx = fmaxf(fmaxf(mx, s[kt][qt][0]), fmaxf(fmaxf(s[kt][qt][1], s[kt][qt][2]), s[kt][qt][3]));
        mx = fmaxf(mx, __shfl_xor(mx, 16)); mx = fmaxf(mx, __shfl_xor(mx, 32));
        if (PLAIN) mx *= sl2;
        mnew[qt] = fmaxf(m[qt], mx);
        alpha[qt] = __builtin_amdgcn_exp2f(m[qt] - mnew[qt]);
        m[qt] = mnew[qt];
      }
      if (__any((alpha[0] < 1.f) | (alpha[1] < 1.f))) {
#pragma unroll
        for (int qt = 0; qt < 2; ++qt) {
          l[qt] *= alpha[qt];
          if (MFMA_SUM) { lacc[qt][0] *= alpha[qt]; lacc[qt][1] *= alpha[qt]; lacc[qt][2] *= alpha[qt]; lacc[qt][3] *= alpha[qt]; }
#pragma unroll
          for (int dt = 0; dt < 4; ++dt)
#pragma unroll
            for (int j = 0; j < 4; ++j) o[dt][qt][j] *= alpha[qt];
        }
      }
#pragma unroll
      for (int qt = 0; qt < 2; ++qt) {
        float ls = 0.f;
        const float nm = -mnew[qt];
#pragma unroll
        for (int kt = 0; kt < 4; ++kt)
#pragma unroll
          for (int j = 0; j < 4; ++j) {
            float pv = __builtin_amdgcn_exp2f(PLAIN ? fmaf(s[kt][qt][j], sl2, nm) : s[kt][qt][j] + nm);
            s[kt][qt][j] = pv; if (!MFMA_SUM) ls += pv;
          }
        if (!MFMA_SUM) l[qt] += ls;
      }
    }
    bf16x8 pf[2][2];
#pragma unroll
    for (int qt = 0; qt < 2; ++qt)
#pragma unroll
      for (int kk = 0; kk < 2; ++kk) {
        unsigned w0 = pack2(s[2 * kk][qt][0], s[2 * kk][qt][1]), w1 = pack2(s[2 * kk][qt][2], s[2 * kk][qt][3]);
        unsigned w2 = pack2(s[2 * kk + 1][qt][0], s[2 * kk + 1][qt][1]), w3 = pack2(s[2 * kk + 1][qt][2], s[2 * kk + 1][qt][3]);
        u32x4 u = MK4(w0, w1, w2, w3);
        pf[qt][kk] = __builtin_bit_cast(bf16x8, u);
      }
    const bf16_t* vb = Vl + cur * 64 * VSTR + (quad * 4 + (lr >> 2)) * VSTR + (lr & 3) * 4;
    {
      bf16x8 vfa[2][4];
#pragma unroll
      for (int kk = 0; kk < 2; ++kk)
#pragma unroll
        for (int dt = 0; dt < 4; ++dt) vfa[kk][dt] = cat8(tr_read(vb + (kk * 32) * VSTR + dt * 16), tr_read(vb + (kk * 32 + 16) * VSTR + dt * 16));
#pragma unroll
      for (int kk = 0; kk < 2; ++kk)
#pragma unroll
        for (int dt = 0; dt < 4; ++dt) {
          o[dt][0] = mfma16(vfa[kk][dt], pf[0][kk], o[dt][0]);
          o[dt][1] = mfma16(vfa[kk][dt], pf[1][kk], o[dt][1]);
        }
      if (MFMA_SUM) {
        const bf16x8 ones = {(short)0x3f80, (short)0x3f80, (short)0x3f80, (short)0x3f80, (short)0x3f80, (short)0x3f80, (short)0x3f80, (short)0x3f80};
#pragma unroll
        for (int kk = 0; kk < 2; ++kk) { lacc[0] = mfma16(ones, pf[0][kk], lacc[0]); lacc[1] = mfma16(ones, pf[1][kk], lacc[1]); }
      }
    }
    if (t + 1 < ntiles) {
      const int nx = cur ^ 1;
#pragma unroll
      for (int i = 0; i < NKL; ++i) { int c = tid + i * 256, r = c / KCH, ch = c % KCH; *(u32x4*)(Kl + nx * 64 * KSTR + r * KSTR + ch * 8) = rk[i]; }
#pragma unroll
      for (int i = 0; i < 2; ++i) { int c = tid + i * 256, r = c >> 3, ch = c & 7; *(u32x4*)(Vl + nx * 64 * VSTR + r * VSTR + ch * 8) = rv[i]; }
    }
    __syncthreads();
  }
  if (MFMA_SUM) { const int quad_ = (otid() & 63) >> 4; l[0] = quad_ == 0 ? lacc[0][0] : 0.f; l[1] = quad_ == 0 ? lacc[1][0] : 0.f; }
}

__device__ __forceinline__ void attn_store(f32x4 (&o)[4][2], float (&m)[2], float (&l)[2], bool has_sink, float sink_l2, bf16_t* dst  , int ldo) {
  const int lane = otid() & 63, wave = otid() >> 6, lr = lane & 15, quad = lane >> 4;
#pragma unroll
  for (int qt = 0; qt < 2; ++qt) {
    float lt = l[qt]; lt += __shfl_xor(lt, 16); lt += __shfl_xor(lt, 32);
    if (has_sink) lt += exp2f(sink_l2 - m[qt]);
    float inv = 1.f / lt;
    bf16_t* rp = dst + (size_t)(wave * 32 + qt * 16 + lr) * ldo + quad * 4;
#pragma unroll
    for (int dt = 0; dt < 4; ++dt)
      *(u32x2*)(rp + dt * 16) = MK2(pack2(o[dt][qt][0] * inv, o[dt][qt][1] * inv), pack2(o[dt][qt][2] * inv, o[dt][qt][3] * inv));
  }
}

template <int NKS>
__device__ __forceinline__ void load_q(bf16x8 (&qf)[2][NKS], const bf16_t* q  , int ldq) {
  const int lane = otid() & 63, wave = otid() >> 6, lr = lane & 15, quad = lane >> 4;
#pragma unroll
  for (int qt = 0; qt < 2; ++qt)
#pragma unroll
    for (int ks = 0; ks < NKS; ++ks) qf[qt][ks] = *(const bf16x8*)(q + (size_t)(wave * 32 + qt * 16 + lr) * ldq + ks * 32 + quad * 8);
}

struct TileContig { const bf16_t* k; const bf16_t* v; size_t ks, vs;
  __device__ __forceinline__ KVT operator()(int t) const { return KVT{k + (size_t)t * ks, v + (size_t)t * vs}; } };
struct MaskScale { float sl2; __device__ __forceinline__ float operator()(int, int, int, float s) const { return s * sl2; } };

__device__ void mla_item(const Params& p, int b, int h, int qt128, bool ctxq, char* lds) {
  int r0 = ctxq ? NLAT + b * 256 + qt128 * 128 : b * 16384 + qt128 * 128;
  bf16x8 qf[2][3];
  load_q<3>(qf, p.Qm + (size_t)r0 * 384 + h * 96, 384);
  f32x4 o[4][2]; float m[2] = {-1e30f, -1e30f}, l[2] = {0.f, 0.f};
#pragma unroll
  for (int dt = 0; dt < 4; ++dt) { o[dt][0] = (f32x4){0.f, 0.f, 0.f, 0.f}; o[dt][1] = (f32x4){0.f, 0.f, 0.f, 0.f}; }
  int t0 = ctxq ? 256 : 0, nt = ctxq ? 4 : 260;
  size_t kbase = (size_t)(b * 4 + h) * 16640 + (size_t)t0 * 64;
  TileContig tf{p.Km + kbase * 96, p.Vm + kbase * 64, (size_t)64 * 96, (size_t)64 * 64};
  MaskScale mk{0.10206207261596575f * LOG2E};
  attn_core<96, true, true>(qf, nt, tf, 96, 64, mk, o, m, l, lds);
  attn_store(o, m, l, false, 0.f, p.ACT + (size_t)r0 * 1024 + h * 64, 1024);
}

struct NaTiles { const bf16_t* P; int b, h, lo, nw;
  __device__ __forceinline__ KVT operator()(int t) const {
    size_t row = t < nw ? (size_t)b * 16384 + (size_t)(lo + t) * 64 : (size_t)NLAT + b * 256 + (size_t)(t - nw) * 64;
    return KVT{P + row * PW + C_NK + h * 64, P + row * PW + C_NV + h * 64}; } };
struct NaMask { const float* rpb; int nw, lo, qr0; float sl2;
  __device__ __forceinline__ float operator()(int t, int qi, int kj, float s) const {
    if (t >= nw) return s * sl2;
    int qr = qr0 + (qi >> 6), qc = qi & 63, kr = lo + t;
    int r0q = min(max(qr - 4, 0), 248), c0 = min(max(qc - 8, 0), 48);
    bool ok = (kr >= r0q) & (kr < r0q + 8) & (kj >= c0) & (kj < c0 + 16);
    int dr = min(max(kr - qr + 7, 0), 14), dc = min(max(kj - qc, -15), 15) + 15;
    float bias = rpb[dr * 31 + dc];
    return ok ? s * sl2 + bias * LOG2E : -INFINITY; } };

__device__ void na_item(const Params& p, int l, int b, int h, int pair, char* lds) {
  float* rpbL = (float*)(lds + 60000);
  __syncthreads();
  for (int i = otid(); i < 465; i += 256) rpbL[i] = p.na_rpb[(size_t)(l * 4 + h) * 465 + i];
  int r0 = b * 16384 + pair * 128;
  bf16x8 qf[2][2];
  load_q<2>(qf, p.P + (size_t)r0 * PW + C_NQ + h * 64, PW);
  f32x4 o[4][2]; float m[2] = {-1e30f, -1e30f}, ls[2] = {0.f, 0.f};
#pragma unroll
  for (int dt = 0; dt < 4; ++dt) { o[dt][0] = (f32x4){0.f, 0.f, 0.f, 0.f}; o[dt][1] = (f32x4){0.f, 0.f, 0.f, 0.f}; }
  int qr0 = pair * 2;
  int lo = min(max(qr0 - 4, 0), 248), hi = min(max(qr0 + 1 - 4, 0), 248) + 7;
  int nw = hi - lo + 1;
  NaTiles tf{p.P, b, h, lo, nw};
  NaMask mk{rpbL, nw, lo, qr0, 0.125f * LOG2E};
  attn_core<64, true, false>(qf, nw + 4, tf, PW, PW, mk, o, m, ls, lds);
  attn_store(o, m, ls, false, 0.f, p.ACT + (size_t)r0 * 1024 + 512 + h * 64, 1024);
}

struct SwaTiles { const bf16_t* P; int b, kvh, nlo, nwt;
  __device__ __forceinline__ KVT operator()(int t) const {
    size_t row = t < nwt ? (size_t)b * 16384 + (size_t)(nlo * 128 + t * 64) : (size_t)NLAT + b * 256 + (size_t)(t - nwt) * 64;
    return KVT{P + row * PW + C_SK + kvh * 64, P + row * PW + C_SV + kvh * 64}; } };
struct SwaMask { int nwt, koff  ; float sl2;
  __device__ __forceinline__ float operator()(int t, int qi, int kj, float s) const {
    if (t >= nwt) return s * sl2;
    int delta = koff + t * 64 + kj - qi;
    return (delta <= 128 && delta >= -128) ? s * sl2 : -INFINITY; } };

__device__ void swa_item(const Params& p, int l, int b, int hq, int n, bool ctxq, char* lds) {
  int r0 = ctxq ? NLAT + b * 256 + n * 128 : b * 16384 + n * 128;
  bf16x8 qf[2][2];
  load_q<2>(qf, p.P + (size_t)r0 * PW + C_SQ + hq * 64, PW);
  f32x4 o[4][2]; float m[2] = {-1e30f, -1e30f}, ls[2] = {0.f, 0.f};
#pragma unroll
  for (int dt = 0; dt < 4; ++dt) { o[dt][0] = (f32x4){0.f, 0.f, 0.f, 0.f}; o[dt][1] = (f32x4){0.f, 0.f, 0.f, 0.f}; }
  int nlo = 0, nwt = 0;
  if (!ctxq) { nlo = max(n - 1, 0); int nhi = min(n + 1, 127); nwt = (nhi - nlo + 1) * 2; }
  SwaTiles tf{p.P, b, hq >> 1, nlo, nwt};
  SwaMask mk{nwt, (nlo - n) * 128, 0.125f * LOG2E};
  attn_core<64, true, false>(qf, nwt + 4, tf, PW, PW, mk, o, m, ls, lds);
  float sink = p.swa_sink[l * 4 + hq] * LOG2E;
  attn_store(o, m, ls, true, sink, p.ACT + (size_t)r0 * 1024 + 768 + hq * 64, 1024);
}

__device__ void na_ctx_item(const Params& p, int b, int h, int n, char* lds) {
  int r0 = NLAT + b * 256 + n * 128;
  bf16x8 qf[2][2];
  load_q<2>(qf, p.P + (size_t)r0 * PW + C_NQ + h * 64, PW);
  f32x4 o[4][2]; float m[2] = {-1e30f, -1e30f}, ls[2] = {0.f, 0.f};
#pragma unroll
  for (int dt = 0; dt < 4; ++dt) { o[dt][0] = (f32x4){0.f, 0.f, 0.f, 0.f}; o[dt][1] = (f32x4){0.f, 0.f, 0.f, 0.f}; }
  NaTiles tf{p.P, b, h, 0, 0};
  MaskScale mk{0.125f * LOG2E};
  attn_core<64, true, true>(qf, 4, tf, PW, PW, mk, o, m, ls, lds);
  attn_store(o, m, ls, false, 0.f, p.ACT + (size_t)r0 * 1024 + 512 + h * 64, 1024);
}

__device__ void ret_scan_item(const Params& p, int l, int combo, int part) {
  int dir = combo >> 3, b = (combo >> 2) & 1, h = combo & 3;
  float d = p.ret_decay[l * 8 + dir * 4 + h];
  float lg = -log1pf(__expf(-d)) * LOG2E;
  float gC = exp2f(lg * 128.f);
  int idx = part * 1024 + otid() * 4;
  f32x4 S = (f32x4){0.f, 0.f, 0.f, 0.f};
  const size_t dbase = ((size_t)dir * 260 * 4 + h) * 4096 + idx;
#pragma unroll 1
  for (int s0 = 0; s0 < 130; s0 += 13) {
    f32x4 kv[13]; int ch[13];
#pragma unroll
    for (int u = 0; u < 13; ++u) {
      int step = s0 + u;
      if (dir == 0) ch[u] = step < 2 ? 256 + 2 * b + step : b * 128 + (step - 2);
      else ch[u] = step < 2 ? 256 + 2 * b + 1 - step : b * 128 + 127 - (step - 2);
      kv[u] = *(const f32x4*)(p.Ksum + dbase + (size_t)ch[u] * 16384);
    }
#pragma unroll
    for (int u = 0; u < 13; ++u) {
      *(u32x2*)(p.St + dbase + (size_t)ch[u] * 16384) = MK2(pack2(S[0], S[1]), pack2(S[2], S[3]));
#pragma unroll
      for (int j = 0; j < 4; ++j) S[j] = S[j] * gC + kv[u][j];
    }
  }
}

struct RetMask { float lg; int dir;
  __device__ __forceinline__ float operator()(int t, int qi, int kj, float s) const {
    int j = t * 64 + kj; int df = dir == 0 ? qi - j : j - qi;
    return df >= 0 ? s * 0.125f * __builtin_amdgcn_exp2f(lg * (float)df) : 0.f; } };

__device__ void ret_out_item(const Params& p, int l, int c, int h, char* lds) {
  const int lane = otid() & 63, wave = otid() >> 6, lr = lane & 15, quad = lane >> 4;
  int r0 = c * 128;
  bf16x8 qf[2][2];
  load_q<2>(qf, p.P + (size_t)r0 * PW + C_RQ + h * 64, PW);
  f32x4 res[4][2];
#pragma unroll
  for (int dt = 0; dt < 4; ++dt) { res[dt][0] = (f32x4){0.f, 0.f, 0.f, 0.f}; res[dt][1] = (f32x4){0.f, 0.f, 0.f, 0.f}; }
  TileContig tf{p.P + (size_t)r0 * PW + C_RK + h * 64, p.P + (size_t)r0 * PW + C_RV + h * 64, (size_t)64 * PW, (size_t)64 * PW};
#pragma unroll 1
  for (int dir = 0; dir < 2; ++dir) {
    float d = p.ret_decay[l * 8 + dir * 4 + h];
    float lg = -log1pf(__expf(-d)) * LOG2E;
    f32x4 o[4][2]; float m[2] = {0.f, 0.f}, ls[2] = {0.f, 0.f};
#pragma unroll
    for (int dt = 0; dt < 4; ++dt) { o[dt][0] = (f32x4){0.f, 0.f, 0.f, 0.f}; o[dt][1] = (f32x4){0.f, 0.f, 0.f, 0.f}; }
    rsrc_t str = mkbuf(p.St + ((size_t)(dir * 260 + c) * 4 + h) * 4096);
#pragma unroll
    for (int ks = 0; ks < 2; ++ks)
#pragma unroll
      for (int et = 0; et < 4; ++et) {
        bf16x8 af = __builtin_bit_cast(bf16x8, bload16(str, (unsigned)(lr * 64 + quad * 8) * 2u, (unsigned)(et * 16 * 64 + ks * 32) * 2u));
        o[et][0] = mfma16(af, qf[0][ks], o[et][0]);
        o[et][1] = mfma16(af, qf[1][ks], o[et][1]);
      }
#pragma unroll
    for (int qt = 0; qt < 2; ++qt) {
      int i = wave * 32 + qt * 16 + lr;
      float qdec = exp2f(lg * (float)(dir == 0 ? i + 1 : 128 - i));
#pragma unroll
      for (int et = 0; et < 4; ++et)
#pragma unroll
        for (int j = 0; j < 4; ++j) o[et][qt][j] *= qdec;
    }
    __builtin_amdgcn_sched_barrier(0);
    RetMask mk{lg, dir};
    attn_core<64, false, false>(qf, 2, tf, PW, PW, mk, o, m, ls, lds);
    __builtin_amdgcn_sched_barrier(0);
#pragma unroll
    for (int qt = 0; qt < 2; ++qt) {
      int i = wave * 32 + qt * 16 + lr;
      float ss = 0.f;
#pragma unroll
      for (int et = 0; et < 4; ++et)
#pragma unroll
        for (int j = 0; j < 4; ++j) { float v = o[et][qt][j]; ss += v * v; }
      ss += __shfl_xor(ss, 16); ss += __shfl_xor(ss, 32);
      float rinv = rsqrtf(ss * (1.f / 64.f) + 1e-6f);
      rsrc_t gpr = mkbuf(p.P + (size_t)r0 * PW + (dir == 0 ? C_RGF : C_RGB) + h * 64);
      unsigned goff = (unsigned)(i * PW + quad * 4) * 2u;
#pragma unroll
      for (int et = 0; et < 4; ++et) {
        u32x2 gw = bload8(gpr, goff, et * 32);
        float g0 = lo_f(gw.x), g1 = hi_f(gw.x), g2 = lo_f(gw.y), g3 = hi_f(gw.y);
        res[et][qt][0] += o[et][qt][0] * rinv * silu_f(g0);
        res[et][qt][1] += o[et][qt][1] * rinv * silu_f(g1);
        res[et][qt][2] += o[et][qt][2] * rinv * silu_f(g2);
        res[et][qt][3] += o[et][qt][3] * rinv * silu_f(g3);
      }
    }
  }
#pragma unroll
  for (int qt = 0; qt < 2; ++qt) {
    bf16_t* rp = p.ACT + (size_t)(r0 + wave * 32 + qt * 16 + lr) * 1024 + 256 + h * 64 + quad * 4;
#pragma unroll
    for (int et = 0; et < 4; ++et)
      *(u32x2*)(rp + et * 16) = MK2(pack2(res[et][qt][0], res[et][qt][1]), pack2(res[et][qt][2], res[et][qt][3]));
  }
}


#define XB_TMO      128
#define XB_XCNT(j)  (256  + 64 * (j))
#define XB_XSUB(j)  (1280 + 64 * (j))
#define XB_XGEN(j)  (2304 + 64 * (j))
#define XB_TOP      3328
#define XB_TOPGEN   3392
#define XCD_BAR_WORDS 3456
#define XB_SPIN_CAP (1u << 20)
#define LAS __attribute__((address_space(3)))
__device__ __forceinline__ unsigned xb_ld(unsigned* p)              { return __hip_atomic_load(p, __ATOMIC_RELAXED, __HIP_MEMORY_SCOPE_AGENT); }
__device__ __forceinline__ unsigned xb_add(unsigned* p, unsigned v) { return __hip_atomic_fetch_add(p, v, __ATOMIC_RELAXED, __HIP_MEMORY_SCOPE_AGENT); }
__device__ __forceinline__ unsigned xb_xcc_id() { return (unsigned)__builtin_amdgcn_s_getreg((3 << 11) | 20) & 0xFu; }
#define XB_SPIN(cond, bar) do { unsigned _sp = 0; while (cond) { __builtin_amdgcn_s_sleep(1); \
    if ((++_sp & 255u) == 0u) { if (xb_ld(&(bar)[XB_TMO])) break; if (_sp > XB_SPIN_CAP) { atomicAdd(&(bar)[XB_TMO], 1u); break; } } } } while (0)
struct XcdBarrier { unsigned* bar; unsigned x; volatile LAS unsigned* st; };
__device__ __forceinline__ XcdBarrier xcd_barrier_post(unsigned* bar, volatile LAS unsigned* st) {
    XcdBarrier b; b.bar = bar; b.x = xb_xcc_id(); b.st = st;
    if (threadIdx.x == 0) (void)xb_add(&bar[XB_XCNT(b.x)], 1u);
    return b;
}
__device__ __forceinline__ void xcd_barrier_complete(unsigned* bar, unsigned x, unsigned& nloc, unsigned& nx) {
    const unsigned G = gridDim.x * gridDim.y * gridDim.z;
    unsigned sum, cnt, mine, sp = 0u;
    for (;;) {
        sum = 0u; cnt = 0u; mine = 0u;
#pragma unroll
        for (unsigned j = 0; j < 16; ++j) { const unsigned c = xb_ld(&bar[XB_XCNT(j)]); sum += c; cnt += (c > 0u) ? 1u : 0u; mine = (j == x) ? c : mine; }
        if (sum == G) break;
        __builtin_amdgcn_s_sleep(1);
        if ((++sp & 255u) == 0u) { if (xb_ld(&bar[XB_TMO])) break; if (sp > XB_SPIN_CAP) { atomicAdd(&bar[XB_TMO], 1u); break; } }
    }
    nloc = mine > 0u ? mine : 1u; nx = cnt > 0u ? cnt : 1u;
}
__device__ __forceinline__ void xcd_barrier(const XcdBarrier& b) {
    asm volatile("s_waitcnt vmcnt(0)" ::: "memory");
    __syncthreads();
    if (threadIdx.x == 0) {
        unsigned* bar = b.bar;
        __builtin_amdgcn_s_waitcnt(0);
        unsigned nloc = b.st[0], nx = b.st[1];
        if (nloc == 0u) { xcd_barrier_complete(bar, b.x, nloc, nx); b.st[0] = nloc; b.st[1] = nx; }
        const unsigned old = xb_add(&bar[XB_XSUB(b.x)], 1u);
        const unsigned gen = old / nloc;
        if (old + 1u == (gen + 1u) * nloc) {
            __builtin_amdgcn_fence(__ATOMIC_RELEASE, "agent");
            asm volatile("s_waitcnt vmcnt(0)" ::: "memory");
            const unsigned og = xb_add(&bar[XB_TOP], 1u);
            const unsigned tg = og / nx;
            if (og + 1u == (tg + 1u) * nx) xb_add(&bar[XB_TOPGEN], 1u);
            else XB_SPIN(xb_ld(&bar[XB_TOPGEN]) == tg, bar);
            __builtin_amdgcn_fence(__ATOMIC_ACQUIRE, "agent");
            xb_add(&bar[XB_XGEN(b.x)], 1u);
            asm volatile("s_waitcnt vmcnt(0)" ::: "memory");
        } else {
            XB_SPIN(xb_ld(&bar[XB_XGEN(b.x)]) == gen, bar);
            __builtin_amdgcn_fence(__ATOMIC_ACQUIRE, "agent");
            asm volatile("s_waitcnt vmcnt(0)" ::: "memory");
        }
    }
    __syncthreads();
}

__device__ void run_phase(const Params& p, int ph, int bid, int nb, char* lds) {
#ifndef CM
#define CM 0xff
#endif
#ifndef PH_MASK
#define PH_MASK 0xfffff
#endif
  if (ph == 0) { if (PH_MASK & (1<<9)) prologue_phase(p, bid, nb, lds); return; }
  if (ph == 37) { if (PH_MASK & (1<<10)) final_norm_phase(p, bid, nb); return; }
  const int l = (ph - 1) / 9, sp = (ph - 1) % 9;
  const bf16_t* W = p.W + (size_t)l * W_LAYER;
  if (!((PH_MASK >> sp) & 1)) return;
  switch (sp) {
    case 0: norm_phase(p, l, 0, bid, nb); break;
    case 1: {
      EpiWin epi{p.P};
      for (int rd = 0;; ++rd) { int t = xcd_tile(rd, bid, nb); if (t >= 260 * 24) break; int pm, pn; tile_coord(t, 24, pm, pn); gemm_tile(p.ACT, 1024, W + WO_IN, 1024, 1024, pm * 128, pn * 128, epi, lds); }
    } break;
    case 2: {
      EpiUq eq{&p}; EpiUkv ekv{&p};
      const int n0 = 260 * 4, n1 = n0 + 260 * 4, n2 = n1 + 260 * 3, n3 = n2 + 256;
      for (int t = bid; t < n3; t += nb) {
        if (t < n0) ret_prep_item(p, l, t >> 2, t & 3, lds);
        else if (t < n1) { int u = t - n0, pm = u >> 2, h = u & 3; gemm_tile(p.P + C_CKV, PW, W + WO_UKV, 128, 128, pm * 128, h * 128, ekv, lds); mla_krope_item(p, pm * 128, h); }
        else if (t < n2) { int u = t - n1, pm = u / 3, pn = u % 3; gemm_tile(p.P + C_CQ, PW, W + WO_UQ, 256, 256, pm * 128, pn * 128, eq, lds); }
        else swa_rope_item(p, t - n2);
      }
    } break;
    case 3: {
      int* slot = (int*)(lds + LDS_BYTES - 16);
      if (bid < 64) { if (CM & 2) ret_scan_item(p, l, bid >> 2, bid & 3); }
      const int x = bid & 7;
      for (int pass = 0; pass < 8; ++pass) {
        const int cmb = (x + pass) & 7;
        for (;;) {
          __syncthreads();
          if (otid() == 0) *slot = (int)atomicAdd(p.bar + 8 + l * 8 + cmb, 1u);
          __syncthreads();
          const int q = *slot;
          if (q >= 128) break;
          if (CM & 1) mla_item(p, cmb >> 2, cmb & 3, q, false, lds);
        }
      }
      const int n1 = 1024, n2 = n1 + 1024, n3 = n2 + 16, n4 = n3 + 16, n5 = n4 + 16;
      for (;;) {
        __syncthreads();
        if (otid() == 0) *slot = (int)atomicAdd(p.bar + l, 1u);
        __syncthreads();
        const int t = *slot;
        if (t >= n5) break;
        if (t < n1) { int u = t; if (CM & 4) na_item(p, l, u >> 9, (u >> 7) & 3, u & 127, lds); }
        else if (t < n2) { int u = t - n1; if (CM & 16) swa_item(p, l, u >> 9, (u >> 7) & 3, u & 127, false, lds); }
        else if (t < n3) { int u = t - n2; if (CM & 1) mla_item(p, u >> 3, (u >> 1) & 3, u & 1, true, lds); }
        else if (t < n4) { int u = t - n3; if (CM & 8) na_ctx_item(p, u >> 3, (u >> 1) & 3, u & 1, lds); }
        else { int u = t - n4; if (CM & 16) swa_item(p, l, u >> 3, (u >> 1) & 3, u & 1, true, lds); }
      }
    } break;
    case 4: for (int t = bid; t < 260 * 4; t += nb) ret_out_item(p, l, t >> 2, t & 3, lds); break;
    case 5: {
      EpiResid epi{&p, l, 2048, 1};
      for (int rd = 0;; ++rd) { int t = xcd_tile(rd, bid, nb); if (t >= (l == 3 ? 256 : 260) * 8) break; int pm, pn; tile_coord(t, 8, pm, pn); gemm_tile(p.ACT, 1024, W + WO_OUT, 1024, 1024, pm * 128, pn * 128, epi, lds); }
    } break;
    case 6: norm_phase(p, l, 1, bid, nb); break;
    case 7: {
      EpiFfn1 epi{p.P};
      for (int rd = 0;; ++rd) { int t = xcd_tile(rd, bid, nb); if (t >= (l == 3 ? 256 : 260) * 44) break; int pm, pn; tile_coord(t, 44, pm, pn); gemm_tile(p.ACT, 1024, W + WO_13, 1024, 1024, pm * 128, pn * 128, epi, lds); }
    } break;
    case 8: {
      EpiResid epi{&p, l, 5120, 0};
      for (int rd = 0;; ++rd) { int t = xcd_tile(rd, bid, nb); if (t >= (l == 3 ? 256 : 260) * 8) break; int pm, pn; tile_coord(t, 8, pm, pn); gemm_tile(p.P, 2816, W + WO_2, 2816, 2816, pm * 128, pn * 128, epi, lds); }
    } break;
  }
}

__global__ void __launch_bounds__(256, 2) mega_kernel(Params p, int ph_lo, int ph_hi) {
  __shared__ __attribute__((aligned(16))) char lds[LDS_BYTES];
  __shared__ u32x4 xb_words;
#ifndef REP_MASK
#define REP_MASK 0
#endif
  if (ph_lo < 0) cg::this_grid().sync();
  if (threadIdx.x == 0) xb_words = (u32x4){0u, 0u, 0u, 0u};
  __syncthreads();
  XcdBarrier xb; xb.bar = p.bar; xb.x = 0; xb.st = (volatile LAS unsigned*)&xb_words;
  if (ph_hi - ph_lo > 1) xb = xcd_barrier_post(p.bar, (volatile LAS unsigned*)&xb_words);
  for (int ph = ph_lo; ph < ph_hi; ++ph) {
    const int reps = (REP_MASK && ph >= 1 && ph <= 36 && ((REP_MASK >> ((ph - 1) % 9)) & 1)) ? 2 : 1;
    for (int r = 0; r < reps; ++r) {
      run_phase(p, ph, blockIdx.x, gridDim.x, lds);
      if (r + 1 < reps || ph + 1 < ph_hi) xcd_barrier(xb);
#ifdef EXTRA_SYNC
      for (int e = 0; e < EXTRA_SYNC; ++e) xcd_barrier(xb);
#endif
    }
  }
}

extern "C" void kernel_launch(void* const* d_in, const int* in_sizes, int n_in, void* d_out, int out_size, void* d_ws, size_t ws_size,
                              hipStream_t stream) {
  Params p{};
  const float** f = (const float**)&p;
  for (int i = 0; i < 21; ++i) f[i] = (const float*)d_in[i];
  p.out = (float*)d_out;
  char* w = (char*)d_ws; size_t off = 0;
  auto take = [&](size_t bytes) { char* r = w + off; off += (bytes + 255) & ~(size_t)255; return r; };
  p.Y = (float*)take((size_t)512 * 1024 * 4);
  p.ACT = (bf16_t*)take((size_t)NROWS * 1024 * 2);
  p.P = (bf16_t*)take((size_t)NROWS * PW * 2);
  p.Qm = (bf16_t*)take((size_t)NROWS * 384 * 2);
  p.Km = (bf16_t*)take((size_t)8 * 16640 * 96 * 2);
  p.Vm = (bf16_t*)take((size_t)8 * 16640 * 64 * 2);
  p.Ksum = (float*)take((size_t)2 * 260 * 4 * 4096 * 4);
  p.St = (bf16_t*)take((size_t)2 * 260 * 4 * 4096 * 2);
  p.W = (bf16_t*)take((size_t)4 * W_LAYER * 2);
  p.mod = (float*)take((size_t)4 * 3 * 6144 * 4);
  p.rope64 = (float*)take(256 * 16 * 2 * 4);
  p.rope32 = (float*)take(256 * 8 * 2 * 4);
  p.bar = (unsigned*)take(XCD_BAR_WORDS * 4);
  if (off > ws_size) { fprintf(stderr, "workspace too small: need %zu have %zu\n", off, ws_size); return; }
#if MULTI_LAUNCH
  for (int ph = 0; ph < 38; ++ph) hipLaunchKernelGGL(mega_kernel, dim3(512), dim3(256), 0, stream, p, ph, ph + 1);
#else
  static int grid_blocks = 0;
  if (!grid_blocks) {
    int dev = 0, cus = 0, per_cu = 0;
    hipGetDevice(&dev);
    hipDeviceGetAttribute(&cus, hipDeviceAttributeMultiprocessorCount, dev);
    hipOccupancyMaxActiveBlocksPerMultiprocessor(&per_cu, mega_kernel, 256, 0);
    if (per_cu > 2) per_cu = 2;
    grid_blocks = cus * per_cu;
  }
  hipMemsetAsync(p.bar, 0, XCD_BAR_WORDS * 4, stream);
  int lo = 0, hi = 38;
  void* args[] = {&p, &lo, &hi};
  hipError_t e = hipLaunchCooperativeKernel((void*)mega_kernel, dim3(grid_blocks), dim3(256), args, 0, stream);
  if (e != hipSuccess) fprintf(stderr, "cooperative launch failed: %s (grid %d)\n", hipGetErrorString(e), grid_blocks);
#endif
}
```

```cpp
#include <hip/hip_runtime.h>
#include <hip/hip_cooperative_groups.h>
#include <cstdio>
#include <cstdint>
namespace cg = cooperative_groups;

#ifndef MULTI_LAUNCH
#define MULTI_LAUNCH 0
#endif

typedef unsigned short bf16_t;
typedef short bf16x8 __attribute__((ext_vector_type(8)));
typedef short s16x4 __attribute__((ext_vector_type(4)));
typedef float f32x4 __attribute__((ext_vector_type(4)));
typedef float f32x2 __attribute__((ext_vector_type(2)));
typedef __bf16 bf2_t __attribute__((ext_vector_type(2)));
typedef unsigned u32x4 __attribute__((ext_vector_type(4)));
typedef unsigned u32x2 __attribute__((ext_vector_type(2)));
#define MK4(a,b,c,d) ((u32x4){(a),(b),(c),(d)})
#define MK2(a,b) ((u32x2){(a),(b)})

#define NROWS 33280
#define NLAT 32768
#define PW 3072
#define LOG2E 1.4426950408889634f
#define LDS_BYTES 73728

#define C_CQ 0
#define C_CKV 256
#define C_KR 384
#define C_RQ 416
#define C_RK 672
#define C_RV 928
#define C_RGF 1184
#define C_RGB 1440
#define C_NQ 1696
#define C_NK 1952
#define C_NV 2208
#define C_SQ 2464
#define C_SK 2720
#define C_SV 2848

#define WO_IN 0
#define WO_UQ 3145728
#define WO_UKV 3244032
#define WO_OUT 3309568
#define WO_13 4358144
#define WO_2 10125312
#define W_LAYER 13008896

struct Params {
  const float *x, *c, *ctx, *c_ctx, *ada_w, *ada_b, *norm1_g, *w_in, *mla_q_norm, *mla_w_uq, *mla_kv_norm, *mla_w_ukv,
      *ret_decay, *na_rpb, *swa_sink, *w_out, *norm2_g, *ffn_w1, *ffn_w3, *ffn_w2, *final_g;
  float* out;
  float* Y;
  bf16_t* ACT;
  bf16_t* P;
  bf16_t *Qm, *Km, *Vm;
  float* Ksum;
  bf16_t* St;
  bf16_t* W;
  float* mod;
  float* rope64;
  float* rope32;
  unsigned* bar;
};

__device__ __forceinline__ int otid() { int t = threadIdx.x; asm volatile("" : "+v"(t)); return t; }
typedef __amdgpu_buffer_rsrc_t rsrc_t;
__device__ __forceinline__ rsrc_t mkbuf(const void* base) { return __builtin_amdgcn_make_buffer_rsrc((void*)base, 0, 0x7fffffff, 0x00020000); }
__device__ __forceinline__ u32x4 bload16(rsrc_t r, unsigned voff, unsigned soff) { return __builtin_amdgcn_raw_buffer_load_b128(r, voff, soff, 0); }
__device__ __forceinline__ u32x2 bload8(rsrc_t r, unsigned voff, unsigned soff) { return __builtin_amdgcn_raw_buffer_load_b64(r, voff, soff, 0); }
__device__ __forceinline__ float bf2f(bf16_t h) { return __uint_as_float(((unsigned)h) << 16); }
__device__ __forceinline__ unsigned pack2(float a, float b) { f32x2 v = {a, b}; bf2_t r = __builtin_convertvector(v, bf2_t); return __builtin_bit_cast(unsigned, r); }
__device__ __forceinline__ bf16_t f2bf(float a) { return (bf16_t)(pack2(a, 0.f) & 0xffffu); }
__device__ __forceinline__ float lo_f(unsigned u) { return __uint_as_float(u << 16); }
__device__ __forceinline__ float hi_f(unsigned u) { return __uint_as_float(u & 0xffff0000u); }
__device__ __forceinline__ f32x4 mfma16(bf16x8 a, bf16x8 b, f32x4 c) { return __builtin_amdgcn_mfma_f32_16x16x32_bf16(a, b, c, 0, 0, 0); }
typedef __attribute__((address_space(3))) s16x4 lds_s16x4;
__device__ __forceinline__ s16x4 tr_read(const bf16_t* p) { return __builtin_amdgcn_ds_read_tr16_b64_v4i16((lds_s16x4*)p); }
__device__ __forceinline__ bf16x8 cat8(s16x4 a, s16x4 b) { bf16x8 r; r[0]=a[0]; r[1]=a[1]; r[2]=a[2]; r[3]=a[3]; r[4]=b[0]; r[5]=b[1]; r[6]=b[2]; r[7]=b[3]; return r; }
__device__ __forceinline__ float wave_sum(float v) {
  v += __shfl_xor(v, 32); v += __shfl_xor(v, 16); v += __shfl_xor(v, 8); v += __shfl_xor(v, 4); v += __shfl_xor(v, 2); v += __shfl_xor(v, 1); return v;
}
__device__ __forceinline__ float silu_f(float a) { return a * __builtin_amdgcn_rcpf(1.f + __expf(-a)); }

__device__ __forceinline__ float* xrow(const Params& p, int row) { return row < NLAT ? p.out + (size_t)row * 1024 : p.Y + (size_t)(row - NLAT) * 1024; }
__device__ __forceinline__ const float* xsrc(const Params& p, int l, int row) {
  if (l == 0) return row < NLAT ? p.x + (size_t)row * 1024 : p.ctx + (size_t)(row - NLAT) * 1024;
  return xrow(p, row);
}
__device__ __forceinline__ int modv(int row) { return row < 16384 ? 0 : (row < NLAT ? 1 : 2); }

__device__ void transpose_tile(const float* __restrict__ src, int N, int k0, int n0, bf16_t* __restrict__ dst, int ldd, int mode,
                               const float* __restrict__ kscale, char* lds) {
  bf16_t(*t)[66] = (bf16_t(*)[66])lds;
  const int tid = otid();
  __syncthreads();
#pragma unroll 4
  for (int i = 0; i < 16; ++i) {
    int kk = i * 4 + (tid >> 6), nn = tid & 63;
    float v = (n0 + nn < N) ? src[(size_t)(k0 + kk) * N + n0 + nn] : 0.f;
    if (kscale) v *= kscale[k0 + kk];
    t[kk][nn] = f2bf(v);
  }
  __syncthreads();
  int nn = tid >> 2, kq = tid & 3;
  int n = n0 + nn;
  if (n < N) {
    int row = mode == 0 ? n : ((n >> 4) * 32 + (n & 15) + (mode == 2 ? 16 : 0));
    unsigned w[8];
#pragma unroll
    for (int e = 0; e < 8; ++e) w[e] = (unsigned)t[kq * 16 + 2 * e][nn] | ((unsigned)t[kq * 16 + 2 * e + 1][nn] << 16);
    u32x4* d = (u32x4*)(dst + (size_t)row * ldd + k0 + kq * 16);
    d[0] = MK4(w[0], w[1], w[2], w[3]);
    d[1] = MK4(w[4], w[5], w[6], w[7]);
  }
}

__device__ void prologue_phase(const Params& p, int bid, int nb, char* lds) {
  const int tid = otid();
  for (int it = bid; it < 4 * 3160; it += nb) {
    int l = it / 3160, r = it % 3160;
    bf16_t* W = p.W + (size_t)l * W_LAYER;
    if (r < 752) { int kt = r / 47, nt = r % 47; transpose_tile(p.w_in + (size_t)l * 1024 * 2976, 2976, kt * 64, nt * 64, W + WO_IN, 1024, 0, nullptr, lds); continue; }
    r -= 752;
    if (r < 24) { int kt = r / 6, nt = r % 6; transpose_tile(p.mla_w_uq + (size_t)l * 256 * 384, 384, kt * 64, nt * 64, W + WO_UQ, 256, 0, p.mla_q_norm + l * 256, lds); continue; }
    r -= 24;
    if (r < 16) { int kt = r / 8, nt = r % 8; transpose_tile(p.mla_w_ukv + (size_t)l * 128 * 512, 512, kt * 64, nt * 64, W + WO_UKV, 128, 0, p.mla_kv_norm + l * 128, lds); continue; }
    r -= 16;
    if (r < 256) { int kt = r / 16, nt = r % 16; transpose_tile(p.w_out + (size_t)l * 1024 * 1024, 1024, kt * 64, nt * 64, W + WO_OUT, 1024, 0, nullptr, lds); continue; }
    r -= 256;
    if (r < 704) { int kt = r / 44, nt = r % 44; transpose_tile(p.ffn_w1 + (size_t)l * 1024 * 2816, 2816, kt * 64, nt * 64, W + WO_13, 1024, 1, nullptr, lds); continue; }
    r -= 704;
    if (r < 704) { int kt = r / 44, nt = r % 44; transpose_tile(p.ffn_w3 + (size_t)l * 1024 * 2816, 2816, kt * 64, nt * 64, W + WO_13, 1024, 2, nullptr, lds); continue; }
    r -= 704;
    { int kt = r / 16, nt = r % 16; transpose_tile(p.ffn_w2 + (size_t)l * 2816 * 1024, 1024, kt * 64, nt * 64, W + WO_2, 2816, 0, nullptr, lds); }
  }
  for (int it = bid; it < 4 * 48; it += nb) {
    int l = it / 48, part = it % 48;
    u32x4* d = (u32x4*)(p.W + (size_t)l * W_LAYER + WO_IN + (size_t)2976 * 1024);
    d[part * 256 + tid] = MK4(0, 0, 0, 0);
  }
  for (int it = bid; it < 4 * 96; it += nb) {
    int l = it / 96, cb = it % 96;
    float* s = (float*)lds;
    float* red = s + 3 * 1024;
    __syncthreads();
    for (int i = tid; i < 3072; i += 256) {
      int v = i >> 10, k = i & 1023;
      float cv = v < 2 ? p.c[v * 1024 + k] : p.c_ctx[k];
      s[i] = silu_f(cv);
    }
    __syncthreads();
    int col = cb * 64 + (tid & 63), kp = tid >> 6;
    const float* w = p.ada_w + (size_t)l * 1024 * 6144 + (size_t)(kp * 256) * 6144 + col;
    float a0 = 0.f, a1 = 0.f, a2 = 0.f;
#pragma unroll 8
    for (int k = 0; k < 256; ++k) {
      float wv = w[(size_t)k * 6144];
      a0 += s[kp * 256 + k] * wv; a1 += s[1024 + kp * 256 + k] * wv; a2 += s[2048 + kp * 256 + k] * wv;
    }
    red[(kp * 3 + 0) * 64 + (tid & 63)] = a0; red[(kp * 3 + 1) * 64 + (tid & 63)] = a1; red[(kp * 3 + 2) * 64 + (tid & 63)] = a2;
    __syncthreads();
    if (tid < 192) {
      int v = tid >> 6, cc = tid & 63;
      float sum = red[(0 * 3 + v) * 64 + cc] + red[(1 * 3 + v) * 64 + cc] + red[(2 * 3 + v) * 64 + cc] + red[(3 * 3 + v) * 64 + cc];
      p.mod[(size_t)(l * 3 + v) * 6144 + cb * 64 + cc] = sum + p.ada_b[l * 6144 + cb * 64 + cc];
    }
  }
  if (bid == (nb > 1 ? 1 : 0)) {
    int pos = tid;
    for (int i = 0; i < 16; ++i) {
      float inv = exp2f(-(float)(2 * i) / 32.f * 13.287712379549449f);
      float ang = (float)pos * inv;
      float n = rintf(ang * 0.15915494309189535f);
      float r = fmaf(-n, 6.28318548202514648f, ang); r = fmaf(-n, -1.74845553146951715e-07f, r);
      p.rope64[(pos * 16 + i) * 2] = cosf(r); p.rope64[(pos * 16 + i) * 2 + 1] = sinf(r);
    }
    for (int i = 0; i < 8; ++i) {
      float inv = exp2f(-(float)(2 * i) / 16.f * 13.287712379549449f);
      float ang = (float)pos * inv;
      float n = rintf(ang * 0.15915494309189535f);
      float r = fmaf(-n, 6.28318548202514648f, ang); r = fmaf(-n, -1.74845553146951715e-07f, r);
      p.rope32[(pos * 8 + i) * 2] = cosf(r); p.rope32[(pos * 8 + i) * 2 + 1] = sinf(r);
    }
  }
}

__device__ void norm_phase(const Params& p, int l, int which, int bid, int nb) {
  const int wave = otid() >> 6, lane = otid() & 63;
  const float* g = (which == 0 ? p.norm1_g : p.norm2_g) + l * 1024;
  for (int row = bid * 4 + wave; row < NROWS; row += nb * 4) {
    const float* src = which == 0 ? xsrc(p, l, row) : xrow(p, row);
    const float* md = p.mod + (size_t)(l * 3 + modv(row)) * 6144 + which * 3072;
    f32x4 v[4], g4[4], sh[4], sc[4]; float ss = 0.f;
#pragma unroll
    for (int i = 0; i < 4; ++i) {
      int col = i * 256 + lane * 4;
      v[i] = *(const f32x4*)(src + col); g4[i] = *(const f32x4*)(g + col); sh[i] = *(const f32x4*)(md + col); sc[i] = *(const f32x4*)(md + 1024 + col);
    }
#pragma unroll
    for (int i = 0; i < 4; ++i) ss += v[i][0] * v[i][0] + v[i][1] * v[i][1] + v[i][2] * v[i][2] + v[i][3] * v[i][3];
    ss = wave_sum(ss);
    float rinv = rsqrtf(ss * (1.f / 1024.f) + 1e-6f);
#pragma unroll
    for (int i = 0; i < 4; ++i) {
      int col = i * 256 + lane * 4;
      f32x4 y;
#pragma unroll
      for (int j = 0; j < 4; ++j) y[j] = (v[i][j] * rinv * g4[i][j]) * (1.f + sc[i][j]) + sh[i][j];
      *(u32x2*)(p.ACT + (size_t)row * 1024 + col) = MK2(pack2(y[0], y[1]), pack2(y[2], y[3]));
    }
  }
}

__device__ void final_norm_phase(const Params& p, int bid, int nb) {
  const int wave = otid() >> 6, lane = otid() & 63;
  for (int row = bid * 4 + wave; row < NLAT; row += nb * 4) {
    float* src = p.out + (size_t)row * 1024;
    f32x4 v[4]; float ss = 0.f;
#pragma unroll
    for (int i = 0; i < 4; ++i) { v[i] = *(const f32x4*)(src + i * 256 + lane * 4); ss += v[i][0] * v[i][0] + v[i][1] * v[i][1] + v[i][2] * v[i][2] + v[i][3] * v[i][3]; }
    ss = wave_sum(ss);
    float rinv = rsqrtf(ss * (1.f / 1024.f) + 1e-6f);
#pragma unroll
    for (int i = 0; i < 4; ++i) {
      int col = i * 256 + lane * 4;
      f32x4 g4 = *(const f32x4*)(p.final_g + col);
      f32x4 y;
#pragma unroll
      for (int j = 0; j < 4; ++j) y[j] = v[i][j] * rinv * g4[j];
      *(f32x4*)(src + col) = y;
    }
  }
}

#define GSTR 64
template <class Epi>
__device__ __forceinline__ void gemm_tile(const bf16_t* __restrict__ A, int lda, const bf16_t* __restrict__ Bt, int ldb, int K, int m0, int n0,
                                          const Epi& epi, char* lds) {
  bf16_t* As = (bf16_t*)lds;
  bf16_t* Bs = As + 2 * 128 * GSTR;
  const int tid = otid(), wave = tid >> 6, lane = tid & 63, wm = wave >> 1, wn = wave & 1, lr = lane & 15, quad = lane >> 4;
  const int lrow = tid >> 3, lch = tid & 7, wch = lch ^ (lrow & 7);
  rsrc_t gar = mkbuf(A + (size_t)m0 * lda), gbr = mkbuf(Bt + (size_t)n0 * ldb);
  unsigned aoff[4], boff[4];
#pragma unroll
  for (int i = 0; i < 4; ++i) { aoff[i] = (unsigned)((lrow + 32 * i) * lda + lch * 8) * 2u; boff[i] = (unsigned)((lrow + 32 * i) * ldb + lch * 8) * 2u; }
  u32x4 ra0[4], rb0[4], ra1[4], rb1[4];
  f32x4 acc[4][4];
#pragma unroll
  for (int i = 0; i < 4; ++i)
#pragma unroll
    for (int j = 0; j < 4; ++j) acc[i][j] = (f32x4){0.f, 0.f, 0.f, 0.f};
  const int nk = K >> 6;
#pragma unroll
  for (int i = 0; i < 4; ++i) { ra0[i] = bload16(gar, aoff[i], 0); rb0[i] = bload16(gbr, boff[i], 0); }
#pragma unroll
  for (int i = 0; i < 4; ++i) { ra1[i] = bload16(gar, aoff[i], 128u); rb1[i] = bload16(gbr, boff[i], 128u); }
  __syncthreads();
#pragma unroll
  for (int i = 0; i < 4; ++i) { *(u32x4*)(As + (lrow + 32 * i) * GSTR + wch * 8) = ra0[i]; *(u32x4*)(Bs + (lrow + 32 * i) * GSTR + wch * 8) = rb0[i]; }
  __syncthreads();
  const int rsw = (quad ^ (lr & 7)) * 8;
  const bf16_t* as0 = As + (wm * 64 + lr) * GSTR;
  const bf16_t* bs0 = Bs + (wn * 64 + lr) * GSTR;
#define GEMM_COMPUTE(BUF)                                                                                         \
  {                                                                                                               \
    const bf16_t* as = as0 + (BUF) * 128 * GSTR;                                                                  \
    const bf16_t* bs = bs0 + (BUF) * 128 * GSTR;                                                                  \
    _Pragma("unroll") for (int ks = 0; ks < 2; ++ks) {                                                            \
      bf16x8 af[4], bfr[4];                                                                                       \
      _Pragma("unroll") for (int i = 0; i < 4; ++i) {                                                             \
        af[i] = *(const bf16x8*)(as + i * 16 * GSTR + (rsw ^ (ks * 32)));                                         \
        bfr[i] = *(const bf16x8*)(bs + i * 16 * GSTR + (rsw ^ (ks * 32)));                                        \
      }                                                                                                           \
      _Pragma("unroll") for (int mi = 0; mi < 4; ++mi)                                                            \
        _Pragma("unroll") for (int ni = 0; ni < 4; ++ni) acc[mi][ni] = mfma16(bfr[ni], af[mi], acc[mi][ni]);      \
    }                                                                                                             \
  }
  for (int kt = 0; kt < nk; kt += 2) {
    if (kt + 2 < nk) {
      const unsigned so = (unsigned)(kt + 2) * 128u;
#pragma unroll
      for (int i = 0; i < 4; ++i) { ra0[i] = bload16(gar, aoff[i], so); rb0[i] = bload16(gbr, boff[i], so); }
    }
    GEMM_COMPUTE(0)
#pragma unroll
    for (int i = 0; i < 4; ++i) { *(u32x4*)(As + 128 * GSTR + (lrow + 32 * i) * GSTR + wch * 8) = ra1[i]; *(u32x4*)(Bs + 128 * GSTR + (lrow + 32 * i) * GSTR + wch * 8) = rb1[i]; }
    __syncthreads();
    if (kt + 3 < nk) {
      const unsigned so = (unsigned)(kt + 3) * 128u;
#pragma unroll
      for (int i = 0; i < 4; ++i) { ra1[i] = bload16(gar, aoff[i], so); rb1[i] = bload16(gbr, boff[i], so); }
    }
    GEMM_COMPUTE(1)
    if (kt + 2 < nk) {
#pragma unroll
      for (int i = 0; i < 4; ++i) { *(u32x4*)(As + (lrow + 32 * i) * GSTR + wch * 8) = ra0[i]; *(u32x4*)(Bs + (lrow + 32 * i) * GSTR + wch * 8) = rb0[i]; }
    }
    __syncthreads();
  }
#undef GEMM_COMPUTE
  epi(acc, m0 + wm * 64, n0 + wn * 64, lr, quad);
}

__device__ __forceinline__ void tile_coord(int t, int nN, int& pm, int& pn) {
  const int nM = 260, GM = 8;
  int gsz = GM * nN; int g = t / gsz, r = t % gsz; int fm = g * GM; int gm = min(GM, nM - fm);
  pm = fm + (r % gm); pn = r / gm;
}
__device__ __forceinline__ int xcd_tile(int round, int bid, int nb) { return round * nb + (bid & 7) * (nb >> 3) + (bid >> 3); }

struct EpiWin {
  bf16_t* P;
  __device__ __forceinline__ void operator()(f32x4 (&acc)[4][4], int mb, int nbs, int lr, int quad) const {
#pragma unroll
    for (int mi = 0; mi < 4; ++mi) {
      bf16_t* rp = P + (size_t)(mb + mi * 16 + lr) * PW + nbs + quad * 4;
#pragma unroll
      for (int ni = 0; ni < 4; ++ni) *(u32x2*)(rp + ni * 16) = MK2(pack2(acc[mi][ni][0], acc[mi][ni][1]), pack2(acc[mi][ni][2], acc[mi][ni][3]));
    }
  }
};

struct EpiResid {
  const Params* p; int l; int goff; int use_src;
  __device__ __forceinline__ void operator()(f32x4 (&acc)[4][4], int mb, int nbs, int lr, int quad) const {
#pragma unroll
    for (int mi = 0; mi < 4; ++mi) {
      int row = mb + mi * 16 + lr;
      const float* gate = p->mod + (size_t)(l * 3 + modv(row)) * 6144 + goff;
      const float* src = use_src ? xsrc(*p, l, row) : xrow(*p, row);
      float* dst = xrow(*p, row);
#pragma unroll
      for (int ni = 0; ni < 4; ++ni) {
        int col = nbs + ni * 16 + quad * 4;
        f32x4 g4 = *(const f32x4*)(gate + col), x4 = *(const f32x4*)(src + col);
#pragma unroll
        for (int j = 0; j < 4; ++j) x4[j] += g4[j] * acc[mi][ni][j];
        *(f32x4*)(dst + col) = x4;
      }
    }
  }
};

struct EpiFfn1 {
  bf16_t* U;
  __device__ __forceinline__ void operator()(f32x4 (&acc)[4][4], int mb, int nbs, int lr, int quad) const {
#pragma unroll
    for (int mi = 0; mi < 4; ++mi) {
      int row = mb + mi * 16 + lr;
#pragma unroll
      for (int pr = 0; pr < 2; ++pr) {
        int ucol = ((nbs + pr * 32) >> 5) * 16 + quad * 4;
        float u[4];
#pragma unroll
        for (int j = 0; j < 4; ++j) u[j] = silu_f(acc[mi][2 * pr][j]) * acc[mi][2 * pr + 1][j];
        *(u32x2*)(U + (size_t)row * 2816 + ucol) = MK2(pack2(u[0], u[1]), pack2(u[2], u[3]));
      }
    }
  }
};

struct EpiUq {
  const Params* p;
  __device__ __forceinline__ void operator()(f32x4 (&acc)[4][4], int mb, int nbs, int lr, int quad) const {
#pragma unroll
    for (int mi = 0; mi < 4; ++mi) {
      int row = mb + mi * 16 + lr;
      const bf16_t* cq = p->P + (size_t)row * PW + C_CQ + quad * 64;
      float ss = 0.f;
#pragma unroll
      for (int i = 0; i < 8; ++i) {
        u32x4 w = *(const u32x4*)(cq + i * 8);
        float a;
        a = lo_f(w.x); ss += a * a; a = hi_f(w.x); ss += a * a; a = lo_f(w.y); ss += a * a; a = hi_f(w.y); ss += a * a;
        a = lo_f(w.z); ss += a * a; a = hi_f(w.z); ss += a * a; a = lo_f(w.w); ss += a * a; a = hi_f(w.w); ss += a * a;
      }
      ss += __shfl_xor(ss, 16); ss += __shfl_xor(ss, 32);
      float rinv = rsqrtf(ss * (1.f / 256.f) + 1e-6f);
      bool latent = row < NLAT;
      int tok = row & 16383, prow = tok >> 6, pcol = tok & 63;
#pragma unroll
      for (int ni = 0; ni < 4; ++ni) {
        int col = nbs + ni * 16 + quad * 4;
        int sub = ((nbs >> 4) + ni) % 6;
        float v[4];
#pragma unroll
        for (int j = 0; j < 4; ++j) v[j] = acc[mi][ni][j] * rinv;
        if (sub >= 4) {
          float o[4];
#pragma unroll
          for (int j = 0; j < 4; ++j) o[j] = __shfl_xor(v[j], 32);
          if (latent) {
            int pos = sub == 4 ? prow : pcol;
#pragma unroll
            for (int j = 0; j < 4; ++j) {
              int i = (quad & 1) * 4 + j;
              float cs = p->rope32[(pos * 8 + i) * 2], sn = p->rope32[(pos * 8 + i) * 2 + 1];
              v[j] = quad < 2 ? v[j] * cs - o[j] * sn : v[j] * cs + o[j] * sn;
            }
          }
        }
        *(u32x2*)(p->Qm + (size_t)row * 384 + col) = MK2(pack2(v[0], v[1]), pack2(v[2], v[3]));
      }
    }
  }
};

__device__ __forceinline__ void mla_key_of_row(int row, int& b, int& key) {
  if (row < NLAT) { b = row >> 14; key = row & 16383; } else { b = (row - NLAT) >> 8; key = 16384 + ((row - NLAT) & 255); }
}

struct EpiUkv {
  const Params* p;
  __device__ __forceinline__ void operator()(f32x4 (&acc)[4][4], int mb, int nbs, int lr, int quad) const {
    int h = nbs >> 7, isv = (nbs >> 6) & 1;
#pragma unroll
    for (int mi = 0; mi < 4; ++mi) {
      int row = mb + mi * 16 + lr;
      const bf16_t* ck = p->P + (size_t)row * PW + C_CKV + quad * 32;
      float ss = 0.f;
#pragma unroll
      for (int i = 0; i < 4; ++i) {
        u32x4 w = *(const u32x4*)(ck + i * 8);
        float a;
        a = lo_f(w.x); ss += a * a; a = hi_f(w.x); ss += a * a; a = lo_f(w.y); ss += a * a; a = hi_f(w.y); ss += a * a;
        a = lo_f(w.z); ss += a * a; a = hi_f(w.z); ss += a * a; a = lo_f(w.w); ss += a * a; a = hi_f(w.w); ss += a * a;
      }
      ss += __shfl_xor(ss, 16); ss += __shfl_xor(ss, 32);
      float rinv = rsqrtf(ss * (1.f / 128.f) + 1e-6f);
      int b, key; mla_key_of_row(row, b, key);
      size_t kidx = (size_t)(b * 4 + h) * 16640 + key;
      bf16_t* dst = isv ? p->Vm + kidx * 64 : p->Km + kidx * 96;
#pragma unroll
      for (int ni = 0; ni < 4; ++ni) {
        f32x4 a = acc[mi][ni];
        *(u32x2*)(dst + ni * 16 + quad * 4) = MK2(pack2(a[0] * rinv, a[1] * rinv), pack2(a[2] * rinv, a[3] * rinv));
      }
    }
  }
};

__device__ __forceinline__ void rope64_pair_vals(const bf16_t* base, int pr, int prow, int pcol, const float* rope64, bool rotate, float (&o1)[8], float (&o2)[8], int& c0) {
  c0 = pr < 2 ? pr : pr + 2;
  int pos = pr < 2 ? prow : pcol, i0 = (pr & 1) * 8;
  u32x4 a = *(const u32x4*)(base + c0 * 8), b = *(const u32x4*)(base + (c0 + 2) * 8);
  unsigned aw[4] = {a.x, a.y, a.z, a.w}, bw[4] = {b.x, b.y, b.z, b.w};
#pragma unroll
  for (int e = 0; e < 8; ++e) {
    float x1 = (e & 1) ? hi_f(aw[e >> 1]) : lo_f(aw[e >> 1]);
    float x2 = (e & 1) ? hi_f(bw[e >> 1]) : lo_f(bw[e >> 1]);
    if (rotate) {
      float cs = rope64[(pos * 16 + i0 + e) * 2], sn = rope64[(pos * 16 + i0 + e) * 2 + 1];
      o1[e] = x1 * cs - x2 * sn; o2[e] = x2 * cs + x1 * sn;
    } else { o1[e] = x1; o2[e] = x2; }
  }
}
__device__ __forceinline__ u32x4 pack8(const float (&o)[8]) { return MK4(pack2(o[0], o[1]), pack2(o[2], o[3]), pack2(o[4], o[5]), pack2(o[6], o[7])); }

#define VSTR 80
__device__ void ret_prep_item(const Params& p, int l, int c, int h, char* lds) {
  bf16_t* vL = (bf16_t*)lds;
  bf16_t* kfL = vL + 128 * VSTR;
  bf16_t* kbL = kfL + 128 * VSTR;
  const int tid = otid(), wave = tid >> 6, lane = tid & 63, lr = lane & 15, quad = lane >> 4;
  const bool latent = c < 256;
  const int r0 = c * 128;
  float df = p.ret_decay[l * 8 + h], db = p.ret_decay[l * 8 + 4 + h];
  float lgf = -log1pf(__expf(-df)) * LOG2E, lgb = -log1pf(__expf(-db)) * LOG2E;
  __syncthreads();
#pragma unroll
  for (int i = 0; i < 2; ++i) {
    int idx = tid + 256 * i, r = idx >> 2, pr = idx & 3;
    int row = r0 + r, tok = row & 16383, prow = tok >> 6, pcol = tok & 63;
    bf16_t* kb = p.P + (size_t)row * PW + C_RK + h * 64;
    float o1[8], o2[8]; int c0;
    rope64_pair_vals(kb, pr, prow, pcol, p.rope64, latent, o1, o2, c0);
    if (latent) { *(u32x4*)(kb + c0 * 8) = pack8(o1); *(u32x4*)(kb + (c0 + 2) * 8) = pack8(o2); }
    float wf = exp2f(lgf * (float)(127 - r)) * 0.125f, wb = exp2f(lgb * (float)r) * 0.125f;
    float t1[8], t2[8];
#pragma unroll
    for (int e = 0; e < 8; ++e) { t1[e] = o1[e] * wf; t2[e] = o2[e] * wf; }
    *(u32x4*)(kfL + r * VSTR + c0 * 8) = pack8(t1); *(u32x4*)(kfL + r * VSTR + (c0 + 2) * 8) = pack8(t2);
#pragma unroll
    for (int e = 0; e < 8; ++e) { t1[e] = o1[e] * wb; t2[e] = o2[e] * wb; }
    *(u32x4*)(kbL + r * VSTR + c0 * 8) = pack8(t1); *(u32x4*)(kbL + r * VSTR + (c0 + 2) * 8) = pack8(t2);
    if (latent) {
      bf16_t* qb = p.P + (size_t)row * PW + C_RQ + h * 64;
      rope64_pair_vals(qb, pr, prow, pcol, p.rope64, true, o1, o2, c0);
      *(u32x4*)(qb + c0 * 8) = pack8(o1); *(u32x4*)(qb + (c0 + 2) * 8) = pack8(o2);
    }
  }
#pragma unroll
  for (int i = 0; i < 4; ++i) {
    int idx = tid + 256 * i, r = idx >> 3, ch = idx & 7;
    *(u32x4*)(vL + r * VSTR + ch * 8) = *(const u32x4*)(p.P + (size_t)(r0 + r) * PW + C_RV + h * 64 + ch * 8);
  }
  __syncthreads();
  f32x4 acc[2][4];
#pragma unroll
  for (int d = 0; d < 2; ++d)
#pragma unroll
    for (int j = 0; j < 4; ++j) acc[d][j] = (f32x4){0.f, 0.f, 0.f, 0.f};
  const int roff = (quad * 4 + (lr >> 2)) * VSTR + (lr & 3) * 4;
#pragma unroll
  for (int ks = 0; ks < 4; ++ks) {
    bf16x8 af = cat8(tr_read(vL + ks * 32 * VSTR + roff + wave * 16), tr_read(vL + (ks * 32 + 16) * VSTR + roff + wave * 16));
#pragma unroll
    for (int dt = 0; dt < 4; ++dt) {
      bf16x8 b0 = cat8(tr_read(kfL + ks * 32 * VSTR + roff + dt * 16), tr_read(kfL + (ks * 32 + 16) * VSTR + roff + dt * 16));
      acc[0][dt] = mfma16(af, b0, acc[0][dt]);
      bf16x8 b1 = cat8(tr_read(kbL + ks * 32 * VSTR + roff + dt * 16), tr_read(kbL + (ks * 32 + 16) * VSTR + roff + dt * 16));
      acc[1][dt] = mfma16(af, b1, acc[1][dt]);
    }
  }
#pragma unroll
  for (int dir = 0; dir < 2; ++dir) {
    float* ks = p.Ksum + ((size_t)(dir * 260 + c) * 4 + h) * 4096;
#pragma unroll
    for (int dt = 0; dt < 4; ++dt)
#pragma unroll
      for (int j = 0; j < 4; ++j) ks[(wave * 16 + quad * 4 + j) * 64 + dt * 16 + lr] = acc[dir][dt][j];
  }
}

__device__ void swa_rope_item(const Params& p, int mt) {
  const int tid = otid();
  for (int idx = tid; idx < 128 * 24; idx += 256) {
    int r = idx / 24, pp = idx % 24;
    int row = mt * 128 + r, tok = row & 16383, prow = tok >> 6, pcol = tok & 63;
    int hd = pp >> 2, pr = pp & 3;
    bf16_t* base = p.P + (size_t)row * PW + (hd < 4 ? C_SQ + hd * 64 : C_SK + (hd - 4) * 64);
    float o1[8], o2[8]; int c0;
    rope64_pair_vals(base, pr, prow, pcol, p.rope64, true, o1, o2, c0);
    *(u32x4*)(base + c0 * 8) = pack8(o1); *(u32x4*)(base + (c0 + 2) * 8) = pack8(o2);
  }
}

__device__ void mla_krope_item(const Params& p, int m0, int h) {
  const int tid = otid();
  int row = m0 + (tid >> 1), part = tid & 1;
  bool latent = row < NLAT;
  int tok = row & 16383, pos = part == 0 ? (tok >> 6) : (tok & 63);
  const bf16_t* src = p.P + (size_t)row * PW + C_KR + part * 16;
  u32x4 a = *(const u32x4*)src, b = *(const u32x4*)(src + 8);
  unsigned aw[4] = {a.x, a.y, a.z, a.w}, bw[4] = {b.x, b.y, b.z, b.w};
  float o1[8], o2[8];
#pragma unroll
  for (int e = 0; e < 8; ++e) {
    float x1 = (e & 1) ? hi_f(aw[e >> 1]) : lo_f(aw[e >> 1]);
    float x2 = (e & 1) ? hi_f(bw[e >> 1]) : lo_f(bw[e >> 1]);
    if (latent) {
      float cs = p.rope32[(pos * 8 + e) * 2], sn = p.rope32[(pos * 8 + e) * 2 + 1];
      o1[e] = x1 * cs - x2 * sn; o2[e] = x2 * cs + x1 * sn;
    } else { o1[e] = x1; o2[e] = x2; }
  }
  int b_, key; mla_key_of_row(row, b_, key);
  bf16_t* dst = p.Km + ((size_t)(b_ * 4 + h) * 16640 + key) * 96 + 64 + part * 16;
  *(u32x4*)dst = pack8(o1); *(u32x4*)(dst + 8) = pack8(o2);
}

struct KVT { const bf16_t* k; const bf16_t* v; };

template <int DQK, bool SOFTMAX, bool PLAIN, class TileFn, class MaskFn>
__device__ __forceinline__ void attn_core(const bf16x8 (&qf)[2][DQK / 32], int ntiles, const TileFn& tf, int ldk, int ldv, const MaskFn& mk,
                                          f32x4 (&o)[4][2], float (&m)[2], float (&l)[2], char* lds) {
  constexpr int KSTR = DQK + 16, NKS = DQK / 32, KCH = DQK / 8, NKL = (64 * KCH) / 256;
  bf16_t* Kl = (bf16_t*)lds;
  bf16_t* Vl = Kl + 2 * 64 * KSTR;
  const int tid = otid(), wave = tid >> 6, lane = tid & 63, lr = lane & 15, quad = lane >> 4;
  constexpr bool MFMA_SUM = SOFTMAX && PLAIN;
  f32x4 lacc[2] = {(f32x4){0.f, 0.f, 0.f, 0.f}, (f32x4){0.f, 0.f, 0.f, 0.f}};
  u32x4 rk[NKL], rv[2];
  unsigned koff[NKL], voff[2];
#pragma unroll
  for (int i = 0; i < NKL; ++i) { int c = tid + i * 256, r = c / KCH, ch = c % KCH; koff[i] = (unsigned)(r * ldk + ch * 8) * 2u; }
#pragma unroll
  for (int i = 0; i < 2; ++i) { int c = tid + i * 256, r = c >> 3, ch = c & 7; voff[i] = (unsigned)(r * ldv + ch * 8) * 2u; }
  __syncthreads();
  {
    KVT kv = tf(0);
    rsrc_t kr = mkbuf(kv.k), vr = mkbuf(kv.v);
#pragma unroll
    for (int i = 0; i < NKL; ++i) rk[i] = bload16(kr, koff[i], 0);
#pragma unroll
    for (int i = 0; i < 2; ++i) rv[i] = bload16(vr, voff[i], 0);
#pragma unroll
    for (int i = 0; i < NKL; ++i) { int c = tid + i * 256, r = c / KCH, ch = c % KCH; *(u32x4*)(Kl + r * KSTR + ch * 8) = rk[i]; }
#pragma unroll
    for (int i = 0; i < 2; ++i) { int c = tid + i * 256, r = c >> 3, ch = c & 7; *(u32x4*)(Vl + r * VSTR + ch * 8) = rv[i]; }
  }
  __syncthreads();
  for (int t = 0; t < ntiles; ++t) {
    const int cur = t & 1;
    if (t + 1 < ntiles) {
      KVT kv = tf(t + 1);
      rsrc_t kr = mkbuf(kv.k), vr = mkbuf(kv.v);
#pragma unroll
      for (int i = 0; i < NKL; ++i) rk[i] = bload16(kr, koff[i], 0);
#pragma unroll
      for (int i = 0; i < 2; ++i) rv[i] = bload16(vr, voff[i], 0);
    }
    f32x4 s[4][2];
#pragma unroll
    for (int kt = 0; kt < 4; ++kt) { s[kt][0] = (f32x4){0.f, 0.f, 0.f, 0.f}; s[kt][1] = (f32x4){0.f, 0.f, 0.f, 0.f}; }
    const bf16_t* kb = Kl + cur * 64 * KSTR + lr * KSTR + quad * 8;
    {
      bf16x8 kfa[NKS][4];
#pragma unroll
      for (int ks = 0; ks < NKS; ++ks)
#pragma unroll
        for (int kt = 0; kt < 4; ++kt) kfa[ks][kt] = *(const bf16x8*)(kb + kt * 16 * KSTR + ks * 32);
#pragma unroll
      for (int ks = 0; ks < NKS; ++ks)
#pragma unroll
        for (int kt = 0; kt < 4; ++kt) {
          s[kt][0] = mfma16(kfa[ks][kt], qf[0][ks], s[kt][0]);
          s[kt][1] = mfma16(kfa[ks][kt], qf[1][ks], s[kt][1]);
        }
    }
    if (!PLAIN) {
#pragma unroll
      for (int kt = 0; kt < 4; ++kt)
#pragma unroll
        for (int qt = 0; qt < 2; ++qt)
#pragma unroll
          for (int j = 0; j < 4; ++j) s[kt][qt][j] = mk(t, wave * 32 + qt * 16 + lr, kt * 16 + quad * 4 + j, s[kt][qt][j]);
    }
    if (SOFTMAX) {
      const float sl2 = PLAIN ? mk(0, 0, 0, 1.0f) : 1.0f;
      float mnew[2], alpha[2];
#pragma unroll
      for (int qt = 0; qt < 2; ++qt) {
        float mx = fmaxf(fmaxf(s[0][qt][0], s[0][qt][1]), fmaxf(s[0][qt][2], s[0][qt][3]));
#pragma unroll
        for (int kt = 1; kt < 4; ++kt) mx = fmaxf(fmaxf(mx, s[kt][qt][0]), fmaxf(fmaxf(s[kt][qt][1], s[kt][qt][2]), s[kt][qt][3]));
        mx = fmaxf(mx, __shfl_xor(mx, 16)); mx = fmaxf(mx, __shfl_xor(mx, 32));
        if (PLAIN) mx *= sl2;
        mnew[qt] = fmaxf(m[qt], mx);
        alpha[qt] = __builtin_amdgcn_exp2f(m[qt] - mnew[qt]);
        m[qt] = mnew[qt];
      }
      if (__any((alpha[0] < 1.f) | (alpha[1] < 1.f))) {
#pragma unroll
        for (int qt = 0; qt < 2; ++qt) {
          l[qt] *= alpha[qt];
          if (MFMA_SUM) { lacc[qt][0] *= alpha[qt]; lacc[qt][1] *= alpha[qt]; lacc[qt][2] *= alpha[qt]; lacc[qt][3] *= alpha[qt]; }
#pragma unroll
          for (int dt = 0; dt < 4; ++dt)
#pragma unroll
            for (int j = 0; j < 4; ++j) o[dt][qt][j] *= alpha[qt];
        }
      }
#pragma unroll
      for (int qt = 0; qt < 2; ++qt) {
        float ls = 0.f;
        const float nm = -mnew[qt];
#pragma unroll
        for (int kt = 0; kt < 4; ++kt)
#pragma unroll
          for (int j = 0; j < 4; ++j) {
            float pv = __builtin_amdgcn_exp2f(PLAIN ? fmaf(s[kt][qt][j], sl2, nm) : s[kt][qt][j] + nm);
            s[kt][qt][j] = pv; if (!MFMA_SUM) ls += pv;
          }
        if (!MFMA_SUM) l[qt] += ls;
      }
    }
    bf16x8 pf[2][2];
#pragma unroll
    for (int qt = 0; qt < 2; ++qt)
#pragma unroll
      for (int kk = 0; kk < 2; ++kk) {
        unsigned w0 = pack2(s[2 * kk][qt][0], s[2 * kk][qt][1]), w1 = pack2(s[2 * kk][qt][2], s[2 * kk][qt][3]);
        unsigned w2 = pack2(s[2 * kk + 1][qt][0], s[2 * kk + 1][qt][1]), w3 = pack2(s[2 * kk + 1][qt][2], s[2 * kk + 1][qt][3]);
        u32x4 u = MK4(w0, w1, w2, w3);
        pf[qt][kk] = __builtin_bit_cast(bf16x8, u);
      }
    const bf16_t* vb = Vl + cur * 64 * VSTR + (quad * 4 + (lr >> 2)) * VSTR + (lr & 3) * 4;
    {
      bf16x8 vfa[2][4];
#pragma unroll
      for (int kk = 0; kk < 2; ++kk)
#pragma unroll
        for (int dt = 0; dt < 4; ++dt) vfa[kk][dt] = cat8(tr_read(vb + (kk * 32) * VSTR + dt * 16), tr_read(vb + (kk * 32 + 16) * VSTR + dt * 16));
#pragma unroll
      for (int kk = 0; kk < 2; ++kk)
#pragma unroll
        for (int dt = 0; dt < 4; ++dt) {
          o[dt][0] = mfma16(vfa[kk][dt], pf[0][kk], o[dt][0]);
          o[dt][1] = mfma16(vfa[kk][dt], pf[1][kk], o[dt][1]);
        }
      if (MFMA_SUM) {
        const bf16x8 ones = {(short)0x3f80, (short)0x3f80, (short)0x3f80, (short)0x3f80, (short)0x3f80, (short)0x3f80, (short)0x3f80, (short)0x3f80};
#pragma unroll
        for (int kk = 0; kk < 2; ++kk) { lacc[0] = mfma16(ones, pf[0][kk], lacc[0]); lacc[1] = mfma16(ones, pf[1][kk], lacc[1]); }
      }
    }
    if (t + 1 < ntiles) {
      const int nx = cur ^ 1;
#pragma unroll
      for (int i = 0; i < NKL; ++i) { int c = tid + i * 256, r = c / KCH, ch = c % KCH; *(u32x4*)(Kl + nx * 64 * KSTR + r * KSTR + ch * 8) = rk[i]; }
#pragma unroll
      for (int i = 0; i < 2; ++i) { int c = tid + i * 256, r = c >> 3, ch = c & 7; *(u32x4*)(Vl + nx * 64 * VSTR + r * VSTR + ch * 8) = rv[i]; }
    }
    __syncthreads();
  }
  if (MFMA_SUM) { const int quad_ = (otid() & 63) >> 4; l[0] = quad_ == 0 ? lacc[0][0] : 0.f; l[1] = quad_ == 0 ? lacc[1][0] : 0.f; }
}

__device__ __forceinline__ void attn_store(f32x4 (&o)[4][2], float (&m)[2], float (&l)[2], bool has_sink, float sink_l2, bf16_t* dst  , int ldo) {
  const int lane = otid() & 63, wave = otid() >> 6, lr = lane & 15, quad = lane >> 4;
#pragma unroll
  for (int qt = 0; qt < 2; ++qt) {
    float lt = l[qt]; lt += __shfl_xor(lt, 16); lt += __shfl_xor(lt, 32);
    if (has_sink) lt += exp2f(sink_l2 - m[qt]);
    float inv = 1.f / lt;
    bf16_t* rp = dst + (size_t)(wave * 32 + qt * 16 + lr) * ldo + quad * 4;
#pragma unroll
    for (int dt = 0; dt < 4; ++dt)
      *(u32x2*)(rp + dt * 16) = MK2(pack2(o[dt][qt][0] * inv, o[dt][qt][1] * inv), pack2(o[dt][qt][2] * inv, o[dt][qt][3] * inv));
  }
}

template <int NKS>
__device__ __forceinline__ void load_q(bf16x8 (&qf)[2][NKS], const bf16_t* q  , int ldq) {
  const int lane = otid() & 63, wave = otid() >> 6, lr = lane & 15, quad = lane >> 4;
#pragma unroll
  for (int qt = 0; qt < 2; ++qt)
#pragma unroll
    for (int ks = 0; ks < NKS; ++ks) qf[qt][ks] = *(const bf16x8*)(q + (size_t)(wave * 32 + qt * 16 + lr) * ldq + ks * 32 + quad * 8);
}

struct TileContig { const bf16_t* k; const bf16_t* v; size_t ks, vs;
  __device__ __forceinline__ KVT operator()(int t) const { return KVT{k + (size_t)t * ks, v + (size_t)t * vs}; } };
struct MaskScale { float sl2; __device__ __forceinline__ float operator()(int, int, int, float s) const { return s * sl2; } };

__device__ void mla_item(const Params& p, int b, int h, int qt128, bool ctxq, char* lds) {
  int r0 = ctxq ? NLAT + b * 256 + qt128 * 128 : b * 16384 + qt128 * 128;
  bf16x8 qf[2][3];
  load_q<3>(qf, p.Qm + (size_t)r0 * 384 + h * 96, 384);
  f32x4 o[4][2]; float m[2] = {-1e30f, -1e30f}, l[2] = {0.f, 0.f};
#pragma unroll
  for (int dt = 0; dt < 4; ++dt) { o[dt][0] = (f32x4){0.f, 0.f, 0.f, 0.f}; o[dt][1] = (f32x4){0.f, 0.f, 0.f, 0.f}; }
  int t0 = ctxq ? 256 : 0, nt = ctxq ? 4 : 260;
  size_t kbase = (size_t)(b * 4 + h) * 16640 + (size_t)t0 * 64;
  TileContig tf{p.Km + kbase * 96, p.Vm + kbase * 64, (size_t)64 * 96, (size_t)64 * 64};
  MaskScale mk{0.10206207261596575f * LOG2E};
  attn_core<96, true, true>(qf, nt, tf, 96, 64, mk, o, m, l, lds);
  attn_store(o, m, l, false, 0.f, p.ACT + (size_t)r0 * 1024 + h * 64, 1024);
}

struct NaTiles { const bf16_t* P; int b, h, lo, nw;
  __device__ __forceinline__ KVT operator()(int t) const {
    size_t row = t < nw ? (size_t)b * 16384 + (size_t)(lo + t) * 64 : (size_t)NLAT + b * 256 + (size_t)(t - nw) * 64;
    return KVT{P + row * PW + C_NK + h * 64, P + row * PW + C_NV + h * 64}; } };
struct NaMask { const float* rpb; int nw, lo, qr0; float sl2;
  __device__ __forceinline__ float operator()(int t, int qi, int kj, float s) const {
    if (t >= nw) return s * sl2;
    int qr = qr0 + (qi >> 6), qc = qi & 63, kr = lo + t;
    int r0q = min(max(qr - 4, 0), 248), c0 = min(max(qc - 8, 0), 48);
    bool ok = (kr >= r0q) & (kr < r0q + 8) & (kj >= c0) & (kj < c0 + 16);
    int dr = min(max(kr - qr + 7, 0), 14), dc = min(max(kj - qc, -15), 15) + 15;
    float bias = rpb[dr * 31 + dc];
    return ok ? s * sl2 + bias * LOG2E : -INFINITY; } };

__device__ void na_item(const Params& p, int l, int b, int h, int pair, char* lds) {
  float* rpbL = (float*)(lds + 60000);
  __syncthreads();
  for (int i = otid(); i < 465; i += 256) rpbL[i] = p.na_rpb[(size_t)(l * 4 + h) * 465 + i];
  int r0 = b * 16384 + pair * 128;
  bf16x8 qf[2][2];
  load_q<2>(qf, p.P + (size_t)r0 * PW + C_NQ + h * 64, PW);
  f32x4 o[4][2]; float m[2] = {-1e30f, -1e30f}, ls[2] = {0.f, 0.f};
#pragma unroll
  for (int dt = 0; dt < 4; ++dt) { o[dt][0] = (f32x4){0.f, 0.f, 0.f, 0.f}; o[dt][1] = (f32x4){0.f, 0.f, 0.f, 0.f}; }
  int qr0 = pair * 2;
  int lo = min(max(qr0 - 4, 0), 248), hi = min(max(qr0 + 1 - 4, 0), 248) + 7;
  int nw = hi - lo + 1;
  NaTiles tf{p.P, b, h, lo, nw};
  NaMask mk{rpbL, nw, lo, qr0, 0.125f * LOG2E};
  attn_core<64, true, false>(qf, nw + 4, tf, PW, PW, mk, o, m, ls, lds);
  attn_store(o, m, ls, false, 0.f, p.ACT + (size_t)r0 * 1024 + 512 + h * 64, 1024);
}

struct SwaTiles { const bf16_t* P; int b, kvh, nlo, nwt;
  __device__ __forceinline__ KVT operator()(int t) const {
    size_t row = t < nwt ? (size_t)b * 16384 + (size_t)(nlo * 128 + t * 64) : (size_t)NLAT + b * 256 + (size_t)(t - nwt) * 64;
    return KVT{P + row * PW + C_SK + kvh * 64, P + row * PW + C_SV + kvh * 64}; } };
struct SwaMask { int nwt, koff  ; float sl2;
  __device__ __forceinline__ float operator()(int t, int qi, int kj, float s) const {
    if (t >= nwt) return s * sl2;
    int delta = koff + t * 64 + kj - qi;
    return (delta <= 128 && delta >= -128) ? s * sl2 : -INFINITY; } };

__device__ void swa_item(const Params& p, int l, int b, int hq, int n, bool ctxq, char* lds) {
  int r0 = ctxq ? NLAT + b * 256 + n * 128 : b * 16384 + n * 128;
  bf16x8 qf[2][2];
  load_q<2>(qf, p.P + (size_t)r0 * PW + C_SQ + hq * 64, PW);
  f32x4 o[4][2]; float m[2] = {-1e30f, -1e30f}, ls[2] = {0.f, 0.f};
#pragma unroll
  for (int dt = 0; dt < 4; ++dt) { o[dt][0] = (f32x4){0.f, 0.f, 0.f, 0.f}; o[dt][1] = (f32x4){0.f, 0.f, 0.f, 0.f}; }
  int nlo = 0, nwt = 0;
  if (!ctxq) { nlo = max(n - 1, 0); int nhi = min(n + 1, 127); nwt = (nhi - nlo + 1) * 2; }
  SwaTiles tf{p.P, b, hq >> 1, nlo, nwt};
  SwaMask mk{nwt, (nlo - n) * 128, 0.125f * LOG2E};
  attn_core<64, true, false>(qf, nwt + 4, tf, PW, PW, mk, o, m, ls, lds);
  float sink = p.swa_sink[l * 4 + hq] * LOG2E;
  attn_store(o, m, ls, true, sink, p.ACT + (size_t)r0 * 1024 + 768 + hq * 64, 1024);
}

__device__ void na_ctx_item(const Params& p, int b, int h, int n, char* lds) {
  int r0 = NLAT + b * 256 + n * 128;
  bf16x8 qf[2][2];
  load_q<2>(qf, p.P + (size_t)r0 * PW + C_NQ + h * 64, PW);
  f32x4 o[4][2]; float m[2] = {-1e30f, -1e30f}, ls[2] = {0.f, 0.f};
#pragma unroll
  for (int dt = 0; dt < 4; ++dt) { o[dt][0] = (f32x4){0.f, 0.f, 0.f, 0.f}; o[dt][1] = (f32x4){0.f, 0.f, 0.f, 0.f}; }
  NaTiles tf{p.P, b, h, 0, 0};
  MaskScale mk{0.125f * LOG2E};
  attn_core<64, true, true>(qf, 4, tf, PW, PW, mk, o, m, ls, lds);
  attn_store(o, m, ls, false, 0.f, p.ACT + (size_t)r0 * 1024 + 512 + h * 64, 1024);
}

__device__ void ret_scan_item(const Params& p, int l, int combo, int part) {
  int dir = combo >> 3, b = (combo >> 2) & 1, h = combo & 3;
  float d = p.ret_decay[l * 8 + dir * 4 + h];
  float lg = -log1pf(__expf(-d)) * LOG2E;
  float gC = exp2f(lg * 128.f);
  int idx = part * 1024 + otid() * 4;
  f32x4 S = (f32x4){0.f, 0.f, 0.f, 0.f};
  const size_t dbase = ((size_t)dir * 260 * 4 + h) * 4096 + idx;
#pragma unroll 1
  for (int s0 = 0; s0 < 130; s0 += 13) {
    f32x4 kv[13]; int ch[13];
#pragma unroll
    for (int u = 0; u < 13; ++u) {
      int step = s0 + u;
      if (dir == 0) ch[u] = step < 2 ? 256 + 2 * b + step : b * 128 + (step - 2);
      else ch[u] = step < 2 ? 256 + 2 * b + 1 - step : b * 128 + 127 - (step - 2);
      kv[u] = *(const f32x4*)(p.Ksum + dbase + (size_t)ch[u] * 16384);
    }
#pragma unroll
    for (int u = 0; u < 13; ++u) {
      *(u32x2*)(p.St + dbase + (size_t)ch[u] * 16384) = MK2(pack2(S[0], S[1]), pack2(S[2], S[3]));
#pragma unroll
      for (int j = 0; j < 4; ++j) S[j] = S[j] * gC + kv[u][j];
    }
  }
}

struct RetMask { float lg; int dir;
  __device__ __forceinline__ float operator()(int t, int qi, int kj, float s) const {
    int j = t * 64 + kj; int df = dir == 0 ? qi - j : j - qi;
    return df >= 0 ? s * 0.125f * __builtin_amdgcn_exp2f(lg * (float)df) : 0.f; } };

__device__ void ret_out_item(const Params& p, int l, int c, int h, char* lds) {
  const int lane = otid() & 63, wave = otid() >> 6, lr = lane & 15, quad = lane >> 4;
  int r0 = c * 128;
  bf16x8 qf[2][2];
  load_q<2>(qf, p.P + (size_t)r0 * PW + C_RQ + h * 64, PW);
  f32x4 res[4][2];
#pragma unroll
  for (int dt = 0; dt < 4; ++dt) { res[dt][0] = (f32x4){0.f, 0.f, 0.f, 0.f}; res[dt][1] = (f32x4){0.f, 0.f, 0.f, 0.f}; }
  TileContig tf{p.P + (size_t)r0 * PW + C_RK + h * 64, p.P + (size_t)r0 * PW + C_RV + h * 64, (size_t)64 * PW, (size_t)64 * PW};
#pragma unroll 1
  for (int dir = 0; dir < 2; ++dir) {
    float d = p.ret_decay[l * 8 + dir * 4 + h];
    float lg = -log1pf(__expf(-d)) * LOG2E;
    f32x4 o[4][2]; float m[2] = {0.f, 0.f}, ls[2] = {0.f, 0.f};
#pragma unroll
    for (int dt = 0; dt < 4; ++dt) { o[dt][0] = (f32x4){0.f, 0.f, 0.f, 0.f}; o[dt][1] = (f32x4){0.f, 0.f, 0.f, 0.f}; }
    rsrc_t str = mkbuf(p.St + ((size_t)(dir * 260 + c) * 4 + h) * 4096);
#pragma unroll
    for (int ks = 0; ks < 2; ++ks)
#pragma unroll
      for (int et = 0; et < 4; ++et) {
        bf16x8 af = __builtin_bit_cast(bf16x8, bload16(str, (unsigned)(lr * 64 + quad * 8) * 2u, (unsigned)(et * 16 * 64 + ks * 32) * 2u));
        o[et][0] = mfma16(af, qf[0][ks], o[et][0]);
        o[et][1] = mfma16(af, qf[1][ks], o[et][1]);
      }
#pragma unroll
    for (int qt = 0; qt < 2; ++qt) {
      int i = wave * 32 + qt * 16 + lr;
      float qdec = exp2f(lg * (float)(dir == 0 ? i + 1 : 128 - i));
#pragma unroll
      for (int et = 0; et < 4; ++et)
#pragma unroll
        for (int j = 0; j < 4; ++j) o[et][qt][j] *= qdec;
    }
    __builtin_amdgcn_sched_barrier(0);
    RetMask mk{lg, dir};
    attn_core<64, false, false>(qf, 2, tf, PW, PW, mk, o, m, ls, lds);
    __builtin_amdgcn_sched_barrier(0);
#pragma unroll
    for (int qt = 0; qt < 2; ++qt) {
      int i = wave * 32 + qt * 16 + lr;
      float ss = 0.f;
#pragma unroll
      for (int et = 0; et < 4; ++et)
#pragma unroll
        for (int j = 0; j < 4; ++j) { float v = o[et][qt][j]; ss += v * v; }
      ss += __shfl_xor(ss, 16); ss += __shfl_xor(ss, 32);
      float rinv = rsqrtf(ss * (1.f / 64.f) + 1e-6f);
      rsrc_t gpr = mkbuf(p.P + (size_t)r0 * PW + (dir == 0 ? C_RGF : C_RGB) + h * 64);
      unsigned goff = (unsigned)(i * PW + quad * 4) * 2u;
#pragma unroll
      for (int et = 0; et < 4; ++et) {
        u32x2 gw = bload8(gpr, goff, et * 32);
        float g0 = lo_f(gw.x), g1 = hi_f(gw.x), g2 = lo_f(gw.y), g3 = hi_f(gw.y);
        res[et][qt][0] += o[et][qt][0] * rinv * silu_f(g0);
        res[et][qt][1] += o[et][qt][1] * rinv * silu_f(g1);
        res[et][qt][2] += o[et][qt][2] * rinv * silu_f(g2);
        res[et][qt][3] += o[et][qt][3] * rinv * silu_f(g3);
      }
    }
  }
#pragma unroll
  for (int qt = 0; qt < 2; ++qt) {
    bf16_t* rp = p.ACT + (size_t)(r0 + wave * 32 + qt * 16 + lr) * 1024 + 256 + h * 64 + quad * 4;
#pragma unroll
    for (int et = 0; et < 4; ++et)
      *(u32x2*)(rp + et * 16) = MK2(pack2(res[et][qt][0], res[et][qt][1]), pack2(res[et][qt][2], res[et][qt][3]));
  }
}


#define XB_TMO      128
#define XB_XCNT(j)  (256  + 64 * (j))
#define XB_XSUB(j)  (1280 + 64 * (j))
#define XB_XGEN(j)  (2304 + 64 * (j))
#define XB_TOP      3328
#define XB_TOPGEN   3392
#define XCD_BAR_WORDS 3456
#define XB_SPIN_CAP (1u << 20)
#define LAS __attribute__((address_space(3)))
__device__ __forceinline__ unsigned xb_ld(unsigned* p)              { return __hip_atomic_load(p, __ATOMIC_RELAXED, __HIP_MEMORY_SCOPE_AGENT); }
__device__ __forceinline__ unsigned xb_add(unsigned* p, unsigned v) { return __hip_atomic_fetch_add(p, v, __ATOMIC_RELAXED, __HIP_MEMORY_SCOPE_AGENT); }
__device__ __forceinline__ unsigned xb_xcc_id() { return (unsigned)__builtin_amdgcn_s_getreg((3 << 11) | 20) & 0xFu; }
#define XB_SPIN(cond, bar) do { unsigned _sp = 0; while (cond) { __builtin_amdgcn_s_sleep(1); \
    if ((++_sp & 255u) == 0u) { if (xb_ld(&(bar)[XB_TMO])) break; if (_sp > XB_SPIN_CAP) { atomicAdd(&(bar)[XB_TMO], 1u); break; } } } } while (0)
struct XcdBarrier { unsigned* bar; unsigned x; volatile LAS unsigned* st; };
__device__ __forceinline__ XcdBarrier xcd_barrier_post(unsigned* bar, volatile LAS unsigned* st) {
    XcdBarrier b; b.bar = bar; b.x = xb_xcc_id(); b.st = st;
    if (threadIdx.x == 0) (void)xb_add(&bar[XB_XCNT(b.x)], 1u);
    return b;
}
__device__ __forceinline__ void xcd_barrier_complete(unsigned* bar, unsigned x, unsigned& nloc, unsigned& nx) {
    const unsigned G = gridDim.x * gridDim.y * gridDim.z;
    unsigned sum, cnt, mine, sp = 0u;
    for (;;) {
        sum = 0u; cnt = 0u; mine = 0u;
#pragma unroll
        for (unsigned j = 0; j < 16; ++j) { const unsigned c = xb_ld(&bar[XB_XCNT(j)]); sum += c; cnt += (c > 0u) ? 1u : 0u; mine = (j == x) ? c : mine; }
        if (sum == G) break;
        __builtin_amdgcn_s_sleep(1);
        if ((++sp & 255u) == 0u) { if (xb_ld(&bar[XB_TMO])) break; if (sp > XB_SPIN_CAP) { atomicAdd(&bar[XB_TMO], 1u); break; } }
    }
    nloc = mine > 0u ? mine : 1u; nx = cnt > 0u ? cnt : 1u;
}
__device__ __forceinline__ void xcd_barrier(const XcdBarrier& b) {
    asm volatile("s_waitcnt vmcnt(0)" ::: "memory");
    __syncthreads();
    if (threadIdx.x == 0) {
        unsigned* bar = b.bar;
        __builtin_amdgcn_s_waitcnt(0);
        unsigned nloc = b.st[0], nx = b.st[1];
        if (nloc == 0u) { xcd_barrier_complete(bar, b.x, nloc, nx); b.st[0] = nloc; b.st[1] = nx; }
        const unsigned old = xb_add(&bar[XB_XSUB(b.x)], 1u);
        const unsigned gen = old / nloc;
        if (old + 1u == (gen + 1u) * nloc) {
            __builtin_amdgcn_fence(__ATOMIC_RELEASE, "agent");
            asm volatile("s_waitcnt vmcnt(0)" ::: "memory");
            const unsigned og = xb_add(&bar[XB_TOP], 1u);
            const unsigned tg = og / nx;
            if (og + 1u == (tg + 1u) * nx) xb_add(&bar[XB_TOPGEN], 1u);
            else XB_SPIN(xb_ld(&bar[XB_TOPGEN]) == tg, bar);
            __builtin_amdgcn_fence(__ATOMIC_ACQUIRE, "agent");
            xb_add(&bar[XB_XGEN(b.x)], 1u);
            asm volatile("s_waitcnt vmcnt(0)" ::: "memory");
        } else {
            XB_SPIN(xb_ld(&bar[XB_XGEN(b.x)]) == gen, bar);
            __builtin_amdgcn_fence(__ATOMIC_ACQUIRE, "agent");
            asm volatile("s_waitcnt vmcnt(0)" ::: "memory");
        }
    }
    __syncthreads();
}

__device__ void run_phase(const Params& p, int ph, int bid, int nb, char* lds) {
#ifndef CM
#define CM 0xff
#endif
#ifndef PH_MASK
#define PH_MASK 0xfffff
#endif
  if (ph == 0) { if (PH_MASK & (1<<9)) prologue_phase(p, bid, nb, lds); return; }
  if (ph == 37) { if (PH_MASK & (1<<10)) final_norm_phase(p, bid, nb); return; }
  const int l = (ph - 1) / 9, sp = (ph - 1) % 9;
  const bf16_t* W = p.W + (size_t)l * W_LAYER;
  if (!((PH_MASK >> sp) & 1)) return;
  switch (sp) {
    case 0: norm_phase(p, l, 0, bid, nb); break;
    case 1: {
      EpiWin epi{p.P};
      for (int rd = 0;; ++rd) { int t = xcd_tile(rd, bid, nb); if (t >= 260 * 24) break; int pm, pn; tile_coord(t, 24, pm, pn); gemm_tile(p.ACT, 1024, W + WO_IN, 1024, 1024, pm * 128, pn * 128, epi, lds); }
    } break;
    case 2: {
      EpiUq eq{&p}; EpiUkv ekv{&p};
      const int n0 = 260 * 4, n1 = n0 + 260 * 4, n2 = n1 + 260 * 3, n3 = n2 + 256;
      for (int t = bid; t < n3; t += nb) {
        if (t < n0) ret_prep_item(p, l, t >> 2, t & 3, lds);
        else if (t < n1) { int u = t - n0, pm = u >> 2, h = u & 3; gemm_tile(p.P + C_CKV, PW, W + WO_UKV, 128, 128, pm * 128, h * 128, ekv, lds); mla_krope_item(p, pm * 128, h); }
        else if (t < n2) { int u = t - n1, pm = u / 3, pn = u % 3; gemm_tile(p.P + C_CQ, PW, W + WO_UQ, 256, 256, pm * 128, pn * 128, eq, lds); }
        else swa_rope_item(p, t - n2);
      }
    } break;
    case 3: {
      int* slot = (int*)(lds + LDS_BYTES - 16);
      if (bid < 64) { if (CM & 2) ret_scan_item(p, l, bid >> 2, bid & 3); }
      const int x = bid & 7;
      for (int pass = 0; pass < 8; ++pass) {
        const int cmb = (x + pass) & 7;
        for (;;) {
          __syncthreads();
          if (otid() == 0) *slot = (int)atomicAdd(p.bar + 8 + l * 8 + cmb, 1u);
          __syncthreads();
          const int q = *slot;
          if (q >= 128) break;
          if (CM & 1) mla_item(p, cmb >> 2, cmb & 3, q, false, lds);
        }
      }
      const int n1 = 1024, n2 = n1 + 1024, n3 = n2 + 16, n4 = n3 + 16, n5 = n4 + 16;
      for (;;) {
        __syncthreads();
        if (otid() == 0) *slot = (int)atomicAdd(p.bar + l, 1u);
        __syncthreads();
        const int t = *slot;
        if (t >= n5) break;
        if (t < n1) { int u = t; if (CM & 4) na_item(p, l, u >> 9, (u >> 7) & 3, u & 127, lds); }
        else if (t < n2) { int u = t - n1; if (CM & 16) swa_item(p, l, u >> 9, (u >> 7) & 3, u & 127, false, lds); }
        else if (t < n3) { int u = t - n2; if (CM & 1) mla_item(p, u >> 3, (u >> 1) & 3, u & 1, true, lds); }
        else if (t < n4) { int u = t - n3; if (CM & 8) na_ctx_item(p, u >> 3, (u >> 1) & 3, u & 1, lds); }
        else { int u = t - n4; if (CM & 16) swa_item(p, l, u >> 3, (u >> 1) & 3, u & 1, true, lds); }
      }
    } break;
    case 4: for (int t = bid; t < 260 * 4; t += nb) ret_out_item(p, l, t >> 2, t & 3, lds); break;
    case 5: {
      EpiResid epi{&p, l, 2048, 1};
      for (int rd = 0;; ++rd) { int t = xcd_tile(rd, bid, nb); if (t >= (l == 3 ? 256 : 260) * 8) break; int pm, pn; tile_coord(t, 8, pm, pn); gemm_tile(p.ACT, 1024, W + WO_OUT, 1024, 1024, pm * 128, pn * 128, epi, lds); }
    } break;
    case 6: norm_phase(p, l, 1, bid, nb); break;
    case 7: {
      EpiFfn1 epi{p.P};
      for (int rd = 0;; ++rd) { int t = xcd_tile(rd, bid, nb); if (t >= (l == 3 ? 256 : 260) * 44) break; int pm, pn; tile_coord(t, 44, pm, pn); gemm_tile(p.ACT, 1024, W + WO_13, 1024, 1024, pm * 128, pn * 128, epi, lds); }
    } break;
    case 8: {
      EpiResid epi{&p, l, 5120, 0};
      for (int rd = 0;; ++rd) { int t = xcd_tile(rd, bid, nb); if (t >= (l == 3 ? 256 : 260) * 8) break; int pm, pn; tile_coord(t, 8, pm, pn); gemm_tile(p.P, 2816, W + WO_2, 2816, 2816, pm * 128, pn * 128, epi, lds); }
    } break;
  }
}

__global__ void __launch_bounds__(256, 2) mega_kernel(Params p, int ph_lo, int ph_hi) {
  __shared__ __attribute__((aligned(16))) char lds[LDS_BYTES];
  __shared__ u32x4 xb_words;
#ifndef REP_MASK
#define REP_MASK 0
#endif
  if (ph_lo < 0) cg::this_grid().sync();
  if (threadIdx.x == 0) xb_words = (u32x4){0u, 0u, 0u, 0u};
  __syncthreads();
  XcdBarrier xb; xb.bar = p.bar; xb.x = 0; xb.st = (volatile LAS unsigned*)&xb_words;
  if (ph_hi - ph_lo > 1) xb = xcd_barrier_post(p.bar, (volatile LAS unsigned*)&xb_words);
  for (int ph = ph_lo; ph < ph_hi; ++ph) {
    const int reps = (REP_MASK && ph >= 1 && ph <= 36 && ((REP_MASK >> ((ph - 1) % 9)) & 1)) ? 2 : 1;
    for (int r = 0; r < reps; ++r) {
      run_phase(p, ph, blockIdx.x, gridDim.x, lds);
      if (r + 1 < reps || ph + 1 < ph_hi) xcd_barrier(xb);
#ifdef EXTRA_SYNC
      for (int e = 0; e < EXTRA_SYNC; ++e) xcd_barrier(xb);
#endif
    }
  }
}

extern "C" void kernel_launch(void* const* d_in, const int* in_sizes, int n_in, void* d_out, int out_size, void* d_ws, size_t ws_size,
                              hipStream_t stream) {
  Params p{};
  const float** f = (const float**)&p;
  for (int i = 0; i < 21; ++i) f[i] = (const float*)d_in[i];
  p.out = (float*)d_out;
  char* w = (char*)d_ws; size_t off = 0;
  auto take = [&](size_t bytes) { char* r = w + off; off += (bytes + 255) & ~(size_t)255; return r; };
  p.Y = (float*)take((size_t)512 * 1024 * 4);
  p.ACT = (bf16_t*)take((size_t)NROWS * 1024 * 2);
  p.P = (bf16_t*)take((size_t)NROWS * PW * 2);
  p.Qm = (bf16_t*)take((size_t)NROWS * 384 * 2);
  p.Km = (bf16_t*)take((size_t)8 * 16640 * 96 * 2);
  p.Vm = (bf16_t*)take((size_t)8 * 16640 * 64 * 2);
  p.Ksum = (float*)take((size_t)2 * 260 * 4 * 4096 * 4);
  p.St = (bf16_t*)take((size_t)2 * 260 * 4 * 4096 * 2);
  p.W = (bf16_t*)take((size_t)4 * W_LAYER * 2);
  p.mod = (float*)take((size_t)4 * 3 * 6144 * 4);
  p.rope64 = (float*)take(256 * 16 * 2 * 4);
  p.rope32 = (float*)take(256 * 8 * 2 * 4);
  p.bar = (unsigned*)take(XCD_BAR_WORDS * 4);
  if (off > ws_size) { fprintf(stderr, "workspace too small: need %zu have %zu\n", off, ws_size); return; }
#if MULTI_LAUNCH
  for (int ph = 0; ph < 38; ++ph) hipLaunchKernelGGL(mega_kernel, dim3(512), dim3(256), 0, stream, p, ph, ph + 1);
#else
  static int grid_blocks = 0;
  if (!grid_blocks) {
    int dev = 0, cus = 0, per_cu = 0;
    hipGetDevice(&dev);
    hipDeviceGetAttribute(&cus, hipDeviceAttributeMultiprocessorCount, dev);
    hipOccupancyMaxActiveBlocksPerMultiprocessor(&per_cu, mega_kernel, 256, 0);
    if (per_cu > 2) per_cu = 2;
    grid_blocks = cus * per_cu;
  }
  hipMemsetAsync(p.bar, 0, XCD_BAR_WORDS * 4, stream);
  int lo = 0, hi = 38;
  void* args[] = {&p, &lo, &hi};
  hipError_t e = hipLaunchCooperativeKernel((void*)mega_kernel, dim3(grid_blocks), dim3(256), args, 0, stream);
  if (e != hipSuccess) fprintf(stderr, "cooperative launch failed: %s (grid %d)\n", hipGetErrorString(e), grid_blocks);
#endif
}
```

```cpp
#include <hip/hip_runtime.h>
#include <hip/hip_cooperative_groups.h>
#include <cstdio>
#include <cstdint>
namespace cg = cooperative_groups;

#ifndef MULTI_LAUNCH
#define MULTI_LAUNCH 0
#endif

typedef unsigned short bf16_t;
typedef short bf16x8 __attribute__((ext_vector_type(8)));
typedef short s16x4 __attribute__((ext_vector_type(4)));
typedef float f32x4 __attribute__((ext_vector_type(4)));
typedef float f32x2 __attribute__((ext_vector_type(2)));
typedef __bf16 bf2_t __attribute__((ext_vector_type(2)));
typedef unsigned u32x4 __attribute__((ext_vector_type(4)));
typedef unsigned u32x2 __attribute__((ext_vector_type(2)));
#define MK4(a,b,c,d) ((u32x4){(a),(b),(c),(d)})
#define MK2(a,b) ((u32x2){(a),(b)})

#define NROWS 33280
#define NLAT 32768
#define PW 3072
#define LOG2E 1.4426950408889634f
#define LDS_BYTES 73728

#define C_CQ 0
#define C_CKV 256
#define C_KR 384
#define C_RQ 416
#define C_RK 672
#define C_RV 928
#define C_RGF 1184
#define C_RGB 1440
#define C_NQ 1696
#define C_NK 1952
#define C_NV 2208
#define C_SQ 2464
#define C_SK 2720
#define C_SV 2848

#define WO_IN 0
#define WO_UQ 3145728
#define WO_UKV 3244032
#define WO_OUT 3309568
#define WO_13 4358144
#define WO_2 10125312
#define W_LAYER 13008896

struct Params {
  const float *x, *c, *ctx, *c_ctx, *ada_w, *ada_b, *norm1_g, *w_in, *mla_q_norm, *mla_w_uq, *mla_kv_norm, *mla_w_ukv,
      *ret_decay, *na_rpb, *swa_sink, *w_out, *norm2_g, *ffn_w1, *ffn_w3, *ffn_w2, *final_g;
  float* out;
  float* Y;
  bf16_t* ACT;
  bf16_t* P;
  bf16_t *Qm, *Km, *Vm;
  float* Ksum;
  bf16_t* St;
  bf16_t* W;
  float* mod;
  float* rope64;
  float* rope32;
  unsigned* bar;
};

__device__ __forceinline__ int otid() { int t = threadIdx.x; asm volatile("" : "+v"(t)); return t; }
typedef __amdgpu_buffer_rsrc_t rsrc_t;
__device__ __forceinline__ rsrc_t mkbuf(const void* base) { return __builtin_amdgcn_make_buffer_rsrc((void*)base, 0, 0x7fffffff, 0x00020000); }
__device__ __forceinline__ u32x4 bload16(rsrc_t r, unsigned voff, unsigned soff) { return __builtin_amdgcn_raw_buffer_load_b128(r, voff, soff, 0); }
__device__ __forceinline__ u32x2 bload8(rsrc_t r, unsigned voff, unsigned soff) { return __builtin_amdgcn_raw_buffer_load_b64(r, voff, soff, 0); }
__device__ __forceinline__ float bf2f(bf16_t h) { return __uint_as_float(((unsigned)h) << 16); }
__device__ __forceinline__ unsigned pack2(float a, float b) { f32x2 v = {a, b}; bf2_t r = __builtin_convertvector(v, bf2_t); return __builtin_bit_cast(unsigned, r); }
__device__ __forceinline__ bf16_t f2bf(float a) { return (bf16_t)(pack2(a, 0.f) & 0xffffu); }
__device__ __forceinline__ float lo_f(unsigned u) { return __uint_as_float(u << 16); }
__device__ __forceinline__ float hi_f(unsigned u) { return __uint_as_float(u & 0xffff0000u); }
__device__ __forceinline__ f32x4 mfma16(bf16x8 a, bf16x8 b, f32x4 c) { return __builtin_amdgcn_mfma_f32_16x16x32_bf16(a, b, c, 0, 0, 0); }
typedef __attribute__((address_space(3))) s16x4 lds_s16x4;
__device__ __forceinline__ s16x4 tr_read(const bf16_t* p) { return __builtin_amdgcn_ds_read_tr16_b64_v4i16((lds_s16x4*)p); }
__device__ __forceinline__ bf16x8 cat8(s16x4 a, s16x4 b) { bf16x8 r; r[0]=a[0]; r[1]=a[1]; r[2]=a[2]; r[3]=a[3]; r[4]=b[0]; r[5]=b[1]; r[6]=b[2]; r[7]=b[3]; return r; }
__device__ __forceinline__ float wave_sum(float v) {
  v += __shfl_xor(v, 32); v += __shfl_xor(v, 16); v += __shfl_xor(v, 8); v += __shfl_xor(v, 4); v += __shfl_xor(v, 2); v += __shfl_xor(v, 1); return v;
}
__device__ __forceinline__ float silu_f(float a) { return a * __builtin_amdgcn_rcpf(1.f + __expf(-a)); }

__device__ __forceinline__ float* xrow(const Params& p, int row) { return row < NLAT ? p.out + (size_t)row * 1024 : p.Y + (size_t)(row - NLAT) * 1024; }
__device__ __forceinline__ const float* xsrc(const Params& p, int l, int row) {
  if (l == 0) return row < NLAT ? p.x + (size_t)row * 1024 : p.ctx + (size_t)(row - NLAT) * 1024;
  return xrow(p, row);
}
__device__ __forceinline__ int modv(int row) { return row < 16384 ? 0 : (row < NLAT ? 1 : 2); }

__device__ void transpose_tile(const float* __restrict__ src, int N, int k0, int n0, bf16_t* __restrict__ dst, int ldd, int mode,
                               const float* __restrict__ kscale, char* lds) {
  bf16_t(*t)[66] = (bf16_t(*)[66])lds;
  const int tid = otid();
  __syncthreads();
#pragma unroll 4
  for (int i = 0; i < 16; ++i) {
    int kk = i * 4 + (tid >> 6), nn = tid & 63;
    float v = (n0 + nn < N) ? src[(size_t)(k0 + kk) * N + n0 + nn] : 0.f;
    if (kscale) v *= kscale[k0 + kk];
    t[kk][nn] = f2bf(v);
  }
  __syncthreads();
  int nn = tid >> 2, kq = tid & 3;
  int n = n0 + nn;
  if (n < N) {
    int row = mode == 0 ? n : ((n >> 4) * 32 + (n & 15) + (mode == 2 ? 16 : 0));
    unsigned w[8];
#pragma unroll
    for (int e = 0; e < 8; ++e) w[e] = (unsigned)t[kq * 16 + 2 * e][nn] | ((unsigned)t[kq * 16 + 2 * e + 1][nn] << 16);
    u32x4* d = (u32x4*)(dst + (size_t)row * ldd + k0 + kq * 16);
    d[0] = MK4(w[0], w[1], w[2], w[3]);
    d[1] = MK4(w[4], w[5], w[6], w[7]);
  }
}

__device__ void prologue_phase(const Params& p, int bid, int nb, char* lds) {
  const int tid = otid();
  for (int it = bid; it < 4 * 3160; it += nb) {
    int l = it / 3160, r = it % 3160;
    bf16_t* W = p.W + (size_t)l * W_LAYER;
    if (r < 752) { int kt = r / 47, nt = r % 47; transpose_tile(p.w_in + (size_t)l * 1024 * 2976, 2976, kt * 64, nt * 64, W + WO_IN, 1024, 0, nullptr, lds); continue; }
    r -= 752;
    if (r < 24) { int kt = r / 6, nt = r % 6; transpose_tile(p.mla_w_uq + (size_t)l * 256 * 384, 384, kt * 64, nt * 64, W + WO_UQ, 256, 0, p.mla_q_norm + l * 256, lds); continue; }
    r -= 24;
    if (r < 16) { int kt = r / 8, nt = r % 8; transpose_tile(p.mla_w_ukv + (size_t)l * 128 * 512, 512, kt * 64, nt * 64, W + WO_UKV, 128, 0, p.mla_kv_norm + l * 128, lds); continue; }
    r -= 16;
    if (r < 256) { int kt = r / 16, nt = r % 16; transpose_tile(p.w_out + (size_t)l * 1024 * 1024, 1024, kt * 64, nt * 64, W + WO_OUT, 1024, 0, nullptr, lds); continue; }
    r -= 256;
    if (r < 704) { int kt = r / 44, nt = r % 44; transpose_tile(p.ffn_w1 + (size_t)l * 1024 * 2816, 2816, kt * 64, nt * 64, W + WO_13, 1024, 1, nullptr, lds); continue; }
    r -= 704;
    if (r < 704) { int kt = r / 44, nt = r % 44; transpose_tile(p.ffn_w3 + (size_t)l * 1024 * 2816, 2816, kt * 64, nt * 64, W + WO_13, 1024, 2, nullptr, lds); continue; }
    r -= 704;
    { int kt = r / 16, nt = r % 16; transpose_tile(p.ffn_w2 + (size_t)l * 2816 * 1024, 1024, kt * 64, nt * 64, W + WO_2, 2816, 0, nullptr, lds); }
  }
  for (int it = bid; it < 4 * 48; it += nb) {
    int l = it / 48, part = it % 48;
    u32x4* d = (u32x4*)(p.W + (size_t)l * W_LAYER + WO_IN + (size_t)2976 * 1024);
    d[part * 256 + tid] = MK4(0, 0, 0, 0);
  }
  for (int it = bid; it < 4 * 96; it += nb) {
    int l = it / 96, cb = it % 96;
    float* s = (float*)lds;
    float* red = s + 3 * 1024;
    __syncthreads();
    for (int i = tid; i < 3072; i += 256) {
      int v = i >> 10, k = i & 1023;
      float cv = v < 2 ? p.c[v * 1024 + k] : p.c_ctx[k];
      s[i] = silu_f(cv);
    }
    __syncthreads();
    int col = cb * 64 + (tid & 63), kp = tid >> 6;
    const float* w = p.ada_w + (size_t)l * 1024 * 6144 + (size_t)(kp * 256) * 6144 + col;
    float a0 = 0.f, a1 = 0.f, a2 = 0.f;
#pragma unroll 8
    for (int k = 0; k < 256; ++k) {
      float wv = w[(size_t)k * 6144];
      a0 += s[kp * 256 + k] * wv; a1 += s[1024 + kp * 256 + k] * wv; a2 += s[2048 + kp * 256 + k] * wv;
    }
    red[(kp * 3 + 0) * 64 + (tid & 63)] = a0; red[(kp * 3 + 1) * 64 + (tid & 63)] = a1; red[(kp * 3 + 2) * 64 + (tid & 63)] = a2;
    __syncthreads();
    if (tid < 192) {
      int v = tid >> 6, cc = tid & 63;
      float sum = red[(0 * 3 + v) * 64 + cc] + red[(1 * 3 + v) * 64 + cc] + red[(2 * 3 + v) * 64 + cc] + red[(3 * 3 + v) * 64 + cc];
      p.mod[(size_t)(l * 3 + v) * 6144 + cb * 64 + cc] = sum + p.ada_b[l * 6144 + cb * 64 + cc];
    }
  }
  if (bid == (nb > 1 ? 1 : 0)) {
    int pos = tid;
    for (int i = 0; i < 16; ++i) {
      float inv = exp2f(-(float)(2 * i) / 32.f * 13.287712379549449f);
      float ang = (float)pos * inv;
      float n = rintf(ang * 0.15915494309189535f);
      float r = fmaf(-n, 6.28318548202514648f, ang); r = fmaf(-n, -1.74845553146951715e-07f, r);
      p.rope64[(pos * 16 + i) * 2] = cosf(r); p.rope64[(pos * 16 + i) * 2 + 1] = sinf(r);
    }
    for (int i = 0; i < 8; ++i) {
      float inv = exp2f(-(float)(2 * i) / 16.f * 13.287712379549449f);
      float ang = (float)pos * inv;
      float n = rintf(ang * 0.15915494309189535f);
      float r = fmaf(-n, 6.28318548202514648f, ang); r = fmaf(-n, -1.74845553146951715e-07f, r);
      p.rope32[(pos * 8 + i) * 2] = cosf(r); p.rope32[(pos * 8 + i) * 2 + 1] = sinf(r);
    }
  }
}

__device__ void norm_phase(const Params& p, int l, int which, int bid, int nb) {
  const int wave = otid() >> 6, lane = otid() & 63;
  const float* g = (which == 0 ? p.norm1_g : p.norm2_g) + l * 1024;
  for (int row = bid * 4 + wave; row < NROWS; row += nb * 4) {
    const float* src = which == 0 ? xsrc(p, l, row) : xrow(p, row);
    const float* md = p.mod + (size_t)(l * 3 + modv(row)) * 6144 + which * 3072;
    f32x4 v[4], g4[4], sh[4], sc[4]; float ss = 0.f;
#pragma unroll
    for (int i = 0; i < 4; ++i) {
      int col = i * 256 + lane * 4;
      v[i] = *(const f32x4*)(src + col); g4[i] = *(const f32x4*)(g + col); sh[i] = *(const f32x4*)(md + col); sc[i] = *(const f32x4*)(md + 1024 + col);
    }
#pragma unroll
    for (int i = 0; i < 4; ++i) ss += v[i][0] * v[i][0] + v[i][1] * v[i][1] + v[i][2] * v[i][2] + v[i][3] * v[i][3];
    ss = wave_sum(ss);
    float rinv = rsqrtf(ss * (1.f / 1024.f) + 1e-6f);
#pragma unroll
    for (int i = 0; i < 4; ++i) {
      int col = i * 256 + lane * 4;
      f32x4 y;
#pragma unroll
      for (int j = 0; j < 4; ++j) y[j] = (v[i][j] * rinv * g4[i][j]) * (1.f + sc[i][j]) + sh[i][j];
      *(u32x2*)(p.ACT + (size_t)row * 1024 + col) = MK2(pack2(y[0], y[1]), pack2(y[2], y[3]));
    }
  }
}

__device__ void final_norm_phase(const Params& p, int bid, int nb) {
  const int wave = otid() >> 6, lane = otid() & 63;
  for (int row = bid * 4 + wave; row < NLAT; row += nb * 4) {
    float* src = p.out + (size_t)row * 1024;
    f32x4 v[4]; float ss = 0.f;
#pragma unroll
    for (int i = 0; i < 4; ++i) { v[i] = *(const f32x4*)(src + i * 256 + lane * 4); ss += v[i][0] * v[i][0] + v[i][1] * v[i][1] + v[i][2] * v[i][2] + v[i][3] * v[i][3]; }
    ss = wave_sum(ss);
    float rinv = rsqrtf(ss * (1.f / 1024.f) + 1e-6f);
#pragma unroll
    for (int i = 0; i < 4; ++i) {
      int col = i * 256 + lane * 4;
      f32x4 g4 = *(const f32x4*)(p.final_g + col);
      f32x4 y;
#pragma unroll
      for (int j = 0; j < 4; ++j) y[j] = v[i][j] * rinv * g4[j];
      *(f32x4*)(src + col) = y;
    }
  }
}

#define GSTR 64
template <class Epi>
__device__ __forceinline__ void gemm_tile(const bf16_t* __restrict__ A, int lda, const bf16_t* __restrict__ Bt, int ldb, int K, int m0, int n0,
                                          const Epi& epi, char* lds) {
  bf16_t* As = (bf16_t*)lds;
  bf16_t* Bs = As + 2 * 128 * GSTR;
  const int tid = otid(), wave = tid >> 6, lane = tid & 63, wm = wave >> 1, wn = wave & 1, lr = lane & 15, quad = lane >> 4;
  const int lrow = tid >> 3, lch = tid & 7, wch = lch ^ (lrow & 7);
  rsrc_t gar = mkbuf(A + (size_t)m0 * lda), gbr = mkbuf(Bt + (size_t)n0 * ldb);
  unsigned aoff[4], boff[4];
#pragma unroll
  for (int i = 0; i < 4; ++i) { aoff[i] = (unsigned)((lrow + 32 * i) * lda + lch * 8) * 2u; boff[i] = (unsigned)((lrow + 32 * i) * ldb + lch * 8) * 2u; }
  u32x4 ra0[4], rb0[4], ra1[4], rb1[4];
  f32x4 acc[4][4];
#pragma unroll
  for (int i = 0; i < 4; ++i)
#pragma unroll
    for (int j = 0; j < 4; ++j) acc[i][j] = (f32x4){0.f, 0.f, 0.f, 0.f};
  const int nk = K >> 6;
#pragma unroll
  for (int i = 0; i < 4; ++i) { ra0[i] = bload16(gar, aoff[i], 0); rb0[i] = bload16(gbr, boff[i], 0); }
#pragma unroll
  for (int i = 0; i < 4; ++i) { ra1[i] = bload16(gar, aoff[i], 128u); rb1[i] = bload16(gbr, boff[i], 128u); }
  __syncthreads();
#pragma unroll
  for (int i = 0; i < 4; ++i) { *(u32x4*)(As + (lrow + 32 * i) * GSTR + wch * 8) = ra0[i]; *(u32x4*)(Bs + (lrow + 32 * i) * GSTR + wch * 8) = rb0[i]; }
  __syncthreads();
  const int rsw = (quad ^ (lr & 7)) * 8;
  const bf16_t* as0 = As + (wm * 64 + lr) * GSTR;
  const bf16_t* bs0 = Bs + (wn * 64 + lr) * GSTR;
#define GEMM_COMPUTE(BUF)                                                                                         \
  {                                                                                                               \
    const bf16_t* as = as0 + (BUF) * 128 * GSTR;                                                                  \
    const bf16_t* bs = bs0 + (BUF) * 128 * GSTR;                                                                  \
    _Pragma("unroll") for (int ks = 0; ks < 2; ++ks) {                                                            \
      bf16x8 af[4], bfr[4];                                                                                       \
      _Pragma("unroll") for (int i = 0; i < 4; ++i) {                                                             \
        af[i] = *(const bf16x8*)(as + i * 16 * GSTR + (rsw ^ (ks * 32)));                                         \
        bfr[i] = *(const bf16x8*)(bs + i * 16 * GSTR + (rsw ^ (ks * 32)));                                        \
      }                                                                                                           \
      _Pragma("unroll") for (int mi = 0; mi < 4; ++mi)                                                            \
        _Pragma("unroll") for (int ni = 0; ni < 4; ++ni) acc[mi][ni] = mfma16(bfr[ni], af[mi], acc[mi][ni]);      \
    }                                                                                                             \
  }
  for (int kt = 0; kt < nk; kt += 2) {
    if (kt + 2 < nk) {
      const unsigned so = (unsigned)(kt + 2) * 128u;
#pragma unroll
      for (int i = 0; i < 4; ++i) { ra0[i] = bload16(gar, aoff[i], so); rb0[i] = bload16(gbr, boff[i], so); }
    }
    GEMM_COMPUTE(0)
#pragma unroll
    for (int i = 0; i < 4; ++i) { *(u32x4*)(As + 128 * GSTR + (lrow + 32 * i) * GSTR + wch * 8) = ra1[i]; *(u32x4*)(Bs + 128 * GSTR + (lrow + 32 * i) * GSTR + wch * 8) = rb1[i]; }
    __syncthreads();
    if (kt + 3 < nk) {
      const unsigned so = (unsigned)(kt + 3) * 128u;
#pragma unroll
      for (int i = 0; i < 4; ++i) { ra1[i] = bload16(gar, aoff[i], so); rb1[i] = bload16(gbr, boff[i], so); }
    }
    GEMM_COMPUTE(1)
    if (kt + 2 < nk) {
#pragma unroll
      for (int i = 0; i < 4; ++i) { *(u32x4*)(As + (lrow + 32 * i) * GSTR + wch * 8) = ra0[i]; *(u32x4*)(Bs + (lrow + 32 * i) * GSTR + wch * 8) = rb0[i]; }
    }
    __syncthreads();
  }
#undef GEMM_COMPUTE
  epi(acc, m0 + wm * 64, n0 + wn * 64, lr, quad);
}

#define BSTG (256 * 32 + 128 * 32)
template <class Epi>
__device__ __forceinline__ void gemm_big_tile(const bf16_t* __restrict__ A, int lda, const bf16_t* __restrict__ Bt, int ldb, int K, int m0, int n0,
                                              const Epi& epi, char* lds) {
  bf16_t* L = (bf16_t*)lds;
  const int tid = otid(), wave = tid >> 6, lane = tid & 63, wm = wave >> 1, wn = wave & 1, lr = lane & 15, quad = lane >> 4;
  const int lrow = tid >> 2, lch = tid & 3;
  const int gsw = (0x1320 >> (((tid >> 4) & 3) * 4)) & 3;
  const int wpos = (lrow * 32 + ((lch ^ gsw) * 8));
  rsrc_t gar = mkbuf(A + (size_t)m0 * lda), gbr = mkbuf(Bt + (size_t)n0 * ldb);
  unsigned aoff[4], boff[2];
#pragma unroll
  for (int i = 0; i < 4; ++i) aoff[i] = (unsigned)((lrow + 64 * i) * lda + lch * 8) * 2u;
#pragma unroll
  for (int i = 0; i < 2; ++i) boff[i] = (unsigned)((lrow + 64 * i) * ldb + lch * 8) * 2u;
  u32x4 ra0[4], rb0[2], ra1[4], rb1[2];
  f32x4 acc[8][4];
#pragma unroll
  for (int i = 0; i < 8; ++i)
#pragma unroll
    for (int j = 0; j < 4; ++j) acc[i][j] = (f32x4){0.f, 0.f, 0.f, 0.f};
  const int nk = K >> 5;
#pragma unroll
  for (int i = 0; i < 4; ++i) ra0[i] = bload16(gar, aoff[i], 0);
#pragma unroll
  for (int i = 0; i < 2; ++i) rb0[i] = bload16(gbr, boff[i], 0);
#pragma unroll
  for (int i = 0; i < 4; ++i) ra1[i] = bload16(gar, aoff[i], 64u);
#pragma unroll
  for (int i = 0; i < 2; ++i) rb1[i] = bload16(gbr, boff[i], 64u);
  __syncthreads();
#pragma unroll
  for (int i = 0; i < 4; ++i) *(u32x4*)(L + wpos + i * 64 * 32) = ra0[i];
#pragma unroll
  for (int i = 0; i < 2; ++i) *(u32x4*)(L + 256 * 32 + wpos + i * 64 * 32) = rb0[i];
  __syncthreads();
  const int rsw = (quad ^ ((0x1320 >> (((lr >> 2) & 3) * 4)) & 3)) * 8;
  const bf16_t* as0 = L + (wm * 128 + lr) * 32 + rsw;
  const bf16_t* bs0 = L + 256 * 32 + (wn * 64 + lr) * 32 + rsw;
#define BIG_FRAGS(ST)                                                                                             \
    bf16x8 af[8], bfr[4];                                                                                         \
    _Pragma("unroll") for (int i = 0; i < 4; ++i) bfr[i] = *(const bf16x8*)(bs0 + (ST) * BSTG + i * 16 * 32);    \
    _Pragma("unroll") for (int i = 0; i < 8; ++i) af[i] = *(const bf16x8*)(as0 + (ST) * BSTG + i * 16 * 32);
#define BIG_MMA(LO, HI)                                                                                           \
    _Pragma("unroll") for (int mi = LO; mi < HI; ++mi)                                                            \
      _Pragma("unroll") for (int ni = 0; ni < 4; ++ni) acc[mi][ni] = mfma16(bfr[ni], af[mi], acc[mi][ni]);
  for (int kt = 0; kt < nk; kt += 2) {
    if (kt + 2 < nk) {
      const unsigned so = (unsigned)(kt + 2) * 64u;
#pragma unroll
      for (int i = 0; i < 4; ++i) ra0[i] = bload16(gar, aoff[i], so);
#pragma unroll
      for (int i = 0; i < 2; ++i) rb0[i] = bload16(gbr, boff[i], so);
    }
    {
      BIG_FRAGS(0)
      BIG_MMA(0, 4)
#pragma unroll
      for (int i = 0; i < 4; ++i) *(u32x4*)(L + BSTG + wpos + i * 64 * 32) = ra1[i];
#pragma unroll
      for (int i = 0; i < 2; ++i) *(u32x4*)(L + BSTG + 256 * 32 + wpos + i * 64 * 32) = rb1[i];
      BIG_MMA(4, 8)
    }
    __syncthreads();
    if (kt + 3 < nk) {
      const unsigned so = (unsigned)(kt + 3) * 64u;
#pragma unroll
      for (int i = 0; i < 4; ++i) ra1[i] = bload16(gar, aoff[i], so);
#pragma unroll
      for (int i = 0; i < 2; ++i) rb1[i] = bload16(gbr, boff[i], so);
    }
    {
      BIG_FRAGS(1)
      BIG_MMA(0, 4)
      if (kt + 2 < nk) {
#pragma unroll
        for (int i = 0; i < 4; ++i) *(u32x4*)(L + wpos + i * 64 * 32) = ra0[i];
#pragma unroll
        for (int i = 0; i < 2; ++i) *(u32x4*)(L + 256 * 32 + wpos + i * 64 * 32) = rb0[i];
      }
      BIG_MMA(4, 8)
    }
    __syncthreads();
  }
#undef BIG_FRAGS
#undef BIG_MMA
  epi(acc, m0 + wm * 128, n0 + wn * 64, lr, quad);
}
__device__ __forceinline__ void big_coord(int t, int nN, int& pm, int& pn) { int gsz = 4 * nN; int g = t / gsz, r = t % gsz; pm = g * 4 + (r & 3); pn = r >> 2; }

__device__ __forceinline__ void tile_coord(int t, int nN, int& pm, int& pn) {
  const int nM = 260, GM = 8;
  int gsz = GM * nN; int g = t / gsz, r = t % gsz; int fm = g * GM; int gm = min(GM, nM - fm);
  pm = fm + (r % gm); pn = r / gm;
}
__device__ __forceinline__ int xcd_tile(int round, int bid, int nb) { return round * nb + (bid & 7) * (nb >> 3) + (bid >> 3); }

struct EpiWin {
  bf16_t* P;
  template <int NMI>
  __device__ __forceinline__ void operator()(f32x4 (&acc)[NMI][4], int mb, int nbs, int lr, int quad) const {
#pragma unroll
    for (int mi = 0; mi < NMI; ++mi) {
      bf16_t* rp = P + (size_t)(mb + mi * 16 + lr) * PW + nbs + quad * 4;
#pragma unroll
      for (int ni = 0; ni < 4; ++ni) *(u32x2*)(rp + ni * 16) = MK2(pack2(acc[mi][ni][0], acc[mi][ni][1]), pack2(acc[mi][ni][2], acc[mi][ni][3]));
    }
  }
};

struct EpiResid {
  const Params* p; int l; int goff; int use_src;
  template <int NMI>
  __device__ __forceinline__ void operator()(f32x4 (&acc)[NMI][4], int mb, int nbs, int lr, int quad) const {
#pragma unroll
    for (int mi = 0; mi < NMI; ++mi) {
      int row = mb + mi * 16 + lr;
      const float* gate = p->mod + (size_t)(l * 3 + modv(row)) * 6144 + goff;
      const float* src = use_src ? xsrc(*p, l, row) : xrow(*p, row);
      float* dst = xrow(*p, row);
#pragma unroll
      for (int ni = 0; ni < 4; ++ni) {
        int col = nbs + ni * 16 + quad * 4;
        f32x4 g4 = *(const f32x4*)(gate + col), x4 = *(const f32x4*)(src + col);
#pragma unroll
        for (int j = 0; j < 4; ++j) x4[j] += g4[j] * acc[mi][ni][j];
        *(f32x4*)(dst + col) = x4;
      }
    }
  }
};

struct EpiFfn1 {
  bf16_t* U;
  template <int NMI>
  __device__ __forceinline__ void operator()(f32x4 (&acc)[NMI][4], int mb, int nbs, int lr, int quad) const {
#pragma unroll
    for (int mi = 0; mi < NMI; ++mi) {
      int row = mb + mi * 16 + lr;
#pragma unroll
      for (int pr = 0; pr < 2; ++pr) {
        int ucol = ((nbs + pr * 32) >> 5) * 16 + quad * 4;
        float u[4];
#pragma unroll
        for (int j = 0; j < 4; ++j) u[j] = silu_f(acc[mi][2 * pr][j]) * acc[mi][2 * pr + 1][j];
        *(u32x2*)(U + (size_t)row * 2816 + ucol) = MK2(pack2(u[0], u[1]), pack2(u[2], u[3]));
      }
    }
  }
};

struct EpiUq {
  const Params* p;
  __device__ __forceinline__ void operator()(f32x4 (&acc)[4][4], int mb, int nbs, int lr, int quad) const {
#pragma unroll
    for (int mi = 0; mi < 4; ++mi) {
      int row = mb + mi * 16 + lr;
      const bf16_t* cq = p->P + (size_t)row * PW + C_CQ + quad * 64;
      float ss = 0.f;
#pragma unroll
      for (int i = 0; i < 8; ++i) {
        u32x4 w = *(const u32x4*)(cq + i * 8);
        float a;
        a = lo_f(w.x); ss += a * a; a = hi_f(w.x); ss += a * a; a = lo_f(w.y); ss += a * a; a = hi_f(w.y); ss += a * a;
        a = lo_f(w.z); ss += a * a; a = hi_f(w.z); ss += a * a; a = lo_f(w.w); ss += a * a; a = hi_f(w.w); ss += a * a;
      }
      ss += __shfl_xor(ss, 16); ss += __shfl_xor(ss, 32);
      float rinv = rsqrtf(ss * (1.f / 256.f) + 1e-6f);
      bool latent = row < NLAT;
      int tok = row & 16383, prow = tok >> 6, pcol = tok & 63;
#pragma unroll
      for (int ni = 0; ni < 4; ++ni) {
        int col = nbs + ni * 16 + quad * 4;
        int sub = ((nbs >> 4) + ni) % 6;
        float v[4];
#pragma unroll
        for (int j = 0; j < 4; ++j) v[j] = acc[mi][ni][j] * rinv;
        if (sub >= 4) {
          float o[4];
#pragma unroll
          for (int j = 0; j < 4; ++j) o[j] = __shfl_xor(v[j], 32);
          if (latent) {
            int pos = sub == 4 ? prow : pcol;
#pragma unroll
            for (int j = 0; j < 4; ++j) {
              int i = (quad & 1) * 4 + j;
              float cs = p->rope32[(pos * 8 + i) * 2], sn = p->rope32[(pos * 8 + i) * 2 + 1];
              v[j] = quad < 2 ? v[j] * cs - o[j] * sn : v[j] * cs + o[j] * sn;
            }
          }
        }
        *(u32x2*)(p->Qm + (size_t)row * 384 + col) = MK2(pack2(v[0], v[1]), pack2(v[2], v[3]));
      }
    }
  }
};

__device__ __forceinline__ void mla_key_of_row(int row, int& b, int& key) {
  if (row < NLAT) { b = row >> 14; key = row & 16383; } else { b = (row - NLAT) >> 8; key = 16384 + ((row - NLAT) & 255); }
}

struct EpiUkv {
  const Params* p;
  __device__ __forceinline__ void operator()(f32x4 (&acc)[4][4], int mb, int nbs, int lr, int quad) const {
    int h = nbs >> 7, isv = (nbs >> 6) & 1;
#pragma unroll
    for (int mi = 0; mi < 4; ++mi) {
      int row = mb + mi * 16 + lr;
      const bf16_t* ck = p->P + (size_t)row * PW + C_CKV + quad * 32;
      float ss = 0.f;
#pragma unroll
      for (int i = 0; i < 4; ++i) {
        u32x4 w = *(const u32x4*)(ck + i * 8);
        float a;
        a = lo_f(w.x); ss += a * a; a = hi_f(w.x); ss += a * a; a = lo_f(w.y); ss += a * a; a = hi_f(w.y); ss += a * a;
        a = lo_f(w.z); ss += a * a; a = hi_f(w.z); ss += a * a; a = lo_f(w.w); ss += a * a; a = hi_f(w.w); ss += a * a;
      }
      ss += __shfl_xor(ss, 16); ss += __shfl_xor(ss, 32);
      float rinv = rsqrtf(ss * (1.f / 128.f) + 1e-6f);
      int b, key; mla_key_of_row(row, b, key);
      size_t kidx = (size_t)(b * 4 + h) * 16640 + key;
      bf16_t* dst = isv ? p->Vm + kidx * 64 : p->Km + kidx * 96;
#pragma unroll
      for (int ni = 0; ni < 4; ++ni) {
        f32x4 a = acc[mi][ni];
        *(u32x2*)(dst + ni * 16 + quad * 4) = MK2(pack2(a[0] * rinv, a[1] * rinv), pack2(a[2] * rinv, a[3] * rinv));
      }
    }
  }
};

__device__ __forceinline__ void rope64_pair_vals(const bf16_t* base, int pr, int prow, int pcol, const float* rope64, bool rotate, float (&o1)[8], float (&o2)[8], int& c0) {
  c0 = pr < 2 ? pr : pr + 2;
  int pos = pr < 2 ? prow : pcol, i0 = (pr & 1) * 8;
  u32x4 a = *(const u32x4*)(base + c0 * 8), b = *(const u32x4*)(base + (c0 + 2) * 8);
  unsigned aw[4] = {a.x, a.y, a.z, a.w}, bw[4] = {b.x, b.y, b.z, b.w};
#pragma unroll
  for (int e = 0; e < 8; ++e) {
    float x1 = (e & 1) ? hi_f(aw[e >> 1]) : lo_f(aw[e >> 1]);
    float x2 = (e & 1) ? hi_f(bw[e >> 1]) : lo_f(bw[e >> 1]);
    if (rotate) {
      float cs = rope64[(pos * 16 + i0 + e) * 2], sn = rope64[(pos * 16 + i0 + e) * 2 + 1];
      o1[e] = x1 * cs - x2 * sn; o2[e] = x2 * cs + x1 * sn;
    } else { o1[e] = x1; o2[e] = x2; }
  }
}
__device__ __forceinline__ u32x4 pack8(const float (&o)[8]) { return MK4(pack2(o[0], o[1]), pack2(o[2], o[3]), pack2(o[4], o[5]), pack2(o[6], o[7])); }

#define VSTR 80
__device__ void ret_prep_item(const Params& p, int l, int c, int h, char* lds) {
  bf16_t* vL = (bf16_t*)lds;
  bf16_t* kfL = vL + 128 * VSTR;
  bf16_t* kbL = kfL + 128 * VSTR;
  const int tid = otid(), wave = tid >> 6, lane = tid & 63, lr = lane & 15, quad = lane >> 4;
  const bool latent = c < 256;
  const int r0 = c * 128;
  float df = p.ret_decay[l * 8 + h], db = p.ret_decay[l * 8 + 4 + h];
  float lgf = -log1pf(__expf(-df)) * LOG2E, lgb = -log1pf(__expf(-db)) * LOG2E;
  __syncthreads();
#pragma unroll
  for (int i = 0; i < 2; ++i) {
    int idx = tid + 256 * i, r = idx >> 2, pr = idx & 3;
    int row = r0 + r, tok = row & 16383, prow = tok >> 6, pcol = tok & 63;
    bf16_t* kb = p.P + (size_t)row * PW + C_RK + h * 64;
    float o1[8], o2[8]; int c0;
    rope64_pair_vals(kb, pr, prow, pcol, p.rope64, latent, o1, o2, c0);
    if (latent) { *(u32x4*)(kb + c0 * 8) = pack8(o1); *(u32x4*)(kb + (c0 + 2) * 8) = pack8(o2); }
    float wf = exp2f(lgf * (float)(127 - r)) * 0.125f, wb = exp2f(lgb * (float)r) * 0.125f;
    float t1[8], t2[8];
#pragma unroll
    for (int e = 0; e < 8; ++e) { t1[e] = o1[e] * wf; t2[e] = o2[e] * wf; }
    *(u32x4*)(kfL + r * VSTR + c0 * 8) = pack8(t1); *(u32x4*)(kfL + r * VSTR + (c0 + 2) * 8) = pack8(t2);
#pragma unroll
    for (int e = 0; e < 8; ++e) { t1[e] = o1[e] * wb; t2[e] = o2[e] * wb; }
    *(u32x4*)(kbL + r * VSTR + c0 * 8) = pack8(t1); *(u32x4*)(kbL + r * VSTR + (c0 + 2) * 8) = pack8(t2);
    if (latent) {
      bf16_t* qb = p.P + (size_t)row * PW + C_RQ + h * 64;
      rope64_pair_vals(qb, pr, prow, pcol, p.rope64, true, o1, o2, c0);
      *(u32x4*)(qb + c0 * 8) = pack8(o1); *(u32x4*)(qb + (c0 + 2) * 8) = pack8(o2);
    }
  }
#pragma unroll
  for (int i = 0; i < 4; ++i) {
    int idx = tid + 256 * i, r = idx >> 3, ch = idx & 7;
    *(u32x4*)(vL + r * VSTR + ch * 8) = *(const u32x4*)(p.P + (size_t)(r0 + r) * PW + C_RV + h * 64 + ch * 8);
  }
  __syncthreads();
  f32x4 acc[2][4];
#pragma unroll
  for (int d = 0; d < 2; ++d)
#pragma unroll
    for (int j = 0; j < 4; ++j) acc[d][j] = (f32x4){0.f, 0.f, 0.f, 0.f};
  const int roff = (quad * 4 + (lr >> 2)) * VSTR + (lr & 3) * 4;
#pragma unroll
  for (int ks = 0; ks < 4; ++ks) {
    bf16x8 af = cat8(tr_read(vL + ks * 32 * VSTR + roff + wave * 16), tr_read(vL + (ks * 32 + 16) * VSTR + roff + wave * 16));
#pragma unroll
    for (int dt = 0; dt < 4; ++dt) {
      bf16x8 b0 = cat8(tr_read(kfL + ks * 32 * VSTR + roff + dt * 16), tr_read(kfL + (ks * 32 + 16) * VSTR + roff + dt * 16));
      acc[0][dt] = mfma16(af, b0, acc[0][dt]);
      bf16x8 b1 = cat8(tr_read(kbL + ks * 32 * VSTR + roff + dt * 16), tr_read(kbL + (ks * 32 + 16) * VSTR + roff + dt * 16));
      acc[1][dt] = mfma16(af, b1, acc[1][dt]);
    }
  }
#pragma unroll
  for (int dir = 0; dir < 2; ++dir) {
    float* ks = p.Ksum + ((size_t)(dir * 260 + c) * 4 + h) * 4096;
#pragma unroll
    for (int dt = 0; dt < 4; ++dt)
#pragma unroll
      for (int j = 0; j < 4; ++j) ks[(wave * 16 + quad * 4 + j) * 64 + dt * 16 + lr] = acc[dir][dt][j];
  }
}

__device__ void swa_rope_item(const Params& p, int mt) {
  const int tid = otid();
  for (int idx = tid; idx < 128 * 24; idx += 256) {
    int r = idx / 24, pp = idx % 24;
    int row = mt * 128 + r, tok = row & 16383, prow = tok >> 6, pcol = tok & 63;
    int hd = pp >> 2, pr = pp & 3;
    bf16_t* base = p.P + (size_t)row * PW + (hd < 4 ? C_SQ + hd * 64 : C_SK + (hd - 4) * 64);
    float o1[8], o2[8]; int c0;
    rope64_pair_vals(base, pr, prow, pcol, p.rope64, true, o1, o2, c0);
    *(u32x4*)(base + c0 * 8) = pack8(o1); *(u32x4*)(base + (c0 + 2) * 8) = pack8(o2);
  }
}

__device__ void mla_krope_item(const Params& p, int m0, int h) {
  const int tid = otid();
  int row = m0 + (tid >> 1), part = tid & 1;
  bool latent = row < NLAT;
  int tok = row & 16383, pos = part == 0 ? (tok >> 6) : (tok & 63);
  const bf16_t* src = p.P + (size_t)row * PW + C_KR + part * 16;
  u32x4 a = *(const u32x4*)src, b = *(const u32x4*)(src + 8);
  unsigned aw[4] = {a.x, a.y, a.z, a.w}, bw[4] = {b.x, b.y, b.z, b.w};
  float o1[8], o2[8];
#pragma unroll
  for (int e = 0; e < 8; ++e) {
    float x1 = (e & 1) ? hi_f(aw[e >> 1]) : lo_f(aw[e >> 1]);
    float x2 = (e & 1) ? hi_f(bw[e >> 1]) : lo_f(bw[e >> 1]);
    if (latent) {
      float cs = p.rope32[(pos * 8 + e) * 2], sn = p.rope32[(pos * 8 + e) * 2 + 1];
      o1[e] = x1 * cs - x2 * sn; o2[e] = x2 * cs + x1 * sn;
    } else { o1[e] = x1; o2[e] = x2; }
  }
  int b_, key; mla_key_of_row(row, b_, key);
  bf16_t* dst = p.Km + ((size_t)(b_ * 4 + h) * 16640 + key) * 96 + 64 + part * 16;
  *(u32x4*)dst = pack8(o1); *(u32x4*)(dst + 8) = pack8(o2);
}

struct KVT { const bf16_t* k; const bf16_t* v; };

template <int DQK, bool SOFTMAX, bool PLAIN, class TileFn, class MaskFn>
__device__ __forceinline__ void attn_core(const bf16x8 (&qf)[2][DQK / 32], int ntiles, const TileFn& tf, int ldk, int ldv, const MaskFn& mk,
                                          f32x4 (&o)[4][2], float (&m)[2], float (&l)[2], char* lds) {
  constexpr int KSTR = DQK + 16, NKS = DQK / 32, KCH = DQK / 8, NKL = (64 * KCH) / 256;
  bf16_t* Kl = (bf16_t*)lds;
  bf16_t* Vl = Kl + 2 * 64 * KSTR;
  const int tid = otid(), wave = tid >> 6, lane = tid & 63, lr = lane & 15, quad = lane >> 4;
  constexpr bool MFMA_SUM = SOFTMAX && PLAIN;
  f32x4 lacc[2] = {(f32x4){0.f, 0.f, 0.f, 0.f}, (f32x4){0.f, 0.f, 0.f, 0.f}};
  u32x4 rk[NKL], rv[2];
  unsigned koff[NKL], voff[2];
#pragma unroll
  for (int i = 0; i < NKL; ++i) { int c = tid + i * 256, r = c / KCH, ch = c % KCH; koff[i] = (unsigned)(r * ldk + ch * 8) * 2u; }
#pragma unroll
  for (int i = 0; i < 2; ++i) { int c = tid + i * 256, r = c >> 3, ch = c & 7; voff[i] = (unsigned)(r * ldv + ch * 8) * 2u; }
  __syncthreads();
  {
    KVT kv = tf(0);
    rsrc_t kr = mkbuf(kv.k), vr = mkbuf(kv.v);
#pragma unroll
    for (int i = 0; i < NKL; ++i) rk[i] = bload16(kr, koff[i], 0);
#pragma unroll
    for (int i = 0; i < 2; ++i) rv[i] = bload16(vr, voff[i], 0);
#pragma unroll
    for (int i = 0; i < NKL; ++i) { int c = tid + i * 256, r = c / KCH, ch = c % KCH; *(u32x4*)(Kl + r * KSTR + ch * 8) = rk[i]; }
#pragma unroll
    for (int i = 0; i < 2; ++i) { int c = tid + i * 256, r = c >> 3, ch = c & 7; *(u32x4*)(Vl + r * VSTR + ch * 8) = rv[i]; }
  }
  __syncthreads();
  for (int t = 0; t < ntiles; ++t) {
    const int cur = t & 1;
    if (t + 1 < ntiles) {
      KVT kv = tf(t + 1);
      rsrc_t kr = mkbuf(kv.k), vr = mkbuf(kv.v);
#pragma unroll
      for (int i = 0; i < NKL; ++i) rk[i] = bload16(kr, koff[i], 0);
#pragma unroll
      for (int i = 0; i < 2; ++i) rv[i] = bload16(vr, voff[i], 0);
    }
    f32x4 s[4][2];
#pragma unroll
    for (int kt = 0; kt < 4; ++kt) { s[kt][0] = (f32x4){0.f, 0.f, 0.f, 0.f}; s[kt][1] = (f32x4){0.f, 0.f, 0.f, 0.f}; }
    const bf16_t* kb = Kl + cur * 64 * KSTR + lr * KSTR + quad * 8;
    {
      bf16x8 kfa[NKS][4];
#pragma unroll
      for (int ks = 0; ks < NKS; ++ks)
#pragma unroll
        for (int kt = 0; kt < 4; ++kt) kfa[ks][kt] = *(const bf16x8*)(kb + kt * 16 * KSTR + ks * 32);
#pragma unroll
      for (int ks = 0; ks < NKS; ++ks)
#pragma unroll
        for (int kt = 0; kt < 4; ++kt) {
          s[kt][0] = mfma16(kfa[ks][kt], qf[0][ks], s[kt][0]);
          s[kt][1] = mfma16(kfa[ks][kt], qf[1][ks], s[kt][1]);
        }
    }
    if (!PLAIN) {
#pragma unroll
      for (int kt = 0; kt < 4; ++kt)
#pragma unroll
        for (int qt = 0; qt < 2; ++qt)
#pragma unroll
          for (int j = 0; j < 4; ++j) s[kt][qt][j] = mk(t, wave * 32 + qt * 16 + lr, kt * 16 + quad * 4 + j, s[kt][qt][j]);
    }
    if (SOFTMAX) {
      const float sl2 = PLAIN ? mk(0, 0, 0, 1.0f) : 1.0f;
      float mnew[2], alpha[2];
#pragma unroll
      for (int qt = 0; qt < 2; ++qt) {
        float mx = fmaxf(fmaxf(s[0][qt][0], s[0][qt][1]), fmaxf(s[0][qt][2], s[0][qt][3]));
#pragma unroll
        for (int kt = 1; kt < 4; ++kt) mx = fmaxf(fmaxf(mx, s[kt][qt][0]), fmaxf(fmaxf(s[kt][qt][1], s[kt][qt][2]), s[kt][qt][3]));
        mx = fmaxf(mx, __shfl_xor(mx, 16)); mx = fmaxf(mx, __shfl_xor(mx, 32));
        if (PLAIN) mx *= sl2;
        mnew[qt] = fmaxf(m[qt], mx);
        alpha[qt] = __builtin_amdgcn_exp2f(m[qt] - mnew[qt]);
        m[qt] = mnew[qt];
      }
      if (__any((alpha[0] < 1.f) | (alpha[1] < 1.f))) {
#pragma unroll
        for (int qt = 0; qt < 2; ++qt) {
          l[qt] *= alpha[qt];
          if (MFMA_SUM) { lacc[qt][0] *= alpha[qt]; lacc[qt][1] *= alpha[qt]; lacc[qt][2] *= alpha[qt]; lacc[qt][3] *= alpha[qt]; }
#pragma unroll
          for (int dt = 0; dt < 4; ++dt)
#pragma unroll
            for (int j = 0; j < 4; ++j) o[dt][qt][j] *= alpha[qt];
        }
      }
#pragma unroll
      for (int qt = 0; qt < 2; ++qt) {
        float ls = 0.f;
        const float nm = -mnew[qt];
#pragma unroll
        for (int kt = 0; kt < 4; ++kt)
#pragma unroll
          for (int j = 0; j < 4; ++j) {
            float pv = __builtin_amdgcn_exp2f(PLAIN ? fmaf(s[kt][qt][j], sl2, nm) : s[kt][qt][j] + nm);
            s[kt][qt][j] = pv; if (!MFMA_SUM) ls += pv;
          }
        if (!MFMA_SUM) l[qt] += ls;
      }
    }
    bf16x8 pf[2][2];
#pragma unroll
    for (int qt = 0; qt < 2; ++qt)
#pragma unroll
      for (int kk = 0; kk < 2; ++kk) {
        unsigned w0 = pack2(s[2 * kk][qt][0], s[2 * kk][qt][1]), w1 = pack2(s[2 * kk][qt][2], s[2 * kk][qt][3]);
        unsigned w2 = pack2(s[2 * kk + 1][qt][0], s[2 * kk + 1][qt][1]), w3 = pack2(s[2 * kk + 1][qt][2], s[2 * kk + 1][qt][3]);
        u32x4 u = MK4(w0, w1, w2, w3);
        pf[qt][kk] = __builtin_bit_cast(bf16x8, u);
      }
    const bf16_t* vb = Vl + cur * 64 * VSTR + (quad * 4 + (lr >> 2)) * VSTR + (lr & 3) * 4;
    {
      bf16x8 vfa[2][4];
#pragma unroll
      for (int kk = 0; kk < 2; ++kk)
#pragma unroll
        for (int dt = 0; dt < 4; ++dt) vfa[kk][dt] = cat8(tr_read(vb + (kk * 32) * VSTR + dt * 16), tr_read(vb + (kk * 32 + 16) * VSTR + dt * 16));
#pragma unroll
      for (int kk = 0; kk < 2; ++kk)
#pragma unroll
        for (int dt = 0; dt < 4; ++dt) {
          o[dt][0] = mfma16(vfa[kk][dt], pf[0][kk], o[dt][0]);
          o[dt][1] = mfma16(vfa[kk][dt], pf[1][kk], o[dt][1]);
        }
      if (MFMA_SUM) {
        const bf16x8 ones = {(short)0x3f80, (short)0x3f80, (short)0x3f80, (short)0x3f80, (short)0x3f80, (short)0x3f80, (short)0x3f80, (short)0x3f80};
#pragma unroll
        for (int kk = 0; kk < 2; ++kk) { lacc[0] = mfma16(ones, pf[0][kk], lacc[0]); lacc[1] = mfma16(ones, pf[1][kk], lacc[1]); }
      }
    }
    if (t + 1 < ntiles) {
      const int nx = cur ^ 1;
#pragma unroll
      for (int i = 0; i < NKL; ++i) { int c = tid + i * 256, r = c / KCH, ch = c % KCH; *(u32x4*)(Kl + nx * 64 * KSTR + r * KSTR + ch * 8) = rk[i]; }
#pragma unroll
      for (int i = 0; i < 2; ++i) { int c = tid + i * 256, r = c >> 3, ch = c & 7; *(u32x4*)(Vl + nx * 64 * VSTR + r * VSTR + ch * 8) = rv[i]; }
    }
    __syncthreads();
  }
  if (MFMA_SUM) { const int quad_ = (otid() & 63) >> 4; l[0] = quad_ == 0 ? lacc[0][0] : 0.f; l[1] = quad_ == 0 ? lacc[1][0] : 0.f; }
}

__device__ __forceinline__ void attn_store(f32x4 (&o)[4][2], float (&m)[2], float (&l)[2], bool has_sink, float sink_l2, bf16_t* dst  , int ldo) {
  const int lane = otid() & 63, wave = otid() >> 6, lr = lane & 15, quad = lane >> 4;
#pragma unroll
  for (int qt = 0; qt < 2; ++qt) {
    float lt = l[qt]; lt += __shfl_xor(lt, 16); lt += __shfl_xor(lt, 32);
    if (has_sink) lt += exp2f(sink_l2 - m[qt]);
    float inv = 1.f / lt;
    bf16_t* rp = dst + (size_t)(wave * 32 + qt * 16 + lr) * ldo + quad * 4;
#pragma unroll
    for (int dt = 0; dt < 4; ++dt)
      *(u32x2*)(rp + dt * 16) = MK2(pack2(o[dt][qt][0] * inv, o[dt][qt][1] * inv), pack2(o[dt][qt][2] * inv, o[dt][qt][3] * inv));
  }
}

template <int NKS>
__device__ __forceinline__ void load_q(bf16x8 (&qf)[2][NKS], const bf16_t* q  , int ldq) {
  const int lane = otid() & 63, wave = otid() >> 6, lr = lane & 15, quad = lane >> 4;
#pragma unroll
  for (int qt = 0; qt < 2; ++qt)
#pragma unroll
    for (int ks = 0; ks < NKS; ++ks) qf[qt][ks] = *(const bf16x8*)(q + (size_t)(wave * 32 + qt * 16 + lr) * ldq + ks * 32 + quad * 8);
}

struct TileContig { const bf16_t* k; const bf16_t* v; size_t ks, vs;
  __device__ __forceinline__ KVT operator()(int t) const { return KVT{k + (size_t)t * ks, v + (size_t)t * vs}; } };
struct MaskScale { float sl2; __device__ __forceinline__ float operator()(int, int, int, float s) const { return s * sl2; } };

__device__ void mla_item(const Params& p, int b, int h, int qt128, bool ctxq, char* lds) {
  int r0 = ctxq ? NLAT + b * 256 + qt128 * 128 : b * 16384 + qt128 * 128;
  bf16x8 qf[2][3];
  load_q<3>(qf, p.Qm + (size_t)r0 * 384 + h * 96, 384);
  f32x4 o[4][2]; float m[2] = {-1e30f, -1e30f}, l[2] = {0.f, 0.f};
#pragma unroll
  for (int dt = 0; dt < 4; ++dt) { o[dt][0] = (f32x4){0.f, 0.f, 0.f, 0.f}; o[dt][1] = (f32x4){0.f, 0.f, 0.f, 0.f}; }
  int t0 = ctxq ? 256 : 0, nt = ctxq ? 4 : 260;
  size_t kbase = (size_t)(b * 4 + h) * 16640 + (size_t)t0 * 64;
  TileContig tf{p.Km + kbase * 96, p.Vm + kbase * 64, (size_t)64 * 96, (size_t)64 * 64};
  MaskScale mk{0.10206207261596575f * LOG2E};
  attn_core<96, true, true>(qf, nt, tf, 96, 64, mk, o, m, l, lds);
  attn_store(o, m, l, false, 0.f, p.ACT + (size_t)r0 * 1024 + h * 64, 1024);
}

struct NaTiles { const bf16_t* P; int b, h, lo, nw;
  __device__ __forceinline__ KVT operator()(int t) const {
    size_t row = t < nw ? (size_t)b * 16384 + (size_t)(lo + t) * 64 : (size_t)NLAT + b * 256 + (size_t)(t - nw) * 64;
    return KVT{P + row * PW + C_NK + h * 64, P + row * PW + C_NV + h * 64}; } };
struct NaMask { const float* rpb; int nw, lo, qr0; float sl2;
  __device__ __forceinline__ float operator()(int t, int qi, int kj, float s) const {
    if (t >= nw) return s * sl2;
    int qr = qr0 + (qi >> 6), qc = qi & 63, kr = lo + t;
    int r0q = min(max(qr - 4, 0), 248), c0 = min(max(qc - 8, 0), 48);
    bool ok = (kr >= r0q) & (kr < r0q + 8) & (kj >= c0) & (kj < c0 + 16);
    int dr = min(max(kr - qr + 7, 0), 14), dc = min(max(kj - qc, -15), 15) + 15;
    float bias = rpb[dr * 31 + dc];
    return ok ? s * sl2 + bias * LOG2E : -INFINITY; } };

__device__ void na_item(const Params& p, int l, int b, int h, int pair, char* lds) {
  float* rpbL = (float*)(lds + 60000);
  __syncthreads();
  for (int i = otid(); i < 465; i += 256) rpbL[i] = p.na_rpb[(size_t)(l * 4 + h) * 465 + i];
  int r0 = b * 16384 + pair * 128;
  bf16x8 qf[2][2];
  load_q<2>(qf, p.P + (size_t)r0 * PW + C_NQ + h * 64, PW);
  f32x4 o[4][2]; float m[2] = {-1e30f, -1e30f}, ls[2] = {0.f, 0.f};
#pragma unroll
  for (int dt = 0; dt < 4; ++dt) { o[dt][0] = (f32x4){0.f, 0.f, 0.f, 0.f}; o[dt][1] = (f32x4){0.f, 0.f, 0.f, 0.f}; }
  int qr0 = pair * 2;
  int lo = min(max(qr0 - 4, 0), 248), hi = min(max(qr0 + 1 - 4, 0), 248) + 7;
  int nw = hi - lo + 1;
  NaTiles tf{p.P, b, h, lo, nw};
  NaMask mk{rpbL, nw, lo, qr0, 0.125f * LOG2E};
  attn_core<64, true, false>(qf, nw + 4, tf, PW, PW, mk, o, m, ls, lds);
  attn_store(o, m, ls, false, 0.f, p.ACT + (size_t)r0 * 1024 + 512 + h * 64, 1024);
}

struct SwaTiles { const bf16_t* P; int b, kvh, nlo, nwt;
  __device__ __forceinline__ KVT operator()(int t) const {
    size_t row = t < nwt ? (size_t)b * 16384 + (size_t)(nlo * 128 + t * 64) : (size_t)NLAT + b * 256 + (size_t)(t - nwt) * 64;
    return KVT{P + row * PW + C_SK + kvh * 64, P + row * PW + C_SV + kvh * 64}; } };
struct SwaMask { int nwt, koff  ; float sl2;
  __device__ __forceinline__ float operator()(int t, int qi, int kj, float s) const {
    if (t >= nwt) return s * sl2;
    int delta = koff + t * 64 + kj - qi;
    return (delta <= 128 && delta >= -128) ? s * sl2 : -INFINITY; } };

__device__ void swa_item(const Params& p, int l, int b, int hq, int n, bool ctxq, char* lds) {
  int r0 = ctxq ? NLAT + b * 256 + n * 128 : b * 16384 + n * 128;
  bf16x8 qf[2][2];
  load_q<2>(qf, p.P + (size_t)r0 * PW + C_SQ + hq * 64, PW);
  f32x4 o[4][2]; float m[2] = {-1e30f, -1e30f}, ls[2] = {0.f, 0.f};
#pragma unroll
  for (int dt = 0; dt < 4; ++dt) { o[dt][0] = (f32x4){0.f, 0.f, 0.f, 0.f}; o[dt][1] = (f32x4){0.f, 0.f, 0.f, 0.f}; }
  int nlo = 0, nwt = 0;
  if (!ctxq) { nlo = max(n - 1, 0); int nhi = min(n + 1, 127); nwt = (nhi - nlo + 1) * 2; }
  SwaTiles tf{p.P, b, hq >> 1, nlo, nwt};
  SwaMask mk{nwt, (nlo - n) * 128, 0.125f * LOG2E};
  attn_core<64, true, false>(qf, nwt + 4, tf, PW, PW, mk, o, m, ls, lds);
  float sink = p.swa_sink[l * 4 + hq] * LOG2E;
  attn_store(o, m, ls, true, sink, p.ACT + (size_t)r0 * 1024 + 768 + hq * 64, 1024);
}

__device__ void na_ctx_item(const Params& p, int b, int h, int n, char* lds) {
  int r0 = NLAT + b * 256 + n * 128;
  bf16x8 qf[2][2];
  load_q<2>(qf, p.P + (size_t)r0 * PW + C_NQ + h * 64, PW);
  f32x4 o[4][2]; float m[2] = {-1e30f, -1e30f}, ls[2] = {0.f, 0.f};
#pragma unroll
  for (int dt = 0; dt < 4; ++dt) { o[dt][0] = (f32x4){0.f, 0.f, 0.f, 0.f}; o[dt][1] = (f32x4){0.f, 0.f, 0.f, 0.f}; }
  NaTiles tf{p.P, b, h, 0, 0};
  MaskScale mk{0.125f * LOG2E};
  attn_core<64, true, true>(qf, 4, tf, PW, PW, mk, o, m, ls, lds);
  attn_store(o, m, ls, false, 0.f, p.ACT + (size_t)r0 * 1024 + 512 + h * 64, 1024);
}

__device__ void ret_scan_item(const Params& p, int l, int combo, int part) {
  int dir = combo >> 3, b = (combo >> 2) & 1, h = combo & 3;
  float d = p.ret_decay[l * 8 + dir * 4 + h];
  float lg = -log1pf(__expf(-d)) * LOG2E;
  float gC = exp2f(lg * 128.f);
  int idx = part * 1024 + otid() * 4;
  f32x4 S = (f32x4){0.f, 0.f, 0.f, 0.f};
  const size_t dbase = ((size_t)dir * 260 * 4 + h) * 4096 + idx;
#pragma unroll 1
  for (int s0 = 0; s0 < 130; s0 += 13) {
    f32x4 kv[13]; int ch[13];
#pragma unroll
    for (int u = 0; u < 13; ++u) {
      int step = s0 + u;
      if (dir == 0) ch[u] = step < 2 ? 256 + 2 * b + step : b * 128 + (step - 2);
      else ch[u] = step < 2 ? 256 + 2 * b + 1 - step : b * 128 + 127 - (step - 2);
      kv[u] = *(const f32x4*)(p.Ksum + dbase + (size_t)ch[u] * 16384);
    }
#pragma unroll
    for (int u = 0; u < 13; ++u) {
      *(u32x2*)(p.St + dbase + (size_t)ch[u] * 16384) = MK2(pack2(S[0], S[1]), pack2(S[2], S[3]));
#pragma unroll
      for (int j = 0; j < 4; ++j) S[j] = S[j] * gC + kv[u][j];
    }
  }
}

struct RetMask { float lg; int dir;
  __device__ __forceinline__ float operator()(int t, int qi, int kj, float s) const {
    int j = t * 64 + kj; int df = dir == 0 ? qi - j : j - qi;
    return df >= 0 ? s * 0.125f * __builtin_amdgcn_exp2f(lg * (float)df) : 0.f; } };

__device__ void ret_out_item(const Params& p, int l, int c, int h, char* lds) {
  const int lane = otid() & 63, wave = otid() >> 6, lr = lane & 15, quad = lane >> 4;
  int r0 = c * 128;
  bf16x8 qf[2][2];
  load_q<2>(qf, p.P + (size_t)r0 * PW + C_RQ + h * 64, PW);
  f32x4 res[4][2];
#pragma unroll
  for (int dt = 0; dt < 4; ++dt) { res[dt][0] = (f32x4){0.f, 0.f, 0.f, 0.f}; res[dt][1] = (f32x4){0.f, 0.f, 0.f, 0.f}; }
  TileContig tf{p.P + (size_t)r0 * PW + C_RK + h * 64, p.P + (size_t)r0 * PW + C_RV + h * 64, (size_t)64 * PW, (size_t)64 * PW};
#pragma unroll 1
  for (int dir = 0; dir < 2; ++dir) {
    float d = p.ret_decay[l * 8 + dir * 4 + h];
    float lg = -log1pf(__expf(-d)) * LOG2E;
    f32x4 o[4][2]; float m[2] = {0.f, 0.f}, ls[2] = {0.f, 0.f};
#pragma unroll
    for (int dt = 0; dt < 4; ++dt) { o[dt][0] = (f32x4){0.f, 0.f, 0.f, 0.f}; o[dt][1] = (f32x4){0.f, 0.f, 0.f, 0.f}; }
    rsrc_t str = mkbuf(p.St + ((size_t)(dir * 260 + c) * 4 + h) * 4096);
#pragma unroll
    for (int ks = 0; ks < 2; ++ks)
#pragma unroll
      for (int et = 0; et < 4; ++et) {
        bf16x8 af = __builtin_bit_cast(bf16x8, bload16(str, (unsigned)(lr * 64 + quad * 8) * 2u, (unsigned)(et * 16 * 64 + ks * 32) * 2u));
        o[et][0] = mfma16(af, qf[0][ks], o[et][0]);
        o[et][1] = mfma16(af, qf[1][ks], o[et][1]);
      }
#pragma unroll
    for (int qt = 0; qt < 2; ++qt) {
      int i = wave * 32 + qt * 16 + lr;
      float qdec = exp2f(lg * (float)(dir == 0 ? i + 1 : 128 - i));
#pragma unroll
      for (int et = 0; et < 4; ++et)
#pragma unroll
        for (int j = 0; j < 4; ++j) o[et][qt][j] *= qdec;
    }
    __builtin_amdgcn_sched_barrier(0);
    RetMask mk{lg, dir};
    attn_core<64, false, false>(qf, 2, tf, PW, PW, mk, o, m, ls, lds);
    __builtin_amdgcn_sched_barrier(0);
#pragma unroll
    for (int qt = 0; qt < 2; ++qt) {
      int i = wave * 32 + qt * 16 + lr;
      float ss = 0.f;
#pragma unroll
      for (int et = 0; et < 4; ++et)
#pragma unroll
        for (int j = 0; j < 4; ++j) { float v = o[et][qt][j]; ss += v * v; }
      ss += __shfl_xor(ss, 16); ss += __shfl_xor(ss, 32);
      float rinv = rsqrtf(ss * (1.f / 64.f) + 1e-6f);
      rsrc_t gpr = mkbuf(p.P + (size_t)r0 * PW + (dir == 0 ? C_RGF : C_RGB) + h * 64);
      unsigned goff = (unsigned)(i * PW + quad * 4) * 2u;
#pragma unroll
      for (int et = 0; et < 4; ++et) {
        u32x2 gw = bload8(gpr, goff, et * 32);
        float g0 = lo_f(gw.x), g1 = hi_f(gw.x), g2 = lo_f(gw.y), g3 = hi_f(gw.y);
        res[et][qt][0] += o[et][qt][0] * rinv * silu_f(g0);
        res[et][qt][1] += o[et][qt][1] * rinv * silu_f(g1);
        res[et][qt][2] += o[et][qt][2] * rinv * silu_f(g2);
        res[et][qt][3] += o[et][qt][3] * rinv * silu_f(g3);
      }
    }
  }
#pragma unroll
  for (int qt = 0; qt < 2; ++qt) {
    bf16_t* rp = p.ACT + (size_t)(r0 + wave * 32 + qt * 16 + lr) * 1024 + 256 + h * 64 + quad * 4;
#pragma unroll
    for (int et = 0; et < 4; ++et)
      *(u32x2*)(rp + et * 16) = MK2(pack2(res[et][qt][0], res[et][qt][1]), pack2(res[et][qt][2], res[et][qt][3]));
  }
}


#define XB_TMO      128
#define XB_XCNT(j)  (256  + 64 * (j))
#define XB_XSUB(j)  (1280 + 64 * (j))
#define XB_XGEN(j)  (2304 + 64 * (j))
#define XB_TOP      3328
#define XB_TOPGEN   3392
#define XCD_BAR_WORDS 3456
#define XB_SPIN_CAP (1u << 20)
#define LAS __attribute__((address_space(3)))
__device__ __forceinline__ unsigned xb_ld(unsigned* p)              { return __hip_atomic_load(p, __ATOMIC_RELAXED, __HIP_MEMORY_SCOPE_AGENT); }
__device__ __forceinline__ unsigned xb_add(unsigned* p, unsigned v) { return __hip_atomic_fetch_add(p, v, __ATOMIC_RELAXED, __HIP_MEMORY_SCOPE_AGENT); }
__device__ __forceinline__ unsigned xb_xcc_id() { return (unsigned)__builtin_amdgcn_s_getreg((3 << 11) | 20) & 0xFu; }
#define XB_SPIN(cond, bar) do { unsigned _sp = 0; while (cond) { __builtin_amdgcn_s_sleep(1); \
    if ((++_sp & 255u) == 0u) { if (xb_ld(&(bar)[XB_TMO])) break; if (_sp > XB_SPIN_CAP) { atomicAdd(&(bar)[XB_TMO], 1u); break; } } } } while (0)
struct XcdBarrier { unsigned* bar; unsigned x; volatile LAS unsigned* st; };
__device__ __forceinline__ XcdBarrier xcd_barrier_post(unsigned* bar, volatile LAS unsigned* st) {
    XcdBarrier b; b.bar = bar; b.x = xb_xcc_id(); b.st = st;
    if (threadIdx.x == 0) (void)xb_add(&bar[XB_XCNT(b.x)], 1u);
    return b;
}
__device__ __forceinline__ void xcd_barrier_complete(unsigned* bar, unsigned x, unsigned& nloc, unsigned& nx) {
    const unsigned G = gridDim.x * gridDim.y * gridDim.z;
    unsigned sum, cnt, mine, sp = 0u;
    for (;;) {
        sum = 0u; cnt = 0u; mine = 0u;
#pragma unroll
        for (unsigned j = 0; j < 16; ++j) { const unsigned c = xb_ld(&bar[XB_XCNT(j)]); sum += c; cnt += (c > 0u) ? 1u : 0u; mine = (j == x) ? c : mine; }
        if (sum == G) break;
        __builtin_amdgcn_s_sleep(1);
        if ((++sp & 255u) == 0u) { if (xb_ld(&bar[XB_TMO])) break; if (sp > XB_SPIN_CAP) { atomicAdd(&bar[XB_TMO], 1u); break; } }
    }
    nloc = mine > 0u ? mine : 1u; nx = cnt > 0u ? cnt : 1u;
}
__device__ __forceinline__ void xcd_barrier(const XcdBarrier& b) {
    asm volatile("s_waitcnt vmcnt(0)" ::: "memory");
    __syncthreads();
    if (threadIdx.x == 0) {
        unsigned* bar = b.bar;
        __builtin_amdgcn_s_waitcnt(0);
        unsigned nloc = b.st[0], nx = b.st[1];
        if (nloc == 0u) { xcd_barrier_complete(bar, b.x, nloc, nx); b.st[0] = nloc; b.st[1] = nx; }
        const unsigned old = xb_add(&bar[XB_XSUB(b.x)], 1u);
        const unsigned gen = old / nloc;
        if (old + 1u == (gen + 1u) * nloc) {
            __builtin_amdgcn_fence(__ATOMIC_RELEASE, "agent");
            asm volatile("s_waitcnt vmcnt(0)" ::: "memory");
            const unsigned og = xb_add(&bar[XB_TOP], 1u);
            const unsigned tg = og / nx;
            if (og + 1u == (tg + 1u) * nx) xb_add(&bar[XB_TOPGEN], 1u);
            else XB_SPIN(xb_ld(&bar[XB_TOPGEN]) == tg, bar);
            __builtin_amdgcn_fence(__ATOMIC_ACQUIRE, "agent");
            xb_add(&bar[XB_XGEN(b.x)], 1u);
            asm volatile("s_waitcnt vmcnt(0)" ::: "memory");
        } else {
            XB_SPIN(xb_ld(&bar[XB_XGEN(b.x)]) == gen, bar);
            __builtin_amdgcn_fence(__ATOMIC_ACQUIRE, "agent");
            asm volatile("s_waitcnt vmcnt(0)" ::: "memory");
        }
    }
    __syncthreads();
}

__device__ void run_phase(const Params& p, int ph, int bid, int nb, char* lds) {
#ifndef CM
#define CM 0xff
#endif
#ifndef PH_MASK
#define PH_MASK 0xfffff
#endif
  if (ph == 0) { if (PH_MASK & (1<<9)) prologue_phase(p, bid, nb, lds); return; }
  if (ph == 37) { if (PH_MASK & (1<<10)) final_norm_phase(p, bid, nb); return; }
  const int l = (ph - 1) / 9, sp = (ph - 1) % 9;
  const bf16_t* W = p.W + (size_t)l * W_LAYER;
  if (!((PH_MASK >> sp) & 1)) return;
  switch (sp) {
    case 0: norm_phase(p, l, 0, bid, nb); break;
    case 1: {
      EpiWin epi{p.P};
      for (int rd = 0;; ++rd) { int t = xcd_tile(rd, bid, nb); if (t >= 128 * 24) break; int pm, pn; big_coord(t, 24, pm, pn); gemm_big_tile(p.ACT, 1024, W + WO_IN, 1024, 1024, pm * 256, pn * 128, epi, lds); }
      for (int u = bid; u < 4 * 24; u += nb) gemm_tile(p.ACT, 1024, W + WO_IN, 1024, 1024, (256 + u / 24) * 128, (u % 24) * 128, epi, lds);
    } break;
    case 2: {
      EpiUq eq{&p}; EpiUkv ekv{&p};
      const int n0 = 260 * 4, n1 = n0 + 260 * 4, n2 = n1 + 260 * 3, n3 = n2 + 256;
      for (int t = bid; t < n3; t += nb) {
        if (t < n0) ret_prep_item(p, l, t >> 2, t & 3, lds);
        else if (t < n1) { int u = t - n0, pm = u >> 2, h = u & 3; gemm_tile(p.P + C_CKV, PW, W + WO_UKV, 128, 128, pm * 128, h * 128, ekv, lds); mla_krope_item(p, pm * 128, h); }
        else if (t < n2) { int u = t - n1, pm = u / 3, pn = u % 3; gemm_tile(p.P + C_CQ, PW, W + WO_UQ, 256, 256, pm * 128, pn * 128, eq, lds); }
        else swa_rope_item(p, t - n2);
      }
    } break;
    case 3: {
      int* slot = (int*)(lds + LDS_BYTES - 16);
      if (bid < 64) {
        if (CM & 2) ret_scan_item(p, l, bid >> 2, bid & 3);
        asm volatile("s_waitcnt vmcnt(0)" ::: "memory");
        __syncthreads();
        if (otid() == 0) { __builtin_amdgcn_fence(__ATOMIC_RELEASE, "agent"); asm volatile("s_waitcnt vmcnt(0)" ::: "memory"); xb_add(p.bar + 40 + l, 1u); }
      }
      bool scan_ready = false;
      const int x = bid & 7;
      for (int pass = 0; pass < 8; ++pass) {
        const int cmb = (x + pass) & 7;
        for (;;) {
          __syncthreads();
          if (otid() == 0) *slot = (int)atomicAdd(p.bar + 8 + l * 8 + cmb, 1u);
          __syncthreads();
          const int q = *slot;
          if (q >= 128) break;
          if (CM & 1) mla_item(p, cmb >> 2, cmb & 3, q, false, lds);
        }
      }
      const int n1 = 1024, n2 = n1 + 1024, n3 = n2 + 16, n4 = n3 + 16, n5 = n4 + 16, n6 = n5 + 1040;
      for (;;) {
        __syncthreads();
        if (otid() == 0) *slot = (int)atomicAdd(p.bar + l, 1u);
        __syncthreads();
        const int t = *slot;
        if (t >= n6) break;
        if (t < n1) { int u = t; if (CM & 4) na_item(p, l, u >> 9, (u >> 7) & 3, u & 127, lds); }
        else if (t < n2) { int u = t - n1; if (CM & 16) swa_item(p, l, u >> 9, (u >> 7) & 3, u & 127, false, lds); }
        else if (t < n3) { int u = t - n2; if (CM & 1) mla_item(p, u >> 3, (u >> 1) & 3, u & 1, true, lds); }
        else if (t < n4) { int u = t - n3; if (CM & 8) na_ctx_item(p, u >> 3, (u >> 1) & 3, u & 1, lds); }
        else if (t < n5) { int u = t - n4; if (CM & 16) swa_item(p, l, u >> 3, (u >> 1) & 3, u & 1, true, lds); }
        else {
          if (!scan_ready) {
            if (otid() == 0) { unsigned sp = 0; while (xb_ld(p.bar + 40 + l) < 64u && ++sp < (1u << 22)) __builtin_amdgcn_s_sleep(2); }
            __syncthreads();
            __builtin_amdgcn_fence(__ATOMIC_ACQUIRE, "agent");
            asm volatile("s_waitcnt vmcnt(0)" ::: "memory");
            scan_ready = true;
          }
          int u = t - n5; ret_out_item(p, l, u >> 2, u & 3, lds);
        }
      }
    } break;
    case 4: break;
    case 5: {
      EpiResid epi{&p, l, 2048, 1};
      for (int rd = 0;; ++rd) { int t = xcd_tile(rd, bid, nb); if (t >= 128 * 8) break; int pm, pn; big_coord(t, 8, pm, pn); gemm_big_tile(p.ACT, 1024, W + WO_OUT, 1024, 1024, pm * 256, pn * 128, epi, lds); }
      if (l < 3) for (int u = bid; u < 4 * 8; u += nb) gemm_tile(p.ACT, 1024, W + WO_OUT, 1024, 1024, (256 + (u >> 3)) * 128, (u & 7) * 128, epi, lds);
    } break;
    case 6: norm_phase(p, l, 1, bid, nb); break;
    case 7: {
      EpiFfn1 epi{p.P};
      for (int rd = 0;; ++rd) { int t = xcd_tile(rd, bid, nb); if (t >= 128 * 44) break; int pm, pn; big_coord(t, 44, pm, pn); gemm_big_tile(p.ACT, 1024, W + WO_13, 1024, 1024, pm * 256, pn * 128, epi, lds); }
      if (l < 3) for (int u = bid; u < 4 * 44; u += nb) gemm_tile(p.ACT, 1024, W + WO_13, 1024, 1024, (256 + u / 44) * 128, (u % 44) * 128, epi, lds);
    } break;
    case 8: {
      EpiResid epi{&p, l, 5120, 0};
      for (int rd = 0;; ++rd) { int t = xcd_tile(rd, bid, nb); if (t >= 128 * 8) break; int pm, pn; big_coord(t, 8, pm, pn); gemm_big_tile(p.P, 2816, W + WO_2, 2816, 2816, pm * 256, pn * 128, epi, lds); }
      if (l < 3) for (int u = bid; u < 4 * 8; u += nb) gemm_tile(p.P, 2816, W + WO_2, 2816, 2816, (256 + (u >> 3)) * 128, (u & 7) * 128, epi, lds);
    } break;
  }
}

__global__ void __launch_bounds__(256, 2) mega_kernel(Params p, int ph_lo, int ph_hi) {
  __shared__ __attribute__((aligned(16))) char lds[LDS_BYTES];
  __shared__ u32x4 xb_words;
#ifndef REP_MASK
#define REP_MASK 0
#endif
  if (ph_lo < 0) cg::this_grid().sync();
  if (threadIdx.x == 0) xb_words = (u32x4){0u, 0u, 0u, 0u};
  __syncthreads();
  XcdBarrier xb; xb.bar = p.bar; xb.x = 0; xb.st = (volatile LAS unsigned*)&xb_words;
  if (ph_hi - ph_lo > 1) xb = xcd_barrier_post(p.bar, (volatile LAS unsigned*)&xb_words);
  for (int ph = ph_lo; ph < ph_hi; ++ph) {
    if (ph >= 1 && ph <= 36 && (ph - 1) % 9 == 4) continue;
    const int reps = (REP_MASK && ph >= 1 && ph <= 36 && ((REP_MASK >> ((ph - 1) % 9)) & 1)) ? 2 : 1;
    for (int r = 0; r < reps; ++r) {
      run_phase(p, ph, blockIdx.x, gridDim.x, lds);
      if (r + 1 < reps || ph + 1 < ph_hi) xcd_barrier(xb);
#ifdef EXTRA_SYNC
      for (int e = 0; e < EXTRA_SYNC; ++e) xcd_barrier(xb);
#endif
    }
  }
}

extern "C" void kernel_launch(void* const* d_in, const int* in_sizes, int n_in, void* d_out, int out_size, void* d_ws, size_t ws_size,
                              hipStream_t stream) {
  Params p{};
  const float** f = (const float**)&p;
  for (int i = 0; i < 21; ++i) f[i] = (const float*)d_in[i];
  p.out = (float*)d_out;
  char* w = (char*)d_ws; size_t off = 0;
  auto take = [&](size_t bytes) { char* r = w + off; off += (bytes + 255) & ~(size_t)255; return r; };
  p.Y = (float*)take((size_t)512 * 1024 * 4);
  p.ACT = (bf16_t*)take((size_t)NROWS * 1024 * 2);
  p.P = (bf16_t*)take((size_t)NROWS * PW * 2);
  p.Qm = (bf16_t*)take((size_t)NROWS * 384 * 2);
  p.Km = (bf16_t*)take((size_t)8 * 16640 * 96 * 2);
  p.Vm = (bf16_t*)take((size_t)8 * 16640 * 64 * 2);
  p.Ksum = (float*)take((size_t)2 * 260 * 4 * 4096 * 4);
  p.St = (bf16_t*)take((size_t)2 * 260 * 4 * 4096 * 2);
  p.W = (bf16_t*)take((size_t)4 * W_LAYER * 2);
  p.mod = (float*)take((size_t)4 * 3 * 6144 * 4);
  p.rope64 = (float*)take(256 * 16 * 2 * 4);
  p.rope32 = (float*)take(256 * 8 * 2 * 4);
  p.bar = (unsigned*)take(XCD_BAR_WORDS * 4);
  if (off > ws_size) { fprintf(stderr, "workspace too small: need %zu have %zu\n", off, ws_size); return; }
#if MULTI_LAUNCH
  for (int ph = 0; ph < 38; ++ph) hipLaunchKernelGGL(mega_kernel, dim3(512), dim3(256), 0, stream, p, ph, ph + 1);
#else
  static int grid_blocks = 0;
  if (!grid_blocks) {
    int dev = 0, cus = 0, per_cu = 0;
    hipGetDevice(&dev);
    hipDeviceGetAttribute(&cus, hipDeviceAttributeMultiprocessorCount, dev);
    hipOccupancyMaxActiveBlocksPerMultiprocessor(&per_cu, mega_kernel, 256, 0);
    if (per_cu > 2) per_cu = 2;
    grid_blocks = cus * per_cu;
  }
  hipMemsetAsync(p.bar, 0, XCD_BAR_WORDS * 4, stream);
  int lo = 0, hi = 38;
  void* args[] = {&p, &lo, &hi};
  hipError_t e = hipLaunchCooperativeKernel((void*)mega_kernel, dim3(grid_blocks), dim3(256), args, 0, stream);
  if (e != hipSuccess) fprintf(stderr, "cooperative launch failed: %s (grid %d)\n", hipGetErrorString(e), grid_blocks);
#endif
}
```

```cpp
#include <hip/hip_runtime.h>
#include <hip/hip_cooperative_groups.h>
#include <cstdio>
#include <cstdint>
namespace cg = cooperative_groups;

#ifndef MULTI_LAUNCH
#define MULTI_LAUNCH 0
#endif

typedef unsigned short bf16_t;
typedef short bf16x8 __attribute__((ext_vector_type(8)));
typedef short s16x4 __attribute__((ext_vector_type(4)));
typedef float f32x4 __attribute__((ext_vector_type(4)));
typedef float f32x2 __attribute__((ext_vector_type(2)));
typedef __bf16 bf2_t __attribute__((ext_vector_type(2)));
typedef unsigned u32x4 __attribute__((ext_vector_type(4)));
typedef unsigned u32x2 __attribute__((ext_vector_type(2)));
#define MK4(a,b,c,d) ((u32x4){(a),(b),(c),(d)})
#define MK2(a,b) ((u32x2){(a),(b)})

#define NROWS 33280
#define NLAT 32768
#define PW 3072
#define LOG2E 1.4426950408889634f
#define LDS_BYTES 73728

#define C_CQ 0
#define C_CKV 256
#define C_KR 384
#define C_RQ 416
#define C_RK 672
#define C_RV 928
#define C_RGF 1184
#define C_RGB 1440
#define C_NQ 1696
#define C_NK 1952
#define C_NV 2208
#define C_SQ 2464
#define C_SK 2720
#define C_SV 2848

#define WO_IN 0
#define WO_UQ 3145728
#define WO_UKV 3244032
#define WO_OUT 3309568
#define WO_13 4358144
#define WO_2 10125312
#define W_LAYER 13008896

struct Params {
  const float *x, *c, *ctx, *c_ctx, *ada_w, *ada_b, *norm1_g, *w_in, *mla_q_norm, *mla_w_uq, *mla_kv_norm, *mla_w_ukv,
      *ret_decay, *na_rpb, *swa_sink, *w_out, *norm2_g, *ffn_w1, *ffn_w3, *ffn_w2, *final_g;
  float* out;
  float* Y;
  bf16_t* ACT;
  bf16_t* P;
  bf16_t *Qm, *Km, *Vm;
  float* Ksum;
  bf16_t* St;
  bf16_t* W;
  float* mod;
  float* rope64;
  float* rope32;
  unsigned* bar;
};

__device__ __forceinline__ int otid() { int t = threadIdx.x; asm volatile("" : "+v"(t)); return t; }
typedef __amdgpu_buffer_rsrc_t rsrc_t;
__device__ __forceinline__ rsrc_t mkbuf(const void* base) { return __builtin_amdgcn_make_buffer_rsrc((void*)base, 0, 0x7fffffff, 0x00020000); }
__device__ __forceinline__ u32x4 bload16(rsrc_t r, unsigned voff, unsigned soff) { return __builtin_amdgcn_raw_buffer_load_b128(r, voff, soff, 0); }
__device__ __forceinline__ u32x2 bload8(rsrc_t r, unsigned voff, unsigned soff) { return __builtin_amdgcn_raw_buffer_load_b64(r, voff, soff, 0); }
__device__ __forceinline__ float bf2f(bf16_t h) { return __uint_as_float(((unsigned)h) << 16); }
__device__ __forceinline__ unsigned pack2(float a, float b) { f32x2 v = {a, b}; bf2_t r = __builtin_convertvector(v, bf2_t); return __builtin_bit_cast(unsigned, r); }
__device__ __forceinline__ bf16_t f2bf(float a) { return (bf16_t)(pack2(a, 0.f) & 0xffffu); }
__device__ __forceinline__ float lo_f(unsigned u) { return __uint_as_float(u << 16); }
__device__ __forceinline__ float hi_f(unsigned u) { return __uint_as_float(u & 0xffff0000u); }
__device__ __forceinline__ f32x4 mfma16(bf16x8 a, bf16x8 b, f32x4 c) { return __builtin_amdgcn_mfma_f32_16x16x32_bf16(a, b, c, 0, 0, 0); }
typedef __attribute__((address_space(3))) s16x4 lds_s16x4;
__device__ __forceinline__ s16x4 tr_read(const bf16_t* p) { return __builtin_amdgcn_ds_read_tr16_b64_v4i16((lds_s16x4*)p); }
__device__ __forceinline__ bf16x8 cat8(s16x4 a, s16x4 b) { bf16x8 r; r[0]=a[0]; r[1]=a[1]; r[2]=a[2]; r[3]=a[3]; r[4]=b[0]; r[5]=b[1]; r[6]=b[2]; r[7]=b[3]; return r; }
__device__ __forceinline__ float wave_sum(float v) {
  v += __shfl_xor(v, 32); v += __shfl_xor(v, 16); v += __shfl_xor(v, 8); v += __shfl_xor(v, 4); v += __shfl_xor(v, 2); v += __shfl_xor(v, 1); return v;
}
__device__ __forceinline__ float silu_f(float a) { return a * __builtin_amdgcn_rcpf(1.f + __expf(-a)); }

__device__ __forceinline__ float* xrow(const Params& p, int row) { return row < NLAT ? p.out + (size_t)row * 1024 : p.Y + (size_t)(row - NLAT) * 1024; }
__device__ __forceinline__ const float* xsrc(const Params& p, int l, int row) {
  if (l == 0) return row < NLAT ? p.x + (size_t)row * 1024 : p.ctx + (size_t)(row - NLAT) * 1024;
  return xrow(p, row);
}
__device__ __forceinline__ int modv(int row) { return row < 16384 ? 0 : (row < NLAT ? 1 : 2); }

__device__ void transpose_tile(const float* __restrict__ src, int N, int k0, int n0, bf16_t* __restrict__ dst, int ldd, int mode,
                               const float* __restrict__ kscale, char* lds) {
  bf16_t(*t)[66] = (bf16_t(*)[66])lds;
  const int tid = otid();
  __syncthreads();
#pragma unroll 4
  for (int i = 0; i < 16; ++i) {
    int kk = i * 4 + (tid >> 6), nn = tid & 63;
    float v = (n0 + nn < N) ? src[(size_t)(k0 + kk) * N + n0 + nn] : 0.f;
    if (kscale) v *= kscale[k0 + kk];
    t[kk][nn] = f2bf(v);
  }
  __syncthreads();
  int nn = tid >> 2, kq = tid & 3;
  int n = n0 + nn;
  if (n < N) {
    int row = mode == 0 ? n : ((n >> 4) * 32 + (n & 15) + (mode == 2 ? 16 : 0));
    unsigned w[8];
#pragma unroll
    for (int e = 0; e < 8; ++e) w[e] = (unsigned)t[kq * 16 + 2 * e][nn] | ((unsigned)t[kq * 16 + 2 * e + 1][nn] << 16);
    u32x4* d = (u32x4*)(dst + (size_t)row * ldd + k0 + kq * 16);
    d[0] = MK4(w[0], w[1], w[2], w[3]);
    d[1] = MK4(w[4], w[5], w[6], w[7]);
  }
}

__device__ void prologue_phase(const Params& p, int bid, int nb, char* lds) {
  const int tid = otid();
  for (int it = bid; it < 4 * 3160; it += nb) {
    int l = it / 3160, r = it % 3160;
    bf16_t* W = p.W + (size_t)l * W_LAYER;
    if (r < 752) { int kt = r / 47, nt = r % 47; transpose_tile(p.w_in + (size_t)l * 1024 * 2976, 2976, kt * 64, nt * 64, W + WO_IN, 1024, 0, nullptr, lds); continue; }
    r -= 752;
    if (r < 24) { int kt = r / 6, nt = r % 6; transpose_tile(p.mla_w_uq + (size_t)l * 256 * 384, 384, kt * 64, nt * 64, W + WO_UQ, 256, 0, p.mla_q_norm + l * 256, lds); continue; }
    r -= 24;
    if (r < 16) { int kt = r / 8, nt = r % 8; transpose_tile(p.mla_w_ukv + (size_t)l * 128 * 512, 512, kt * 64, nt * 64, W + WO_UKV, 128, 0, p.mla_kv_norm + l * 128, lds); continue; }
    r -= 16;
    if (r < 256) { int kt = r / 16, nt = r % 16; transpose_tile(p.w_out + (size_t)l * 1024 * 1024, 1024, kt * 64, nt * 64, W + WO_OUT, 1024, 0, nullptr, lds); continue; }
    r -= 256;
    if (r < 704) { int kt = r / 44, nt = r % 44; transpose_tile(p.ffn_w1 + (size_t)l * 1024 * 2816, 2816, kt * 64, nt * 64, W + WO_13, 1024, 1, nullptr, lds); continue; }
    r -= 704;
    if (r < 704) { int kt = r / 44, nt = r % 44; transpose_tile(p.ffn_w3 + (size_t)l * 1024 * 2816, 2816, kt * 64, nt * 64, W + WO_13, 1024, 2, nullptr, lds); continue; }
    r -= 704;
    { int kt = r / 16, nt = r % 16; transpose_tile(p.ffn_w2 + (size_t)l * 2816 * 1024, 1024, kt * 64, nt * 64, W + WO_2, 2816, 0, nullptr, lds); }
  }
  for (int it = bid; it < 4 * 48; it += nb) {
    int l = it / 48, part = it % 48;
    u32x4* d = (u32x4*)(p.W + (size_t)l * W_LAYER + WO_IN + (size_t)2976 * 1024);
    d[part * 256 + tid] = MK4(0, 0, 0, 0);
  }
  for (int it = bid; it < 4 * 96; it += nb) {
    int l = it / 96, cb = it % 96;
    float* s = (float*)lds;
    float* red = s + 3 * 1024;
    __syncthreads();
    for (int i = tid; i < 3072; i += 256) {
      int v = i >> 10, k = i & 1023;
      float cv = v < 2 ? p.c[v * 1024 + k] : p.c_ctx[k];
      s[i] = silu_f(cv);
    }
    __syncthreads();
    int col = cb * 64 + (tid & 63), kp = tid >> 6;
    const float* w = p.ada_w + (size_t)l * 1024 * 6144 + (size_t)(kp * 256) * 6144 + col;
    float a0 = 0.f, a1 = 0.f, a2 = 0.f;
#pragma unroll 8
    for (int k = 0; k < 256; ++k) {
      float wv = w[(size_t)k * 6144];
      a0 += s[kp * 256 + k] * wv; a1 += s[1024 + kp * 256 + k] * wv; a2 += s[2048 + kp * 256 + k] * wv;
    }
    red[(kp * 3 + 0) * 64 + (tid & 63)] = a0; red[(kp * 3 + 1) * 64 + (tid & 63)] = a1; red[(kp * 3 + 2) * 64 + (tid & 63)] = a2;
    __syncthreads();
    if (tid < 192) {
      int v = tid >> 6, cc = tid & 63;
      float sum = red[(0 * 3 + v) * 64 + cc] + red[(1 * 3 + v) * 64 + cc] + red[(2 * 3 + v) * 64 + cc] + red[(3 * 3 + v) * 64 + cc];
      p.mod[(size_t)(l * 3 + v) * 6144 + cb * 64 + cc] = sum + p.ada_b[l * 6144 + cb * 64 + cc];
    }
  }
  if (bid == (nb > 1 ? 1 : 0)) {
    int pos = tid;
    for (int i = 0; i < 16; ++i) {
      float inv = exp2f(-(float)(2 * i) / 32.f * 13.287712379549449f);
      float ang = (float)pos * inv;
      float n = rintf(ang * 0.15915494309189535f);
      float r = fmaf(-n, 6.28318548202514648f, ang); r = fmaf(-n, -1.74845553146951715e-07f, r);
      p.rope64[(pos * 16 + i) * 2] = cosf(r); p.rope64[(pos * 16 + i) * 2 + 1] = sinf(r);
    }
    for (int i = 0; i < 8; ++i) {
      float inv = exp2f(-(float)(2 * i) / 16.f * 13.287712379549449f);
      float ang = (float)pos * inv;
      float n = rintf(ang * 0.15915494309189535f);
      float r = fmaf(-n, 6.28318548202514648f, ang); r = fmaf(-n, -1.74845553146951715e-07f, r);
      p.rope32[(pos * 8 + i) * 2] = cosf(r); p.rope32[(pos * 8 + i) * 2 + 1] = sinf(r);
    }
  }
}

__device__ void norm_phase(const Params& p, int l, int which, int bid, int nb) {
  const int wave = otid() >> 6, lane = otid() & 63;
  const float* g = (which == 0 ? p.norm1_g : p.norm2_g) + l * 1024;
  for (int row = bid * 4 + wave; row < NROWS; row += nb * 4) {
    const float* src = which == 0 ? xsrc(p, l, row) : xrow(p, row);
    const float* md = p.mod + (size_t)(l * 3 + modv(row)) * 6144 + which * 3072;
    f32x4 v[4], g4[4], sh[4], sc[4]; float ss = 0.f;
#pragma unroll
    for (int i = 0; i < 4; ++i) {
      int col = i * 256 + lane * 4;
      v[i] = *(const f32x4*)(src + col); g4[i] = *(const f32x4*)(g + col); sh[i] = *(const f32x4*)(md + col); sc[i] = *(const f32x4*)(md + 1024 + col);
    }
#pragma unroll
    for (int i = 0; i < 4; ++i) ss += v[i][0] * v[i][0] + v[i][1] * v[i][1] + v[i][2] * v[i][2] + v[i][3] * v[i][3];
    ss = wave_sum(ss);
    float rinv = rsqrtf(ss * (1.f / 1024.f) + 1e-6f);
#pragma unroll
    for (int i = 0; i < 4; ++i) {
      int col = i * 256 + lane * 4;
      f32x4 y;
#pragma unroll
      for (int j = 0; j < 4; ++j) y[j] = (v[i][j] * rinv * g4[i][j]) * (1.f + sc[i][j]) + sh[i][j];
      *(u32x2*)(p.ACT + (size_t)row * 1024 + col) = MK2(pack2(y[0], y[1]), pack2(y[2], y[3]));
    }
  }
}

__device__ void final_norm_phase(const Params& p, int bid, int nb) {
  const int wave = otid() >> 6, lane = otid() & 63;
  for (int row = bid * 4 + wave; row < NLAT; row += nb * 4) {
    float* src = p.out + (size_t)row * 1024;
    f32x4 v[4]; float ss = 0.f;
#pragma unroll
    for (int i = 0; i < 4; ++i) { v[i] = *(const f32x4*)(src + i * 256 + lane * 4); ss += v[i][0] * v[i][0] + v[i][1] * v[i][1] + v[i][2] * v[i][2] + v[i][3] * v[i][3]; }
    ss = wave_sum(ss);
    float rinv = rsqrtf(ss * (1.f / 1024.f) + 1e-6f);
#pragma unroll
    for (int i = 0; i < 4; ++i) {
      int col = i * 256 + lane * 4;
      f32x4 g4 = *(const f32x4*)(p.final_g + col);
      f32x4 y;
#pragma unroll
      for (int j = 0; j < 4; ++j) y[j] = v[i][j] * rinv * g4[j];
      *(f32x4*)(src + col) = y;
    }
  }
}

#define GSTR 64
template <class Epi>
__device__ __forceinline__ void gemm_tile(const bf16_t* __restrict__ A, int lda, const bf16_t* __restrict__ Bt, int ldb, int K, int m0, int n0,
                                          const Epi& epi, char* lds) {
  bf16_t* As = (bf16_t*)lds;
  bf16_t* Bs = As + 2 * 128 * GSTR;
  const int tid = otid(), wave = tid >> 6, lane = tid & 63, wm = wave >> 1, wn = wave & 1, lr = lane & 15, quad = lane >> 4;
  const int lrow = tid >> 3, lch = tid & 7, wch = lch ^ (lrow & 7);
  rsrc_t gar = mkbuf(A + (size_t)m0 * lda), gbr = mkbuf(Bt + (size_t)n0 * ldb);
  unsigned aoff[4], boff[4];
#pragma unroll
  for (int i = 0; i < 4; ++i) { aoff[i] = (unsigned)((lrow + 32 * i) * lda + lch * 8) * 2u; boff[i] = (unsigned)((lrow + 32 * i) * ldb + lch * 8) * 2u; }
  u32x4 ra0[4], rb0[4], ra1[4], rb1[4];
  f32x4 acc[4][4];
#pragma unroll
  for (int i = 0; i < 4; ++i)
#pragma unroll
    for (int j = 0; j < 4; ++j) acc[i][j] = (f32x4){0.f, 0.f, 0.f, 0.f};
  const int nk = K >> 6;
#pragma unroll
  for (int i = 0; i < 4; ++i) { ra0[i] = bload16(gar, aoff[i], 0); rb0[i] = bload16(gbr, boff[i], 0); }
#pragma unroll
  for (int i = 0; i < 4; ++i) { ra1[i] = bload16(gar, aoff[i], 128u); rb1[i] = bload16(gbr, boff[i], 128u); }
  __syncthreads();
#pragma unroll
  for (int i = 0; i < 4; ++i) { *(u32x4*)(As + (lrow + 32 * i) * GSTR + wch * 8) = ra0[i]; *(u32x4*)(Bs + (lrow + 32 * i) * GSTR + wch * 8) = rb0[i]; }
  __syncthreads();
  const int rsw = (quad ^ (lr & 7)) * 8;
  const bf16_t* as0 = As + (wm * 64 + lr) * GSTR;
  const bf16_t* bs0 = Bs + (wn * 64 + lr) * GSTR;
#define GEMM_COMPUTE(BUF)                                                                                         \
  {                                                                                                               \
    const bf16_t* as = as0 + (BUF) * 128 * GSTR;                                                                  \
    const bf16_t* bs = bs0 + (BUF) * 128 * GSTR;                                                                  \
    _Pragma("unroll") for (int ks = 0; ks < 2; ++ks) {                                                            \
      bf16x8 af[4], bfr[4];                                                                                       \
      _Pragma("unroll") for (int i = 0; i < 4; ++i) {                                                             \
        af[i] = *(const bf16x8*)(as + i * 16 * GSTR + (rsw ^ (ks * 32)));                                         \
        bfr[i] = *(const bf16x8*)(bs + i * 16 * GSTR + (rsw ^ (ks * 32)));                                        \
      }                                                                                                           \
      _Pragma("unroll") for (int mi = 0; mi < 4; ++mi)                                                            \
        _Pragma("unroll") for (int ni = 0; ni < 4; ++ni) acc[mi][ni] = mfma16(bfr[ni], af[mi], acc[mi][ni]);      \
    }                                                                                                             \
  }
  for (int kt = 0; kt < nk; kt += 2) {
    if (kt + 2 < nk) {
      const unsigned so = (unsigned)(kt + 2) * 128u;
#pragma unroll
      for (int i = 0; i < 4; ++i) { ra0[i] = bload16(gar, aoff[i], so); rb0[i] = bload16(gbr, boff[i], so); }
    }
    GEMM_COMPUTE(0)
#pragma unroll
    for (int i = 0; i < 4; ++i) { *(u32x4*)(As + 128 * GSTR + (lrow + 32 * i) * GSTR + wch * 8) = ra1[i]; *(u32x4*)(Bs + 128 * GSTR + (lrow + 32 * i) * GSTR + wch * 8) = rb1[i]; }
    __syncthreads();
    if (kt + 3 < nk) {
      const unsigned so = (unsigned)(kt + 3) * 128u;
#pragma unroll
      for (int i = 0; i < 4; ++i) { ra1[i] = bload16(gar, aoff[i], so); rb1[i] = bload16(gbr, boff[i], so); }
    }
    GEMM_COMPUTE(1)
    if (kt + 2 < nk) {
#pragma unroll
      for (int i = 0; i < 4; ++i) { *(u32x4*)(As + (lrow + 32 * i) * GSTR + wch * 8) = ra0[i]; *(u32x4*)(Bs + (lrow + 32 * i) * GSTR + wch * 8) = rb0[i]; }
    }
    __syncthreads();
  }
#undef GEMM_COMPUTE
  epi(acc, m0 + wm * 64, n0 + wn * 64, lr, quad);
}

#define BSTG (256 * 32 + 128 * 32)
template <class Epi>
__device__ __forceinline__ void gemm_big_tile(const bf16_t* __restrict__ A, int lda, const bf16_t* __restrict__ Bt, int ldb, int K, int m0, int n0,
                                              const Epi& epi, char* lds) {
  bf16_t* L = (bf16_t*)lds;
  const int tid = otid(), wave = tid >> 6, lane = tid & 63, wm = wave >> 1, wn = wave & 1, lr = lane & 15, quad = lane >> 4;
  const int lrow = tid >> 2, lch = tid & 3;
  const int gsw = (0x1320 >> (((tid >> 4) & 3) * 4)) & 3;
  const int wpos = (lrow * 32 + ((lch ^ gsw) * 8));
  rsrc_t gar = mkbuf(A + (size_t)m0 * lda), gbr = mkbuf(Bt + (size_t)n0 * ldb);
  unsigned aoff[4], boff[2];
#pragma unroll
  for (int i = 0; i < 4; ++i) aoff[i] = (unsigned)((lrow + 64 * i) * lda + lch * 8) * 2u;
#pragma unroll
  for (int i = 0; i < 2; ++i) boff[i] = (unsigned)((lrow + 64 * i) * ldb + lch * 8) * 2u;
  u32x4 ra0[4], rb0[2], ra1[4], rb1[2];
  f32x4 acc[8][4];
#pragma unroll
  for (int i = 0; i < 8; ++i)
#pragma unroll
    for (int j = 0; j < 4; ++j) acc[i][j] = (f32x4){0.f, 0.f, 0.f, 0.f};
  const int nk = K >> 5;
#pragma unroll
  for (int i = 0; i < 4; ++i) ra0[i] = bload16(gar, aoff[i], 0);
#pragma unroll
  for (int i = 0; i < 2; ++i) rb0[i] = bload16(gbr, boff[i], 0);
#pragma unroll
  for (int i = 0; i < 4; ++i) ra1[i] = bload16(gar, aoff[i], 64u);
#pragma unroll
  for (int i = 0; i < 2; ++i) rb1[i] = bload16(gbr, boff[i], 64u);
  __syncthreads();
#pragma unroll
  for (int i = 0; i < 4; ++i) *(u32x4*)(L + wpos + i * 64 * 32) = ra0[i];
#pragma unroll
  for (int i = 0; i < 2; ++i) *(u32x4*)(L + 256 * 32 + wpos + i * 64 * 32) = rb0[i];
  __syncthreads();
  const int rsw = (quad ^ ((0x1320 >> (((lr >> 2) & 3) * 4)) & 3)) * 8;
  const bf16_t* as0 = L + (wm * 128 + lr) * 32 + rsw;
  const bf16_t* bs0 = L + 256 * 32 + (wn * 64 + lr) * 32 + rsw;
#define BIG_FRAGS(ST)                                                                                             \
    bf16x8 af[8], bfr[4];                                                                                         \
    _Pragma("unroll") for (int i = 0; i < 4; ++i) bfr[i] = *(const bf16x8*)(bs0 + (ST) * BSTG + i * 16 * 32);    \
    _Pragma("unroll") for (int i = 0; i < 8; ++i) af[i] = *(const bf16x8*)(as0 + (ST) * BSTG + i * 16 * 32);
#define BIG_MMA(LO, HI)                                                                                           \
    _Pragma("unroll") for (int mi = LO; mi < HI; ++mi)                                                            \
      _Pragma("unroll") for (int ni = 0; ni < 4; ++ni) acc[mi][ni] = mfma16(bfr[ni], af[mi], acc[mi][ni]);
  for (int kt = 0; kt < nk; kt += 2) {
    if (kt + 2 < nk) {
      const unsigned so = (unsigned)(kt + 2) * 64u;
#pragma unroll
      for (int i = 0; i < 4; ++i) ra0[i] = bload16(gar, aoff[i], so);
#pragma unroll
      for (int i = 0; i < 2; ++i) rb0[i] = bload16(gbr, boff[i], so);
    }
    {
      BIG_FRAGS(0)
      BIG_MMA(0, 4)
#pragma unroll
      for (int i = 0; i < 4; ++i) *(u32x4*)(L + BSTG + wpos + i * 64 * 32) = ra1[i];
#pragma unroll
      for (int i = 0; i < 2; ++i) *(u32x4*)(L + BSTG + 256 * 32 + wpos + i * 64 * 32) = rb1[i];
      BIG_MMA(4, 8)
    }
    __syncthreads();
    if (kt + 3 < nk) {
      const unsigned so = (unsigned)(kt + 3) * 64u;
#pragma unroll
      for (int i = 0; i < 4; ++i) ra1[i] = bload16(gar, aoff[i], so);
#pragma unroll
      for (int i = 0; i < 2; ++i) rb1[i] = bload16(gbr, boff[i], so);
    }
    {
      BIG_FRAGS(1)
      BIG_MMA(0, 4)
      if (kt + 2 < nk) {
#pragma unroll
        for (int i = 0; i < 4; ++i) *(u32x4*)(L + wpos + i * 64 * 32) = ra0[i];
#pragma unroll
        for (int i = 0; i < 2; ++i) *(u32x4*)(L + 256 * 32 + wpos + i * 64 * 32) = rb0[i];
      }
      BIG_MMA(4, 8)
    }
    __syncthreads();
  }
#undef BIG_FRAGS
#undef BIG_MMA
  epi(acc, m0 + wm * 128, n0 + wn * 64, lr, quad);
}
__device__ __forceinline__ void big_coord(int t, int nN, int& pm, int& pn) { int gsz = 4 * nN; int g = t / gsz, r = t % gsz; pm = g * 4 + (r & 3); pn = r >> 2; }

__device__ __forceinline__ void tile_coord(int t, int nN, int& pm, int& pn) {
  const int nM = 260, GM = 8;
  int gsz = GM * nN; int g = t / gsz, r = t % gsz; int fm = g * GM; int gm = min(GM, nM - fm);
  pm = fm + (r % gm); pn = r / gm;
}
__device__ __forceinline__ int xcd_tile(int round, int bid, int nb) { return round * nb + (bid & 7) * (nb >> 3) + (bid >> 3); }

struct EpiWin {
  bf16_t* P; const float* rope64;
  template <int NMI>
  __device__ __forceinline__ void operator()(f32x4 (&acc)[NMI][4], int mb, int nbs, int lr, int quad) const {
#pragma unroll
    for (int mi = 0; mi < NMI; ++mi) {
      const int row = mb + mi * 16 + lr;
      if (row < NLAT) {
        const int tok = row & 16383, prow = tok >> 6, pcol = tok & 63;
#pragma unroll
        for (int pp = 0; pp < 2; ++pp) {
          const int col0 = nbs + pp * 32;
          const bool seg = (col0 >= C_RQ && col0 < C_RV) || (col0 >= C_SQ && col0 < C_SV);
          if (seg) {
            const int pos = (col0 & 63) == 32 ? prow : pcol;
            const f32x4 cs0 = *(const f32x4*)(rope64 + (pos * 16 + quad * 4) * 2), cs1 = *(const f32x4*)(rope64 + (pos * 16 + quad * 4) * 2 + 4);
            const float cc[4] = {cs0[0], cs0[2], cs1[0], cs1[2]}, sn[4] = {cs0[1], cs0[3], cs1[1], cs1[3]};
#pragma unroll
            for (int j = 0; j < 4; ++j) {
              const float x1 = acc[mi][2 * pp][j], x2 = acc[mi][2 * pp + 1][j];
              acc[mi][2 * pp][j] = x1 * cc[j] - x2 * sn[j];
              acc[mi][2 * pp + 1][j] = x2 * cc[j] + x1 * sn[j];
            }
          }
        }
      }
      bf16_t* rp = P + (size_t)row * PW + nbs + quad * 4;
#pragma unroll
      for (int ni = 0; ni < 4; ++ni) *(u32x2*)(rp + ni * 16) = MK2(pack2(acc[mi][ni][0], acc[mi][ni][1]), pack2(acc[mi][ni][2], acc[mi][ni][3]));
    }
  }
};

struct EpiResid {
  const Params* p; int l; int goff; int use_src;
  template <int NMI>
  __device__ __forceinline__ void operator()(f32x4 (&acc)[NMI][4], int mb, int nbs, int lr, int quad) const {
#pragma unroll
    for (int mi = 0; mi < NMI; ++mi) {
      int row = mb + mi * 16 + lr;
      const float* gate = p->mod + (size_t)(l * 3 + modv(row)) * 6144 + goff;
      const float* src = use_src ? xsrc(*p, l, row) : xrow(*p, row);
      float* dst = xrow(*p, row);
#pragma unroll
      for (int ni = 0; ni < 4; ++ni) {
        int col = nbs + ni * 16 + quad * 4;
        f32x4 g4 = *(const f32x4*)(gate + col), x4 = *(const f32x4*)(src + col);
#pragma unroll
        for (int j = 0; j < 4; ++j) x4[j] += g4[j] * acc[mi][ni][j];
        *(f32x4*)(dst + col) = x4;
      }
    }
  }
};

struct EpiFfn1 {
  bf16_t* U;
  template <int NMI>
  __device__ __forceinline__ void operator()(f32x4 (&acc)[NMI][4], int mb, int nbs, int lr, int quad) const {
#pragma unroll
    for (int mi = 0; mi < NMI; ++mi) {
      int row = mb + mi * 16 + lr;
#pragma unroll
      for (int pr = 0; pr < 2; ++pr) {
        int ucol = ((nbs + pr * 32) >> 5) * 16 + quad * 4;
        float u[4];
#pragma unroll
        for (int j = 0; j < 4; ++j) u[j] = silu_f(acc[mi][2 * pr][j]) * acc[mi][2 * pr + 1][j];
        *(u32x2*)(U + (size_t)row * 2816 + ucol) = MK2(pack2(u[0], u[1]), pack2(u[2], u[3]));
      }
    }
  }
};

struct EpiUq {
  const Params* p;
  __device__ __forceinline__ void operator()(f32x4 (&acc)[4][4], int mb, int nbs, int lr, int quad) const {
#pragma unroll
    for (int mi = 0; mi < 4; ++mi) {
      int row = mb + mi * 16 + lr;
      const bf16_t* cq = p->P + (size_t)row * PW + C_CQ + quad * 64;
      float ss = 0.f;
#pragma unroll
      for (int i = 0; i < 8; ++i) {
        u32x4 w = *(const u32x4*)(cq + i * 8);
        float a;
        a = lo_f(w.x); ss += a * a; a = hi_f(w.x); ss += a * a; a = lo_f(w.y); ss += a * a; a = hi_f(w.y); ss += a * a;
        a = lo_f(w.z); ss += a * a; a = hi_f(w.z); ss += a * a; a = lo_f(w.w); ss += a * a; a = hi_f(w.w); ss += a * a;
      }
      ss += __shfl_xor(ss, 16); ss += __shfl_xor(ss, 32);
      float rinv = rsqrtf(ss * (1.f / 256.f) + 1e-6f);
      bool latent = row < NLAT;
      int tok = row & 16383, prow = tok >> 6, pcol = tok & 63;
#pragma unroll
      for (int ni = 0; ni < 4; ++ni) {
        int col = nbs + ni * 16 + quad * 4;
        int sub = ((nbs >> 4) + ni) % 6;
        float v[4];
#pragma unroll
        for (int j = 0; j < 4; ++j) v[j] = acc[mi][ni][j] * rinv;
        if (sub >= 4) {
          float o[4];
#pragma unroll
          for (int j = 0; j < 4; ++j) o[j] = __shfl_xor(v[j], 32);
          if (latent) {
            int pos = sub == 4 ? prow : pcol;
#pragma unroll
            for (int j = 0; j < 4; ++j) {
              int i = (quad & 1) * 4 + j;
              float cs = p->rope32[(pos * 8 + i) * 2], sn = p->rope32[(pos * 8 + i) * 2 + 1];
              v[j] = quad < 2 ? v[j] * cs - o[j] * sn : v[j] * cs + o[j] * sn;
            }
          }
        }
        *(u32x2*)(p->Qm + (size_t)row * 384 + col) = MK2(pack2(v[0], v[1]), pack2(v[2], v[3]));
      }
    }
  }
};

__device__ __forceinline__ void mla_key_of_row(int row, int& b, int& key) {
  if (row < NLAT) { b = row >> 14; key = row & 16383; } else { b = (row - NLAT) >> 8; key = 16384 + ((row - NLAT) & 255); }
}

struct EpiUkv {
  const Params* p;
  __device__ __forceinline__ void operator()(f32x4 (&acc)[4][4], int mb, int nbs, int lr, int quad) const {
    int h = nbs >> 7, isv = (nbs >> 6) & 1;
#pragma unroll
    for (int mi = 0; mi < 4; ++mi) {
      int row = mb + mi * 16 + lr;
      const bf16_t* ck = p->P + (size_t)row * PW + C_CKV + quad * 32;
      float ss = 0.f;
#pragma unroll
      for (int i = 0; i < 4; ++i) {
        u32x4 w = *(const u32x4*)(ck + i * 8);
        float a;
        a = lo_f(w.x); ss += a * a; a = hi_f(w.x); ss += a * a; a = lo_f(w.y); ss += a * a; a = hi_f(w.y); ss += a * a;
        a = lo_f(w.z); ss += a * a; a = hi_f(w.z); ss += a * a; a = lo_f(w.w); ss += a * a; a = hi_f(w.w); ss += a * a;
      }
      ss += __shfl_xor(ss, 16); ss += __shfl_xor(ss, 32);
      float rinv = rsqrtf(ss * (1.f / 128.f) + 1e-6f);
      int b, key; mla_key_of_row(row, b, key);
      size_t kidx = (size_t)(b * 4 + h) * 16640 + key;
      bf16_t* dst = isv ? p->Vm + kidx * 64 : p->Km + kidx * 96;
#pragma unroll
      for (int ni = 0; ni < 4; ++ni) {
        f32x4 a = acc[mi][ni];
        *(u32x2*)(dst + ni * 16 + quad * 4) = MK2(pack2(a[0] * rinv, a[1] * rinv), pack2(a[2] * rinv, a[3] * rinv));
      }
    }
  }
};

__device__ __forceinline__ void rope64_pair_vals(const bf16_t* base, int pr, int prow, int pcol, const float* rope64, bool rotate, float (&o1)[8], float (&o2)[8], int& c0) {
  c0 = pr < 2 ? pr : pr + 2;
  int pos = pr < 2 ? prow : pcol, i0 = (pr & 1) * 8;
  u32x4 a = *(const u32x4*)(base + c0 * 8), b = *(const u32x4*)(base + (c0 + 2) * 8);
  unsigned aw[4] = {a.x, a.y, a.z, a.w}, bw[4] = {b.x, b.y, b.z, b.w};
#pragma unroll
  for (int e = 0; e < 8; ++e) {
    float x1 = (e & 1) ? hi_f(aw[e >> 1]) : lo_f(aw[e >> 1]);
    float x2 = (e & 1) ? hi_f(bw[e >> 1]) : lo_f(bw[e >> 1]);
    if (rotate) {
      float cs = rope64[(pos * 16 + i0 + e) * 2], sn = rope64[(pos * 16 + i0 + e) * 2 + 1];
      o1[e] = x1 * cs - x2 * sn; o2[e] = x2 * cs + x1 * sn;
    } else { o1[e] = x1; o2[e] = x2; }
  }
}
__device__ __forceinline__ u32x4 pack8(const float (&o)[8]) { return MK4(pack2(o[0], o[1]), pack2(o[2], o[3]), pack2(o[4], o[5]), pack2(o[6], o[7])); }

#define VSTR 80
__device__ void ret_prep_item(const Params& p, int l, int c, int h, char* lds) {
  bf16_t* vL = (bf16_t*)lds;
  bf16_t* kfL = vL + 128 * VSTR;
  bf16_t* kbL = kfL + 128 * VSTR;
  const int tid = otid(), wave = tid >> 6, lane = tid & 63, lr = lane & 15, quad = lane >> 4;
  const bool latent = c < 256;
  const int r0 = c * 128;
  float df = p.ret_decay[l * 8 + h], db = p.ret_decay[l * 8 + 4 + h];
  float lgf = -log1pf(__expf(-df)) * LOG2E, lgb = -log1pf(__expf(-db)) * LOG2E;
  __syncthreads();
#pragma unroll
  for (int i = 0; i < 2; ++i) {
    int idx = tid + 256 * i, r = idx >> 2, pr = idx & 3;
    int row = r0 + r, tok = row & 16383, prow = tok >> 6, pcol = tok & 63;
    bf16_t* kb = p.P + (size_t)row * PW + C_RK + h * 64;
    float o1[8], o2[8]; int c0;
    rope64_pair_vals(kb, pr, prow, pcol, p.rope64, false, o1, o2, c0);
    float wf = exp2f(lgf * (float)(127 - r)) * 0.125f, wb = exp2f(lgb * (float)r) * 0.125f;
    float t1[8], t2[8];
#pragma unroll
    for (int e = 0; e < 8; ++e) { t1[e] = o1[e] * wf; t2[e] = o2[e] * wf; }
    *(u32x4*)(kfL + r * VSTR + c0 * 8) = pack8(t1); *(u32x4*)(kfL + r * VSTR + (c0 + 2) * 8) = pack8(t2);
#pragma unroll
    for (int e = 0; e < 8; ++e) { t1[e] = o1[e] * wb; t2[e] = o2[e] * wb; }
    *(u32x4*)(kbL + r * VSTR + c0 * 8) = pack8(t1); *(u32x4*)(kbL + r * VSTR + (c0 + 2) * 8) = pack8(t2);
  }
#pragma unroll
  for (int i = 0; i < 4; ++i) {
    int idx = tid + 256 * i, r = idx >> 3, ch = idx & 7;
    *(u32x4*)(vL + r * VSTR + ch * 8) = *(const u32x4*)(p.P + (size_t)(r0 + r) * PW + C_RV + h * 64 + ch * 8);
  }
  __syncthreads();
  f32x4 acc[2][4];
#pragma unroll
  for (int d = 0; d < 2; ++d)
#pragma unroll
    for (int j = 0; j < 4; ++j) acc[d][j] = (f32x4){0.f, 0.f, 0.f, 0.f};
  const int roff = (quad * 4 + (lr >> 2)) * VSTR + (lr & 3) * 4;
#pragma unroll
  for (int ks = 0; ks < 4; ++ks) {
    bf16x8 af = cat8(tr_read(vL + ks * 32 * VSTR + roff + wave * 16), tr_read(vL + (ks * 32 + 16) * VSTR + roff + wave * 16));
#pragma unroll
    for (int dt = 0; dt < 4; ++dt) {
      bf16x8 b0 = cat8(tr_read(kfL + ks * 32 * VSTR + roff + dt * 16), tr_read(kfL + (ks * 32 + 16) * VSTR + roff + dt * 16));
      acc[0][dt] = mfma16(af, b0, acc[0][dt]);
      bf16x8 b1 = cat8(tr_read(kbL + ks * 32 * VSTR + roff + dt * 16), tr_read(kbL + (ks * 32 + 16) * VSTR + roff + dt * 16));
      acc[1][dt] = mfma16(af, b1, acc[1][dt]);
    }
  }
#pragma unroll
  for (int dir = 0; dir < 2; ++dir) {
    float* ks = p.Ksum + ((size_t)(dir * 260 + c) * 4 + h) * 4096;
#pragma unroll
    for (int dt = 0; dt < 4; ++dt)
#pragma unroll
      for (int j = 0; j < 4; ++j) ks[(wave * 16 + quad * 4 + j) * 64 + dt * 16 + lr] = acc[dir][dt][j];
  }
}

__device__ void swa_rope_item(const Params& p, int mt) {
  const int tid = otid();
  for (int idx = tid; idx < 128 * 24; idx += 256) {
    int r = idx / 24, pp = idx % 24;
    int row = mt * 128 + r, tok = row & 16383, prow = tok >> 6, pcol = tok & 63;
    int hd = pp >> 2, pr = pp & 3;
    bf16_t* base = p.P + (size_t)row * PW + (hd < 4 ? C_SQ + hd * 64 : C_SK + (hd - 4) * 64);
    float o1[8], o2[8]; int c0;
    rope64_pair_vals(base, pr, prow, pcol, p.rope64, true, o1, o2, c0);
    *(u32x4*)(base + c0 * 8) = pack8(o1); *(u32x4*)(base + (c0 + 2) * 8) = pack8(o2);
  }
}

__device__ void mla_krope_item(const Params& p, int m0, int h) {
  const int tid = otid();
  int row = m0 + (tid >> 1), part = tid & 1;
  bool latent = row < NLAT;
  int tok = row & 16383, pos = part == 0 ? (tok >> 6) : (tok & 63);
  const bf16_t* src = p.P + (size_t)row * PW + C_KR + part * 16;
  u32x4 a = *(const u32x4*)src, b = *(const u32x4*)(src + 8);
  unsigned aw[4] = {a.x, a.y, a.z, a.w}, bw[4] = {b.x, b.y, b.z, b.w};
  float o1[8], o2[8];
#pragma unroll
  for (int e = 0; e < 8; ++e) {
    float x1 = (e & 1) ? hi_f(aw[e >> 1]) : lo_f(aw[e >> 1]);
    float x2 = (e & 1) ? hi_f(bw[e >> 1]) : lo_f(bw[e >> 1]);
    if (latent) {
      float cs = p.rope32[(pos * 8 + e) * 2], sn = p.rope32[(pos * 8 + e) * 2 + 1];
      o1[e] = x1 * cs - x2 * sn; o2[e] = x2 * cs + x1 * sn;
    } else { o1[e] = x1; o2[e] = x2; }
  }
  int b_, key; mla_key_of_row(row, b_, key);
  bf16_t* dst = p.Km + ((size_t)(b_ * 4 + h) * 16640 + key) * 96 + 64 + part * 16;
  *(u32x4*)dst = pack8(o1); *(u32x4*)(dst + 8) = pack8(o2);
}

struct KVT { const bf16_t* k; const bf16_t* v; };

template <int DQK, bool SOFTMAX, bool PLAIN, class TileFn, class MaskFn>
__device__ __forceinline__ void attn_core(const bf16x8 (&qf)[2][DQK / 32], int ntiles, const TileFn& tf, int ldk, int ldv, const MaskFn& mk,
                                          f32x4 (&o)[4][2], float (&m)[2], float (&l)[2], char* lds) {
  constexpr int KSTR = DQK + 16, NKS = DQK / 32, KCH = DQK / 8, NKL = (64 * KCH) / 256;
  bf16_t* Kl = (bf16_t*)lds;
  bf16_t* Vl = Kl + 2 * 64 * KSTR;
  const int tid = otid(), wave = tid >> 6, lane = tid & 63, lr = lane & 15, quad = lane >> 4;
  constexpr bool MFMA_SUM = SOFTMAX && PLAIN;
  f32x4 lacc[2] = {(f32x4){0.f, 0.f, 0.f, 0.f}, (f32x4){0.f, 0.f, 0.f, 0.f}};
  u32x4 rk[NKL], rv[2];
  unsigned koff[NKL], voff[2];
#pragma unroll
  for (int i = 0; i < NKL; ++i) { int c = tid + i * 256, r = c / KCH, ch = c % KCH; koff[i] = (unsigned)(r * ldk + ch * 8) * 2u; }
#pragma unroll
  for (int i = 0; i < 2; ++i) { int c = tid + i * 256, r = c >> 3, ch = c & 7; voff[i] = (unsigned)(r * ldv + ch * 8) * 2u; }
  __syncthreads();
  {
    KVT kv = tf(0);
    rsrc_t kr = mkbuf(kv.k), vr = mkbuf(kv.v);
#pragma unroll
    for (int i = 0; i < NKL; ++i) rk[i] = bload16(kr, koff[i], 0);
#pragma unroll
    for (int i = 0; i < 2; ++i) rv[i] = bload16(vr, voff[i], 0);
#pragma unroll
    for (int i = 0; i < NKL; ++i) { int c = tid + i * 256, r = c / KCH, ch = c % KCH; *(u32x4*)(Kl + r * KSTR + ch * 8) = rk[i]; }
#pragma unroll
    for (int i = 0; i < 2; ++i) { int c = tid + i * 256, r = c >> 3, ch = c & 7; *(u32x4*)(Vl + r * VSTR + ch * 8) = rv[i]; }
  }
  __syncthreads();
  for (int t = 0; t < ntiles; ++t) {
    const int cur = t & 1;
    if (t + 1 < ntiles) {
      KVT kv = tf(t + 1);
      rsrc_t kr = mkbuf(kv.k), vr = mkbuf(kv.v);
#pragma unroll
      for (int i = 0; i < NKL; ++i) rk[i] = bload16(kr, koff[i], 0);
#pragma unroll
      for (int i = 0; i < 2; ++i) rv[i] = bload16(vr, voff[i], 0);
    }
    f32x4 s[4][2];
#pragma unroll
    for (int kt = 0; kt < 4; ++kt) { s[kt][0] = (f32x4){0.f, 0.f, 0.f, 0.f}; s[kt][1] = (f32x4){0.f, 0.f, 0.f, 0.f}; }
    const bf16_t* kb = Kl + cur * 64 * KSTR + lr * KSTR + quad * 8;
    {
      bf16x8 kfa[NKS][4];
#pragma unroll
      for (int ks = 0; ks < NKS; ++ks)
#pragma unroll
        for (int kt = 0; kt < 4; ++kt) kfa[ks][kt] = *(const bf16x8*)(kb + kt * 16 * KSTR + ks * 32);
#pragma unroll
      for (int ks = 0; ks < NKS; ++ks)
#pragma unroll
        for (int kt = 0; kt < 4; ++kt) {
          s[kt][0] = mfma16(kfa[ks][kt], qf[0][ks], s[kt][0]);
          s[kt][1] = mfma16(kfa[ks][kt], qf[1][ks], s[kt][1]);
        }
    }
    if (!PLAIN) {
#pragma unroll
      for (int kt = 0; kt < 4; ++kt)
#pragma unroll
        for (int qt = 0; qt < 2; ++qt)
#pragma unroll
          for (int j = 0; j < 4; ++j) s[kt][qt][j] = mk(t, wave * 32 + qt * 16 + lr, kt * 16 + quad * 4 + j, s[kt][qt][j]);
    }
    if (SOFTMAX) {
      const float sl2 = PLAIN ? mk(0, 0, 0, 1.0f) : 1.0f;
      float mnew[2], alpha[2];
#pragma unroll
      for (int qt = 0; qt < 2; ++qt) {
        float mx = fmaxf(fmaxf(s[0][qt][0], s[0][qt][1]), fmaxf(s[0][qt][2], s[0][qt][3]));
#pragma unroll
        for (int kt = 1; kt < 4; ++kt) mx = fmaxf(fmaxf(mx, s[kt][qt][0]), fmaxf(fmaxf(s[kt][qt][1], s[kt][qt][2]), s[kt][qt][3]));
        mx = fmaxf(mx, __shfl_xor(mx, 16)); mx = fmaxf(mx, __shfl_xor(mx, 32));
        if (PLAIN) mx *= sl2;
        mnew[qt] = fmaxf(m[qt], mx);
        alpha[qt] = __builtin_amdgcn_exp2f(m[qt] - mnew[qt]);
        m[qt] = mnew[qt];
      }
      if (__any((alpha[0] < 1.f) | (alpha[1] < 1.f))) {
#pragma unroll
        for (int qt = 0; qt < 2; ++qt) {
          l[qt] *= alpha[qt];
          if (MFMA_SUM) { lacc[qt][0] *= alpha[qt]; lacc[qt][1] *= alpha[qt]; lacc[qt][2] *= alpha[qt]; lacc[qt][3] *= alpha[qt]; }
#pragma unroll
          for (int dt = 0; dt < 4; ++dt)
#pragma unroll
            for (int j = 0; j < 4; ++j) o[dt][qt][j] *= alpha[qt];
        }
      }
#pragma unroll
      for (int qt = 0; qt < 2; ++qt) {
        float ls = 0.f;
        const float nm = -mnew[qt];
#pragma unroll
        for (int kt = 0; kt < 4; ++kt)
#pragma unroll
          for (int j = 0; j < 4; ++j) {
            float pv = __builtin_amdgcn_exp2f(PLAIN ? fmaf(s[kt][qt][j], sl2, nm) : s[kt][qt][j] + nm);
            s[kt][qt][j] = pv; if (!MFMA_SUM) ls += pv;
          }
        if (!MFMA_SUM) l[qt] += ls;
      }
    }
    bf16x8 pf[2][2];
#pragma unroll
    for (int qt = 0; qt < 2; ++qt)
#pragma unroll
      for (int kk = 0; kk < 2; ++kk) {
        unsigned w0 = pack2(s[2 * kk][qt][0], s[2 * kk][qt][1]), w1 = pack2(s[2 * kk][qt][2], s[2 * kk][qt][3]);
        unsigned w2 = pack2(s[2 * kk + 1][qt][0], s[2 * kk + 1][qt][1]), w3 = pack2(s[2 * kk + 1][qt][2], s[2 * kk + 1][qt][3]);
        u32x4 u = MK4(w0, w1, w2, w3);
        pf[qt][kk] = __builtin_bit_cast(bf16x8, u);
      }
    const bf16_t* vb = Vl + cur * 64 * VSTR + (quad * 4 + (lr >> 2)) * VSTR + (lr & 3) * 4;
    {
      bf16x8 vfa[2][4];
#pragma unroll
      for (int kk = 0; kk < 2; ++kk)
#pragma unroll
        for (int dt = 0; dt < 4; ++dt) vfa[kk][dt] = cat8(tr_read(vb + (kk * 32) * VSTR + dt * 16), tr_read(vb + (kk * 32 + 16) * VSTR + dt * 16));
#pragma unroll
      for (int kk = 0; kk < 2; ++kk)
#pragma unroll
        for (int dt = 0; dt < 4; ++dt) {
          o[dt][0] = mfma16(vfa[kk][dt], pf[0][kk], o[dt][0]);
          o[dt][1] = mfma16(vfa[kk][dt], pf[1][kk], o[dt][1]);
        }
      if (MFMA_SUM) {
        const bf16x8 ones = {(short)0x3f80, (short)0x3f80, (short)0x3f80, (short)0x3f80, (short)0x3f80, (short)0x3f80, (short)0x3f80, (short)0x3f80};
#pragma unroll
        for (int kk = 0; kk < 2; ++kk) { lacc[0] = mfma16(ones, pf[0][kk], lacc[0]); lacc[1] = mfma16(ones, pf[1][kk], lacc[1]); }
      }
    }
    if (t + 1 < ntiles) {
      const int nx = cur ^ 1;
#pragma unroll
      for (int i = 0; i < NKL; ++i) { int c = tid + i * 256, r = c / KCH, ch = c % KCH; *(u32x4*)(Kl + nx * 64 * KSTR + r * KSTR + ch * 8) = rk[i]; }
#pragma unroll
      for (int i = 0; i < 2; ++i) { int c = tid + i * 256, r = c >> 3, ch = c & 7; *(u32x4*)(Vl + nx * 64 * VSTR + r * VSTR + ch * 8) = rv[i]; }
    }
    __syncthreads();
  }
  if (MFMA_SUM) { const int quad_ = (otid() & 63) >> 4; l[0] = quad_ == 0 ? lacc[0][0] : 0.f; l[1] = quad_ == 0 ? lacc[1][0] : 0.f; }
}

__device__ __forceinline__ void attn_store(f32x4 (&o)[4][2], float (&m)[2], float (&l)[2], bool has_sink, float sink_l2, bf16_t* dst  , int ldo) {
  const int lane = otid() & 63, wave = otid() >> 6, lr = lane & 15, quad = lane >> 4;
#pragma unroll
  for (int qt = 0; qt < 2; ++qt) {
    float lt = l[qt]; lt += __shfl_xor(lt, 16); lt += __shfl_xor(lt, 32);
    if (has_sink) lt += exp2f(sink_l2 - m[qt]);
    float inv = 1.f / lt;
    bf16_t* rp = dst + (size_t)(wave * 32 + qt * 16 + lr) * ldo + quad * 4;
#pragma unroll
    for (int dt = 0; dt < 4; ++dt)
      *(u32x2*)(rp + dt * 16) = MK2(pack2(o[dt][qt][0] * inv, o[dt][qt][1] * inv), pack2(o[dt][qt][2] * inv, o[dt][qt][3] * inv));
  }
}

template <int NKS>
__device__ __forceinline__ void load_q(bf16x8 (&qf)[2][NKS], const bf16_t* q  , int ldq) {
  const int lane = otid() & 63, wave = otid() >> 6, lr = lane & 15, quad = lane >> 4;
#pragma unroll
  for (int qt = 0; qt < 2; ++qt)
#pragma unroll
    for (int ks = 0; ks < NKS; ++ks) qf[qt][ks] = *(const bf16x8*)(q + (size_t)(wave * 32 + qt * 16 + lr) * ldq + ks * 32 + quad * 8);
}

struct TileContig { const bf16_t* k; const bf16_t* v; size_t ks, vs;
  __device__ __forceinline__ KVT operator()(int t) const { return KVT{k + (size_t)t * ks, v + (size_t)t * vs}; } };
struct MaskScale { float sl2; __device__ __forceinline__ float operator()(int, int, int, float s) const { return s * sl2; } };

__device__ void mla_item(const Params& p, int b, int h, int qt128, bool ctxq, char* lds) {
  int r0 = ctxq ? NLAT + b * 256 + qt128 * 128 : b * 16384 + qt128 * 128;
  bf16x8 qf[2][3];
  load_q<3>(qf, p.Qm + (size_t)r0 * 384 + h * 96, 384);
  f32x4 o[4][2]; float m[2] = {-1e30f, -1e30f}, l[2] = {0.f, 0.f};
#pragma unroll
  for (int dt = 0; dt < 4; ++dt) { o[dt][0] = (f32x4){0.f, 0.f, 0.f, 0.f}; o[dt][1] = (f32x4){0.f, 0.f, 0.f, 0.f}; }
  int t0 = ctxq ? 256 : 0, nt = ctxq ? 4 : 260;
  size_t kbase = (size_t)(b * 4 + h) * 16640 + (size_t)t0 * 64;
  TileContig tf{p.Km + kbase * 96, p.Vm + kbase * 64, (size_t)64 * 96, (size_t)64 * 64};
  MaskScale mk{0.10206207261596575f * LOG2E};
  attn_core<96, true, true>(qf, nt, tf, 96, 64, mk, o, m, l, lds);
  attn_store(o, m, l, false, 0.f, p.ACT + (size_t)r0 * 1024 + h * 64, 1024);
}

struct NaTiles { const bf16_t* P; int b, h, lo, nw;
  __device__ __forceinline__ KVT operator()(int t) const {
    size_t row = t < nw ? (size_t)b * 16384 + (size_t)(lo + t) * 64 : (size_t)NLAT + b * 256 + (size_t)(t - nw) * 64;
    return KVT{P + row * PW + C_NK + h * 64, P + row * PW + C_NV + h * 64}; } };
struct NaMask { const float* rpb; int nw, lo, qr0; float sl2;
  __device__ __forceinline__ float operator()(int t, int qi, int kj, float s) const {
    if (t >= nw) return s * sl2;
    int qr = qr0 + (qi >> 6), qc = qi & 63, kr = lo + t;
    int r0q = min(max(qr - 4, 0), 248), c0 = min(max(qc - 8, 0), 48);
    bool ok = (kr >= r0q) & (kr < r0q + 8) & (kj >= c0) & (kj < c0 + 16);
    int dr = min(max(kr - qr + 7, 0), 14), dc = min(max(kj - qc, -15), 15) + 15;
    float bias = rpb[dr * 31 + dc];
    return ok ? s * sl2 + bias * LOG2E : -INFINITY; } };

__device__ void na_item(const Params& p, int l, int b, int h, int pair, char* lds) {
  float* rpbL = (float*)(lds + 60000);
  __syncthreads();
  for (int i = otid(); i < 465; i += 256) rpbL[i] = p.na_rpb[(size_t)(l * 4 + h) * 465 + i];
  int r0 = b * 16384 + pair * 128;
  bf16x8 qf[2][2];
  load_q<2>(qf, p.P + (size_t)r0 * PW + C_NQ + h * 64, PW);
  f32x4 o[4][2]; float m[2] = {-1e30f, -1e30f}, ls[2] = {0.f, 0.f};
#pragma unroll
  for (int dt = 0; dt < 4; ++dt) { o[dt][0] = (f32x4){0.f, 0.f, 0.f, 0.f}; o[dt][1] = (f32x4){0.f, 0.f, 0.f, 0.f}; }
  int qr0 = pair * 2;
  int lo = min(max(qr0 - 4, 0), 248), hi = min(max(qr0 + 1 - 4, 0), 248) + 7;
  int nw = hi - lo + 1;
  NaTiles tf{p.P, b, h, lo, nw};
  NaMask mk{rpbL, nw, lo, qr0, 0.125f * LOG2E};
  attn_core<64, true, false>(qf, nw + 4, tf, PW, PW, mk, o, m, ls, lds);
  attn_store(o, m, ls, false, 0.f, p.ACT + (size_t)r0 * 1024 + 512 + h * 64, 1024);
}

struct SwaTiles { const bf16_t* P; int b, kvh, nlo, nwt;
  __device__ __forceinline__ KVT operator()(int t) const {
    size_t row = t < nwt ? (size_t)b * 16384 + (size_t)(nlo * 128 + t * 64) : (size_t)NLAT + b * 256 + (size_t)(t - nwt) * 64;
    return KVT{P + row * PW + C_SK + kvh * 64, P + row * PW + C_SV + kvh * 64}; } };
struct SwaMask { int nwt, koff  ; float sl2;
  __device__ __forceinline__ float operator()(int t, int qi, int kj, float s) const {
    if (t >= nwt) return s * sl2;
    int delta = koff + t * 64 + kj - qi;
    return (delta <= 128 && delta >= -128) ? s * sl2 : -INFINITY; } };

__device__ void swa_item(const Params& p, int l, int b, int hq, int n, bool ctxq, char* lds) {
  int r0 = ctxq ? NLAT + b * 256 + n * 128 : b * 16384 + n * 128;
  bf16x8 qf[2][2];
  load_q<2>(qf, p.P + (size_t)r0 * PW + C_SQ + hq * 64, PW);
  f32x4 o[4][2]; float m[2] = {-1e30f, -1e30f}, ls[2] = {0.f, 0.f};
#pragma unroll
  for (int dt = 0; dt < 4; ++dt) { o[dt][0] = (f32x4){0.f, 0.f, 0.f, 0.f}; o[dt][1] = (f32x4){0.f, 0.f, 0.f, 0.f}; }
  int nlo = 0, nwt = 0;
  if (!ctxq) { nlo = max(n - 1, 0); int nhi = min(n + 1, 127); nwt = (nhi - nlo + 1) * 2; }
  SwaTiles tf{p.P, b, hq >> 1, nlo, nwt};
  SwaMask mk{nwt, (nlo - n) * 128, 0.125f * LOG2E};
  attn_core<64, true, false>(qf, nwt + 4, tf, PW, PW, mk, o, m, ls, lds);
  float sink = p.swa_sink[l * 4 + hq] * LOG2E;
  attn_store(o, m, ls, true, sink, p.ACT + (size_t)r0 * 1024 + 768 + hq * 64, 1024);
}

__device__ void na_ctx_item(const Params& p, int b, int h, int n, char* lds) {
  int r0 = NLAT + b * 256 + n * 128;
  bf16x8 qf[2][2];
  load_q<2>(qf, p.P + (size_t)r0 * PW + C_NQ + h * 64, PW);
  f32x4 o[4][2]; float m[2] = {-1e30f, -1e30f}, ls[2] = {0.f, 0.f};
#pragma unroll
  for (int dt = 0; dt < 4; ++dt) { o[dt][0] = (f32x4){0.f, 0.f, 0.f, 0.f}; o[dt][1] = (f32x4){0.f, 0.f, 0.f, 0.f}; }
  NaTiles tf{p.P, b, h, 0, 0};
  MaskScale mk{0.125f * LOG2E};
  attn_core<64, true, true>(qf, 4, tf, PW, PW, mk, o, m, ls, lds);
  attn_store(o, m, ls, false, 0.f, p.ACT + (size_t)r0 * 1024 + 512 + h * 64, 1024);
}

__device__ void ret_scan_item(const Params& p, int l, int combo, int part) {
  int dir = combo >> 3, b = (combo >> 2) & 1, h = combo & 3;
  float d = p.ret_decay[l * 8 + dir * 4 + h];
  float lg = -log1pf(__expf(-d)) * LOG2E;
  float gC = exp2f(lg * 128.f);
  int idx = part * 1024 + otid() * 4;
  f32x4 S = (f32x4){0.f, 0.f, 0.f, 0.f};
  const size_t dbase = ((size_t)dir * 260 * 4 + h) * 4096 + idx;
#pragma unroll 1
  for (int s0 = 0; s0 < 130; s0 += 13) {
    f32x4 kv[13]; int ch[13];
#pragma unroll
    for (int u = 0; u < 13; ++u) {
      int step = s0 + u;
      if (dir == 0) ch[u] = step < 2 ? 256 + 2 * b + step : b * 128 + (step - 2);
      else ch[u] = step < 2 ? 256 + 2 * b + 1 - step : b * 128 + 127 - (step - 2);
      kv[u] = *(const f32x4*)(p.Ksum + dbase + (size_t)ch[u] * 16384);
    }
#pragma unroll
    for (int u = 0; u < 13; ++u) {
      *(u32x2*)(p.St + dbase + (size_t)ch[u] * 16384) = MK2(pack2(S[0], S[1]), pack2(S[2], S[3]));
#pragma unroll
      for (int j = 0; j < 4; ++j) S[j] = S[j] * gC + kv[u][j];
    }
  }
}

struct RetMask { float lg; int dir;
  __device__ __forceinline__ float operator()(int t, int qi, int kj, float s) const {
    int j = t * 64 + kj; int df = dir == 0 ? qi - j : j - qi;
    return df >= 0 ? s * 0.125f * __builtin_amdgcn_exp2f(lg * (float)df) : 0.f; } };

__device__ void ret_out_item(const Params& p, int l, int c, int h, char* lds) {
  const int lane = otid() & 63, wave = otid() >> 6, lr = lane & 15, quad = lane >> 4;
  int r0 = c * 128;
  bf16x8 qf[2][2];
  load_q<2>(qf, p.P + (size_t)r0 * PW + C_RQ + h * 64, PW);
  f32x4 res[4][2];
#pragma unroll
  for (int dt = 0; dt < 4; ++dt) { res[dt][0] = (f32x4){0.f, 0.f, 0.f, 0.f}; res[dt][1] = (f32x4){0.f, 0.f, 0.f, 0.f}; }
  TileContig tf{p.P + (size_t)r0 * PW + C_RK + h * 64, p.P + (size_t)r0 * PW + C_RV + h * 64, (size_t)64 * PW, (size_t)64 * PW};
#pragma unroll 1
  for (int dir = 0; dir < 2; ++dir) {
    float d = p.ret_decay[l * 8 + dir * 4 + h];
    float lg = -log1pf(__expf(-d)) * LOG2E;
    f32x4 o[4][2]; float m[2] = {0.f, 0.f}, ls[2] = {0.f, 0.f};
#pragma unroll
    for (int dt = 0; dt < 4; ++dt) { o[dt][0] = (f32x4){0.f, 0.f, 0.f, 0.f}; o[dt][1] = (f32x4){0.f, 0.f, 0.f, 0.f}; }
    rsrc_t str = mkbuf(p.St + ((size_t)(dir * 260 + c) * 4 + h) * 4096);
#pragma unroll
    for (int ks = 0; ks < 2; ++ks)
#pragma unroll
      for (int et = 0; et < 4; ++et) {
        bf16x8 af = __builtin_bit_cast(bf16x8, bload16(str, (unsigned)(lr * 64 + quad * 8) * 2u, (unsigned)(et * 16 * 64 + ks * 32) * 2u));
        o[et][0] = mfma16(af, qf[0][ks], o[et][0]);
        o[et][1] = mfma16(af, qf[1][ks], o[et][1]);
      }
#pragma unroll
    for (int qt = 0; qt < 2; ++qt) {
      int i = wave * 32 + qt * 16 + lr;
      float qdec = exp2f(lg * (float)(dir == 0 ? i + 1 : 128 - i));
#pragma unroll
      for (int et = 0; et < 4; ++et)
#pragma unroll
        for (int j = 0; j < 4; ++j) o[et][qt][j] *= qdec;
    }
    __builtin_amdgcn_sched_barrier(0);
    RetMask mk{lg, dir};
    attn_core<64, false, false>(qf, 2, tf, PW, PW, mk, o, m, ls, lds);
    __builtin_amdgcn_sched_barrier(0);
#pragma unroll
    for (int qt = 0; qt < 2; ++qt) {
      int i = wave * 32 + qt * 16 + lr;
      float ss = 0.f;
#pragma unroll
      for (int et = 0; et < 4; ++et)
#pragma unroll
        for (int j = 0; j < 4; ++j) { float v = o[et][qt][j]; ss += v * v; }
      ss += __shfl_xor(ss, 16); ss += __shfl_xor(ss, 32);
      float rinv = rsqrtf(ss * (1.f / 64.f) + 1e-6f);
      rsrc_t gpr = mkbuf(p.P + (size_t)r0 * PW + (dir == 0 ? C_RGF : C_RGB) + h * 64);
      unsigned goff = (unsigned)(i * PW + quad * 4) * 2u;
#pragma unroll
      for (int et = 0; et < 4; ++et) {
        u32x2 gw = bload8(gpr, goff, et * 32);
        float g0 = lo_f(gw.x), g1 = hi_f(gw.x), g2 = lo_f(gw.y), g3 = hi_f(gw.y);
        res[et][qt][0] += o[et][qt][0] * rinv * silu_f(g0);
        res[et][qt][1] += o[et][qt][1] * rinv * silu_f(g1);
        res[et][qt][2] += o[et][qt][2] * rinv * silu_f(g2);
        res[et][qt][3] += o[et][qt][3] * rinv * silu_f(g3);
      }
    }
  }
#pragma unroll
  for (int qt = 0; qt < 2; ++qt) {
    bf16_t* rp = p.ACT + (size_t)(r0 + wave * 32 + qt * 16 + lr) * 1024 + 256 + h * 64 + quad * 4;
#pragma unroll
    for (int et = 0; et < 4; ++et)
      *(u32x2*)(rp + et * 16) = MK2(pack2(res[et][qt][0], res[et][qt][1]), pack2(res[et][qt][2], res[et][qt][3]));
  }
}


#define XB_TMO      128
#define XB_XCNT(j)  (256  + 64 * (j))
#define XB_XSUB(j)  (1280 + 64 * (j))
#define XB_XGEN(j)  (2304 + 64 * (j))
#define XB_TOP      3328
#define XB_TOPGEN   3392
#define XCD_BAR_WORDS 3456
#define XB_SPIN_CAP (1u << 20)
#define LAS __attribute__((address_space(3)))
__device__ __forceinline__ unsigned xb_ld(unsigned* p)              { return __hip_atomic_load(p, __ATOMIC_RELAXED, __HIP_MEMORY_SCOPE_AGENT); }
__device__ __forceinline__ unsigned xb_add(unsigned* p, unsigned v) { return __hip_atomic_fetch_add(p, v, __ATOMIC_RELAXED, __HIP_MEMORY_SCOPE_AGENT); }
__device__ __forceinline__ unsigned xb_xcc_id() { return (unsigned)__builtin_amdgcn_s_getreg((3 << 11) | 20) & 0xFu; }
#define XB_SPIN(cond, bar) do { unsigned _sp = 0; while (cond) { __builtin_amdgcn_s_sleep(1); \
    if ((++_sp & 255u) == 0u) { if (xb_ld(&(bar)[XB_TMO])) break; if (_sp > XB_SPIN_CAP) { atomicAdd(&(bar)[XB_TMO], 1u); break; } } } } while (0)
struct XcdBarrier { unsigned* bar; unsigned x; volatile LAS unsigned* st; };
__device__ __forceinline__ XcdBarrier xcd_barrier_post(unsigned* bar, volatile LAS unsigned* st) {
    XcdBarrier b; b.bar = bar; b.x = xb_xcc_id(); b.st = st;
    if (threadIdx.x == 0) (void)xb_add(&bar[XB_XCNT(b.x)], 1u);
    return b;
}
__device__ __forceinline__ void xcd_barrier_complete(unsigned* bar, unsigned x, unsigned& nloc, unsigned& nx) {
    const unsigned G = gridDim.x * gridDim.y * gridDim.z;
    unsigned sum, cnt, mine, sp = 0u;
    for (;;) {
        sum = 0u; cnt = 0u; mine = 0u;
#pragma unroll
        for (unsigned j = 0; j < 16; ++j) { const unsigned c = xb_ld(&bar[XB_XCNT(j)]); sum += c; cnt += (c > 0u) ? 1u : 0u; mine = (j == x) ? c : mine; }
        if (sum == G) break;
        __builtin_amdgcn_s_sleep(1);
        if ((++sp & 255u) == 0u) { if (xb_ld(&bar[XB_TMO])) break; if (sp > XB_SPIN_CAP) { atomicAdd(&bar[XB_TMO], 1u); break; } }
    }
    nloc = mine > 0u ? mine : 1u; nx = cnt > 0u ? cnt : 1u;
}
__device__ __forceinline__ void xcd_barrier(const XcdBarrier& b) {
    asm volatile("s_waitcnt vmcnt(0)" ::: "memory");
    __syncthreads();
    if (threadIdx.x == 0) {
        unsigned* bar = b.bar;
        __builtin_amdgcn_s_waitcnt(0);
        unsigned nloc = b.st[0], nx = b.st[1];
        if (nloc == 0u) { xcd_barrier_complete(bar, b.x, nloc, nx); b.st[0] = nloc; b.st[1] = nx; }
        const unsigned old = xb_add(&bar[XB_XSUB(b.x)], 1u);
        const unsigned gen = old / nloc;
        if (old + 1u == (gen + 1u) * nloc) {
            __builtin_amdgcn_fence(__ATOMIC_RELEASE, "agent");
            asm volatile("s_waitcnt vmcnt(0)" ::: "memory");
            const unsigned og = xb_add(&bar[XB_TOP], 1u);
            const unsigned tg = og / nx;
            if (og + 1u == (tg + 1u) * nx) xb_add(&bar[XB_TOPGEN], 1u);
            else XB_SPIN(xb_ld(&bar[XB_TOPGEN]) == tg, bar);
            __builtin_amdgcn_fence(__ATOMIC_ACQUIRE, "agent");
            xb_add(&bar[XB_XGEN(b.x)], 1u);
            asm volatile("s_waitcnt vmcnt(0)" ::: "memory");
        } else {
            XB_SPIN(xb_ld(&bar[XB_XGEN(b.x)]) == gen, bar);
            __builtin_amdgcn_fence(__ATOMIC_ACQUIRE, "agent");
            asm volatile("s_waitcnt vmcnt(0)" ::: "memory");
        }
    }
    __syncthreads();
}

__device__ void run_phase(const Params& p, int ph, int bid, int nb, char* lds) {
#ifndef CM
#define CM 0xff
#endif
#ifndef PH_MASK
#define PH_MASK 0xfffff
#endif
  if (ph == 0) { if (PH_MASK & (1<<9)) prologue_phase(p, bid, nb, lds); return; }
  if (ph == 37) { if (PH_MASK & (1<<10)) final_norm_phase(p, bid, nb); return; }
  const int l = (ph - 1) / 9, sp = (ph - 1) % 9;
  const bf16_t* W = p.W + (size_t)l * W_LAYER;
  if (!((PH_MASK >> sp) & 1)) return;
  switch (sp) {
    case 0: norm_phase(p, l, 0, bid, nb); break;
    case 1: {
      EpiWin epi{p.P, p.rope64};
      for (int rd = 0;; ++rd) { int t = xcd_tile(rd, bid, nb); if (t >= 128 * 24) break; int pm, pn; big_coord(t, 24, pm, pn); gemm_big_tile(p.ACT, 1024, W + WO_IN, 1024, 1024, pm * 256, pn * 128, epi, lds); }
      for (int u = bid; u < 4 * 24; u += nb) gemm_tile(p.ACT, 1024, W + WO_IN, 1024, 1024, (256 + u / 24) * 128, (u % 24) * 128, epi, lds);
    } break;
    case 2: {
      EpiUq eq{&p}; EpiUkv ekv{&p};
      const int n0 = 260 * 4, n1 = n0 + 260 * 4, n2 = n1 + 260 * 3;
      for (int t = bid; t < n2; t += nb) {
        if (t < n0) ret_prep_item(p, l, t >> 2, t & 3, lds);
        else if (t < n1) { int u = t - n0, pm = u >> 2, h = u & 3; gemm_tile(p.P + C_CKV, PW, W + WO_UKV, 128, 128, pm * 128, h * 128, ekv, lds); mla_krope_item(p, pm * 128, h); }
        else { int u = t - n1, pm = u / 3, pn = u % 3; gemm_tile(p.P + C_CQ, PW, W + WO_UQ, 256, 256, pm * 128, pn * 128, eq, lds); }
      }
    } break;
    case 3: {
      int* slot = (int*)(lds + LDS_BYTES - 16);
      if (bid < 64) {
        if (CM & 2) ret_scan_item(p, l, bid >> 2, bid & 3);
        asm volatile("s_waitcnt vmcnt(0)" ::: "memory");
        __syncthreads();
        if (otid() == 0) { __builtin_amdgcn_fence(__ATOMIC_RELEASE, "agent"); asm volatile("s_waitcnt vmcnt(0)" ::: "memory"); xb_add(p.bar + 40 + l, 1u); }
      }
      bool scan_ready = false;
      const int x = bid & 7;
      for (int pass = 0; pass < 8; ++pass) {
        const int cmb = (x + pass) & 7;
        for (;;) {
          __syncthreads();
          if (otid() == 0) *slot = (int)atomicAdd(p.bar + 8 + l * 8 + cmb, 1u);
          __syncthreads();
          const int q = *slot;
          if (q >= 128) break;
          if (CM & 1) mla_item(p, cmb >> 2, cmb & 3, q, false, lds);
        }
      }
      const int n1 = 1024, n2 = n1 + 1024, n3 = n2 + 16, n4 = n3 + 16, n5 = n4 + 16, n6 = n5 + 1040;
      for (;;) {
        __syncthreads();
        if (otid() == 0) *slot = (int)atomicAdd(p.bar + l, 1u);
        __syncthreads();
        const int t = *slot;
        if (t >= n6) break;
        if (t < n1) { int u = t; if (CM & 4) na_item(p, l, u >> 9, (u >> 7) & 3, u & 127, lds); }
        else if (t < n2) { int u = t - n1; if (CM & 16) swa_item(p, l, u >> 9, (u >> 7) & 3, u & 127, false, lds); }
        else if (t < n3) { int u = t - n2; if (CM & 1) mla_item(p, u >> 3, (u >> 1) & 3, u & 1, true, lds); }
        else if (t < n4) { int u = t - n3; if (CM & 8) na_ctx_item(p, u >> 3, (u >> 1) & 3, u & 1, lds); }
        else if (t < n5) { int u = t - n4; if (CM & 16) swa_item(p, l, u >> 3, (u >> 1) & 3, u & 1, true, lds); }
        else {
          if (!scan_ready) {
            if (otid() == 0) { unsigned sp = 0; while (xb_ld(p.bar + 40 + l) < 64u && ++sp < (1u << 22)) __builtin_amdgcn_s_sleep(2); }
            __syncthreads();
            __builtin_amdgcn_fence(__ATOMIC_ACQUIRE, "agent");
            asm volatile("s_waitcnt vmcnt(0)" ::: "memory");
            scan_ready = true;
          }
          int u = t - n5; ret_out_item(p, l, u >> 2, u & 3, lds);
        }
      }
    } break;
    case 4: break;
    case 5: {
      EpiResid epi{&p, l, 2048, 1};
      for (int rd = 0;; ++rd) { int t = xcd_tile(rd, bid, nb); if (t >= 128 * 8) break; int pm, pn; big_coord(t, 8, pm, pn); gemm_big_tile(p.ACT, 1024, W + WO_OUT, 1024, 1024, pm * 256, pn * 128, epi, lds); }
      if (l < 3) for (int u = bid; u < 4 * 8; u += nb) gemm_tile(p.ACT, 1024, W + WO_OUT, 1024, 1024, (256 + (u >> 3)) * 128, (u & 7) * 128, epi, lds);
    } break;
    case 6: norm_phase(p, l, 1, bid, nb); break;
    case 7: {
      EpiFfn1 epi{p.P};
      for (int rd = 0;; ++rd) { int t = xcd_tile(rd, bid, nb); if (t >= 128 * 44) break; int pm, pn; big_coord(t, 44, pm, pn); gemm_big_tile(p.ACT, 1024, W + WO_13, 1024, 1024, pm * 256, pn * 128, epi, lds); }
      if (l < 3) for (int u = bid; u < 4 * 44; u += nb) gemm_tile(p.ACT, 1024, W + WO_13, 1024, 1024, (256 + u / 44) * 128, (u % 44) * 128, epi, lds);
    } break;
    case 8: {
      EpiResid epi{&p, l, 5120, 0};
      for (int rd = 0;; ++rd) { int t = xcd_tile(rd, bid, nb); if (t >= 128 * 8) break; int pm, pn; big_coord(t, 8, pm, pn); gemm_big_tile(p.P, 2816, W + WO_2, 2816, 2816, pm * 256, pn * 128, epi, lds); }
      if (l < 3) for (int u = bid; u < 4 * 8; u += nb) gemm_tile(p.P, 2816, W + WO_2, 2816, 2816, (256 + (u >> 3)) * 128, (u & 7) * 128, epi, lds);
    } break;
  }
}

__global__ void __launch_bounds__(256, 2) mega_kernel(Params p, int ph_lo, int ph_hi) {
  __shared__ __attribute__((aligned(16))) char lds[LDS_BYTES];
  __shared__ u32x4 xb_words;
#ifndef REP_MASK
#define REP_MASK 0
#endif
  if (ph_lo < 0) cg::this_grid().sync();
  if (threadIdx.x == 0) xb_words = (u32x4){0u, 0u, 0u, 0u};
  __syncthreads();
  XcdBarrier xb; xb.bar = p.bar; xb.x = 0; xb.st = (volatile LAS unsigned*)&xb_words;
  if (ph_hi - ph_lo > 1) xb = xcd_barrier_post(p.bar, (volatile LAS unsigned*)&xb_words);
  for (int ph = ph_lo; ph < ph_hi; ++ph) {
    if (ph >= 1 && ph <= 36 && (ph - 1) % 9 == 4) continue;
    const int reps = (REP_MASK && ph >= 1 && ph <= 36 && ((REP_MASK >> ((ph - 1) % 9)) & 1)) ? 2 : 1;
    for (int r = 0; r < reps; ++r) {
      run_phase(p, ph, blockIdx.x, gridDim.x, lds);
      if (r + 1 < reps || ph + 1 < ph_hi) xcd_barrier(xb);
#ifdef EXTRA_SYNC
      for (int e = 0; e < EXTRA_SYNC; ++e) xcd_barrier(xb);
#endif
    }
  }
}

extern "C" void kernel_launch(void* const* d_in, const int* in_sizes, int n_in, void* d_out, int out_size, void* d_ws, size_t ws_size,
                              hipStream_t stream) {
  Params p{};
  const float** f = (const float**)&p;
  for (int i = 0; i < 21; ++i) f[i] = (const float*)d_in[i];
  p.out = (float*)d_out;
  char* w = (char*)d_ws; size_t off = 0;
  auto take = [&](size_t bytes) { char* r = w + off; off += (bytes + 255) & ~(size_t)255; return r; };
  p.Y = (float*)take((size_t)512 * 1024 * 4);
  p.ACT = (bf16_t*)take((size_t)NROWS * 1024 * 2);
  p.P = (bf16_t*)take((size_t)NROWS * PW * 2);
  p.Qm = (bf16_t*)take((size_t)NROWS * 384 * 2);
  p.Km = (bf16_t*)take((size_t)8 * 16640 * 96 * 2);
  p.Vm = (bf16_t*)take((size_t)8 * 16640 * 64 * 2);
  p.Ksum = (float*)take((size_t)2 * 260 * 4 * 4096 * 4);
  p.St = (bf16_t*)take((size_t)2 * 260 * 4 * 4096 * 2);
  p.W = (bf16_t*)take((size_t)4 * W_LAYER * 2);
  p.mod = (float*)take((size_t)4 * 3 * 6144 * 4);
  p.rope64 = (float*)take(256 * 16 * 2 * 4);
  p.rope32 = (float*)take(256 * 8 * 2 * 4);
  p.bar = (unsigned*)take(XCD_BAR_WORDS * 4);
  if (off > ws_size) { fprintf(stderr, "workspace too small: need %zu have %zu\n", off, ws_size); return; }
#if MULTI_LAUNCH
  for (int ph = 0; ph < 38; ++ph) hipLaunchKernelGGL(mega_kernel, dim3(512), dim3(256), 0, stream, p, ph, ph + 1);
#else
  static int grid_blocks = 0;
  if (!grid_blocks) {
    int dev = 0, cus = 0, per_cu = 0;
    hipGetDevice(&dev);
    hipDeviceGetAttribute(&cus, hipDeviceAttributeMultiprocessorCount, dev);
    hipOccupancyMaxActiveBlocksPerMultiprocessor(&per_cu, mega_kernel, 256, 0);
    if (per_cu > 2) per_cu = 2;
    grid_blocks = cus * per_cu;
  }
  hipMemsetAsync(p.bar, 0, XCD_BAR_WORDS * 4, stream);
  int lo = 0, hi = 38;
  void* args[] = {&p, &lo, &hi};
  hipError_t e = hipLaunchCooperativeKernel((void*)mega_kernel, dim3(grid_blocks), dim3(256), args, 0, stream);
  if (e != hipSuccess) fprintf(stderr, "cooperative launch failed: %s (grid %d)\n", hipGetErrorString(e), grid_blocks);
#endif
}
```

```cpp
#include <hip/hip_runtime.h>
#include <hip/hip_cooperative_groups.h>
#include <cstdio>
#include <cstdint>
namespace cg = cooperative_groups;

#ifndef MULTI_LAUNCH
#define MULTI_LAUNCH 0
#endif

typedef unsigned short bf16_t;
typedef short bf16x8 __attribute__((ext_vector_type(8)));
typedef short s16x4 __attribute__((ext_vector_type(4)));
typedef float f32x4 __attribute__((ext_vector_type(4)));
typedef float f32x2 __attribute__((ext_vector_type(2)));
typedef __bf16 bf2_t __attribute__((ext_vector_type(2)));
typedef unsigned u32x4 __attribute__((ext_vector_type(4)));
typedef unsigned u32x2 __attribute__((ext_vector_type(2)));
#define MK4(a,b,c,d) ((u32x4){(a),(b),(c),(d)})
#define MK2(a,b) ((u32x2){(a),(b)})

#define NROWS 33280
#define NLAT 32768
#define PW 3072
#define LOG2E 1.4426950408889634f
#define LDS_BYTES 73728

#define C_CQ 0
#define C_CKV 256
#define C_KR 384
#define C_RQ 416
#define C_RK 672
#define C_RV 928
#define C_RGF 1184
#define C_RGB 1440
#define C_NQ 1696
#define C_NK 1952
#define C_NV 2208
#define C_SQ 2464
#define C_SK 2720
#define C_SV 2848

#define WO_IN 0
#define WO_UQ 3145728
#define WO_UKV 3244032
#define WO_OUT 3309568
#define WO_13 4358144
#define WO_2 10125312
#define W_LAYER 13008896

struct Params {
  const float *x, *c, *ctx, *c_ctx, *ada_w, *ada_b, *norm1_g, *w_in, *mla_q_norm, *mla_w_uq, *mla_kv_norm, *mla_w_ukv,
      *ret_decay, *na_rpb, *swa_sink, *w_out, *norm2_g, *ffn_w1, *ffn_w3, *ffn_w2, *final_g;
  float* out;
  float* Y;
  bf16_t* ACT;
  bf16_t* P;
  bf16_t *Qm, *Km, *Vm;
  float* Ksum;
  bf16_t* St;
  bf16_t* W;
  float* mod;
  float* rope64;
  float* rope32;
  unsigned* bar;
};

__device__ __forceinline__ int otid() { int t = threadIdx.x; asm volatile("" : "+v"(t)); return t; }
typedef __amdgpu_buffer_rsrc_t rsrc_t;
__device__ __forceinline__ rsrc_t mkbuf(const void* base) { return __builtin_amdgcn_make_buffer_rsrc((void*)base, 0, 0x7fffffff, 0x00020000); }
__device__ __forceinline__ u32x4 bload16(rsrc_t r, unsigned voff, unsigned soff) { return __builtin_amdgcn_raw_buffer_load_b128(r, voff, soff, 0); }
__device__ __forceinline__ u32x2 bload8(rsrc_t r, unsigned voff, unsigned soff) { return __builtin_amdgcn_raw_buffer_load_b64(r, voff, soff, 0); }
__device__ __forceinline__ float bf2f(bf16_t h) { return __uint_as_float(((unsigned)h) << 16); }
__device__ __forceinline__ unsigned pack2(float a, float b) { f32x2 v = {a, b}; bf2_t r = __builtin_convertvector(v, bf2_t); return __builtin_bit_cast(unsigned, r); }
__device__ __forceinline__ bf16_t f2bf(float a) { return (bf16_t)(pack2(a, 0.f) & 0xffffu); }
__device__ __forceinline__ float lo_f(unsigned u) { return __uint_as_float(u << 16); }
__device__ __forceinline__ float hi_f(unsigned u) { return __uint_as_float(u & 0xffff0000u); }
__device__ __forceinline__ f32x4 mfma16(bf16x8 a, bf16x8 b, f32x4 c) { return __builtin_amdgcn_mfma_f32_16x16x32_bf16(a, b, c, 0, 0, 0); }
typedef __attribute__((address_space(3))) s16x4 lds_s16x4;
__device__ __forceinline__ s16x4 tr_read(const bf16_t* p) { return __builtin_amdgcn_ds_read_tr16_b64_v4i16((lds_s16x4*)p); }
__device__ __forceinline__ bf16x8 cat8(s16x4 a, s16x4 b) { bf16x8 r; r[0]=a[0]; r[1]=a[1]; r[2]=a[2]; r[3]=a[3]; r[4]=b[0]; r[5]=b[1]; r[6]=b[2]; r[7]=b[3]; return r; }
__device__ __forceinline__ float wave_sum(float v) {
  v += __shfl_xor(v, 32); v += __shfl_xor(v, 16); v += __shfl_xor(v, 8); v += __shfl_xor(v, 4); v += __shfl_xor(v, 2); v += __shfl_xor(v, 1); return v;
}
__device__ __forceinline__ float quad_max(float v) {
  unsigned b = __float_as_uint(v);
  u32x2 r = __builtin_amdgcn_permlane16_swap(b, b, false, false);
  v = fmaxf(__uint_as_float(r[0]), __uint_as_float(r[1]));
  b = __float_as_uint(v);
  r = __builtin_amdgcn_permlane32_swap(b, b, false, false);
  return fmaxf(__uint_as_float(r[0]), __uint_as_float(r[1]));
}
__device__ __forceinline__ float silu_f(float a) { return a * __builtin_amdgcn_rcpf(1.f + __expf(-a)); }

__device__ __forceinline__ float* xrow(const Params& p, int row) { return row < NLAT ? p.out + (size_t)row * 1024 : p.Y + (size_t)(row - NLAT) * 1024; }
__device__ __forceinline__ const float* xsrc(const Params& p, int l, int row) {
  if (l == 0) return row < NLAT ? p.x + (size_t)row * 1024 : p.ctx + (size_t)(row - NLAT) * 1024;
  return xrow(p, row);
}
__device__ __forceinline__ int modv(int row) { return row < 16384 ? 0 : (row < NLAT ? 1 : 2); }

__device__ void transpose_tile(const float* __restrict__ src, int N, int k0, int n0, bf16_t* __restrict__ dst, int ldd, int mode,
                               const float* __restrict__ kscale, char* lds) {
  bf16_t(*t)[66] = (bf16_t(*)[66])lds;
  const int tid = otid();
  __syncthreads();
#pragma unroll 4
  for (int i = 0; i < 16; ++i) {
    int kk = i * 4 + (tid >> 6), nn = tid & 63;
    float v = (n0 + nn < N) ? src[(size_t)(k0 + kk) * N + n0 + nn] : 0.f;
    if (kscale) v *= kscale[k0 + kk];
    t[kk][nn] = f2bf(v);
  }
  __syncthreads();
  int nn = tid >> 2, kq = tid & 3;
  int n = n0 + nn;
  if (n < N) {
    int row = mode == 0 ? n : ((n >> 4) * 32 + (n & 15) + (mode == 2 ? 16 : 0));
    unsigned w[8];
#pragma unroll
    for (int e = 0; e < 8; ++e) w[e] = (unsigned)t[kq * 16 + 2 * e][nn] | ((unsigned)t[kq * 16 + 2 * e + 1][nn] << 16);
    u32x4* d = (u32x4*)(dst + (size_t)row * ldd + k0 + kq * 16);
    d[0] = MK4(w[0], w[1], w[2], w[3]);
    d[1] = MK4(w[4], w[5], w[6], w[7]);
  }
}

__device__ void prologue_phase(const Params& p, int bid, int nb, char* lds) {
  const int tid = otid();
  for (int it = bid; it < 4 * 3160; it += nb) {
    int l = it / 3160, r = it % 3160;
    bf16_t* W = p.W + (size_t)l * W_LAYER;
    if (r < 752) { int kt = r / 47, nt = r % 47; transpose_tile(p.w_in + (size_t)l * 1024 * 2976, 2976, kt * 64, nt * 64, W + WO_IN, 1024, 0, nullptr, lds); continue; }
    r -= 752;
    if (r < 24) { int kt = r / 6, nt = r % 6; transpose_tile(p.mla_w_uq + (size_t)l * 256 * 384, 384, kt * 64, nt * 64, W + WO_UQ, 256, 0, p.mla_q_norm + l * 256, lds); continue; }
    r -= 24;
    if (r < 16) { int kt = r / 8, nt = r % 8; transpose_tile(p.mla_w_ukv + (size_t)l * 128 * 512, 512, kt * 64, nt * 64, W + WO_UKV, 128, 0, p.mla_kv_norm + l * 128, lds); continue; }
    r -= 16;
    if (r < 256) { int kt = r / 16, nt = r % 16; transpose_tile(p.w_out + (size_t)l * 1024 * 1024, 1024, kt * 64, nt * 64, W + WO_OUT, 1024, 0, nullptr, lds); continue; }
    r -= 256;
    if (r < 704) { int kt = r / 44, nt = r % 44; transpose_tile(p.ffn_w1 + (size_t)l * 1024 * 2816, 2816, kt * 64, nt * 64, W + WO_13, 1024, 1, nullptr, lds); continue; }
    r -= 704;
    if (r < 704) { int kt = r / 44, nt = r % 44; transpose_tile(p.ffn_w3 + (size_t)l * 1024 * 2816, 2816, kt * 64, nt * 64, W + WO_13, 1024, 2, nullptr, lds); continue; }
    r -= 704;
    { int kt = r / 16, nt = r % 16; transpose_tile(p.ffn_w2 + (size_t)l * 2816 * 1024, 1024, kt * 64, nt * 64, W + WO_2, 2816, 0, nullptr, lds); }
  }
  for (int it = bid; it < 4 * 48; it += nb) {
    int l = it / 48, part = it % 48;
    u32x4* d = (u32x4*)(p.W + (size_t)l * W_LAYER + WO_IN + (size_t)2976 * 1024);
    d[part * 256 + tid] = MK4(0, 0, 0, 0);
  }
  for (int it = bid; it < 4 * 96; it += nb) {
    int l = it / 96, cb = it % 96;
    float* s = (float*)lds;
    float* red = s + 3 * 1024;
    __syncthreads();
    for (int i = tid; i < 3072; i += 256) {
      int v = i >> 10, k = i & 1023;
      float cv = v < 2 ? p.c[v * 1024 + k] : p.c_ctx[k];
      s[i] = silu_f(cv);
    }
    __syncthreads();
    int col = cb * 64 + (tid & 63), kp = tid >> 6;
    const float* w = p.ada_w + (size_t)l * 1024 * 6144 + (size_t)(kp * 256) * 6144 + col;
    float a0 = 0.f, a1 = 0.f, a2 = 0.f;
#pragma unroll 8
    for (int k = 0; k < 256; ++k) {
      float wv = w[(size_t)k * 6144];
      a0 += s[kp * 256 + k] * wv; a1 += s[1024 + kp * 256 + k] * wv; a2 += s[2048 + kp * 256 + k] * wv;
    }
    red[(kp * 3 + 0) * 64 + (tid & 63)] = a0; red[(kp * 3 + 1) * 64 + (tid & 63)] = a1; red[(kp * 3 + 2) * 64 + (tid & 63)] = a2;
    __syncthreads();
    if (tid < 192) {
      int v = tid >> 6, cc = tid & 63;
      float sum = red[(0 * 3 + v) * 64 + cc] + red[(1 * 3 + v) * 64 + cc] + red[(2 * 3 + v) * 64 + cc] + red[(3 * 3 + v) * 64 + cc];
      p.mod[(size_t)(l * 3 + v) * 6144 + cb * 64 + cc] = sum + p.ada_b[l * 6144 + cb * 64 + cc];
    }
  }
  if (bid == (nb > 1 ? 1 : 0)) {
    int pos = tid;
    for (int i = 0; i < 16; ++i) {
      float inv = exp2f(-(float)(2 * i) / 32.f * 13.287712379549449f);
      float ang = (float)pos * inv;
      float n = rintf(ang * 0.15915494309189535f);
      float r = fmaf(-n, 6.28318548202514648f, ang); r = fmaf(-n, -1.74845553146951715e-07f, r);
      p.rope64[(pos * 16 + i) * 2] = cosf(r); p.rope64[(pos * 16 + i) * 2 + 1] = sinf(r);
    }
    for (int i = 0; i < 8; ++i) {
      float inv = exp2f(-(float)(2 * i) / 16.f * 13.287712379549449f);
      float ang = (float)pos * inv;
      float n = rintf(ang * 0.15915494309189535f);
      float r = fmaf(-n, 6.28318548202514648f, ang); r = fmaf(-n, -1.74845553146951715e-07f, r);
      p.rope32[(pos * 8 + i) * 2] = cosf(r); p.rope32[(pos * 8 + i) * 2 + 1] = sinf(r);
    }
  }
}

__device__ void norm_phase(const Params& p, int l, int which, int bid, int nb) {
  const int wave = otid() >> 6, lane = otid() & 63;
  const float* g = (which == 0 ? p.norm1_g : p.norm2_g) + l * 1024;
  for (int row = bid * 4 + wave; row < NROWS; row += nb * 4) {
    const float* src = which == 0 ? xsrc(p, l, row) : xrow(p, row);
    const float* md = p.mod + (size_t)(l * 3 + modv(row)) * 6144 + which * 3072;
    f32x4 v[4], g4[4], sh[4], sc[4]; float ss = 0.f;
#pragma unroll
    for (int i = 0; i < 4; ++i) {
      int col = i * 256 + lane * 4;
      v[i] = *(const f32x4*)(src + col); g4[i] = *(const f32x4*)(g + col); sh[i] = *(const f32x4*)(md + col); sc[i] = *(const f32x4*)(md + 1024 + col);
    }
#pragma unroll
    for (int i = 0; i < 4; ++i) ss += v[i][0] * v[i][0] + v[i][1] * v[i][1] + v[i][2] * v[i][2] + v[i][3] * v[i][3];
    ss = wave_sum(ss);
    float rinv = rsqrtf(ss * (1.f / 1024.f) + 1e-6f);
#pragma unroll
    for (int i = 0; i < 4; ++i) {
      int col = i * 256 + lane * 4;
      f32x4 y;
#pragma unroll
      for (int j = 0; j < 4; ++j) y[j] = (v[i][j] * rinv * g4[i][j]) * (1.f + sc[i][j]) + sh[i][j];
      *(u32x2*)(p.ACT + (size_t)row * 1024 + col) = MK2(pack2(y[0], y[1]), pack2(y[2], y[3]));
    }
  }
}

__device__ void final_norm_phase(const Params& p, int bid, int nb) {
  const int wave = otid() >> 6, lane = otid() & 63;
  for (int row = bid * 4 + wave; row < NLAT; row += nb * 4) {
    float* src = p.out + (size_t)row * 1024;
    f32x4 v[4]; float ss = 0.f;
#pragma unroll
    for (int i = 0; i < 4; ++i) { v[i] = *(const f32x4*)(src + i * 256 + lane * 4); ss += v[i][0] * v[i][0] + v[i][1] * v[i][1] + v[i][2] * v[i][2] + v[i][3] * v[i][3]; }
    ss = wave_sum(ss);
    float rinv = rsqrtf(ss * (1.f / 1024.f) + 1e-6f);
#pragma unroll
    for (int i = 0; i < 4; ++i) {
      int col = i * 256 + lane * 4;
      f32x4 g4 = *(const f32x4*)(p.final_g + col);
      f32x4 y;
#pragma unroll
      for (int j = 0; j < 4; ++j) y[j] = v[i][j] * rinv * g4[j];
      *(f32x4*)(src + col) = y;
    }
  }
}

#define GSTR 64
template <class Epi>
__device__ __forceinline__ void gemm_tile(const bf16_t* __restrict__ A, int lda, const bf16_t* __restrict__ Bt, int ldb, int K, int m0, int n0,
                                          const Epi& epi, char* lds) {
  bf16_t* As = (bf16_t*)lds;
  bf16_t* Bs = As + 2 * 128 * GSTR;
  const int tid = otid(), wave = tid >> 6, lane = tid & 63, wm = wave >> 1, wn = wave & 1, lr = lane & 15, quad = lane >> 4;
  const int lrow = tid >> 3, lch = tid & 7, wch = lch ^ (lrow & 7);
  rsrc_t gar = mkbuf(A + (size_t)m0 * lda), gbr = mkbuf(Bt + (size_t)n0 * ldb);
  unsigned aoff[4], boff[4];
#pragma unroll
  for (int i = 0; i < 4; ++i) { aoff[i] = (unsigned)((lrow + 32 * i) * lda + lch * 8) * 2u; boff[i] = (unsigned)((lrow + 32 * i) * ldb + lch * 8) * 2u; }
  u32x4 ra0[4], rb0[4], ra1[4], rb1[4];
  f32x4 acc[4][4];
#pragma unroll
  for (int i = 0; i < 4; ++i)
#pragma unroll
    for (int j = 0; j < 4; ++j) acc[i][j] = (f32x4){0.f, 0.f, 0.f, 0.f};
  const int nk = K >> 6;
#pragma unroll
  for (int i = 0; i < 4; ++i) { ra0[i] = bload16(gar, aoff[i], 0); rb0[i] = bload16(gbr, boff[i], 0); }
#pragma unroll
  for (int i = 0; i < 4; ++i) { ra1[i] = bload16(gar, aoff[i], 128u); rb1[i] = bload16(gbr, boff[i], 128u); }
  __syncthreads();
#pragma unroll
  for (int i = 0; i < 4; ++i) { *(u32x4*)(As + (lrow + 32 * i) * GSTR + wch * 8) = ra0[i]; *(u32x4*)(Bs + (lrow + 32 * i) * GSTR + wch * 8) = rb0[i]; }
  __syncthreads();
  const int rsw = (quad ^ (lr & 7)) * 8;
  const bf16_t* as0 = As + (wm * 64 + lr) * GSTR;
  const bf16_t* bs0 = Bs + (wn * 64 + lr) * GSTR;
#define GEMM_COMPUTE(BUF)                                                                                         \
  {                                                                                                               \
    const bf16_t* as = as0 + (BUF) * 128 * GSTR;                                                                  \
    const bf16_t* bs = bs0 + (BUF) * 128 * GSTR;                                                                  \
    _Pragma("unroll") for (int ks = 0; ks < 2; ++ks) {                                                            \
      bf16x8 af[4], bfr[4];                                                                                       \
      _Pragma("unroll") for (int i = 0; i < 4; ++i) {                                                             \
        af[i] = *(const bf16x8*)(as + i * 16 * GSTR + (rsw ^ (ks * 32)));                                         \
        bfr[i] = *(const bf16x8*)(bs + i * 16 * GSTR + (rsw ^ (ks * 32)));                                        \
      }                                                                                                           \
      _Pragma("unroll") for (int mi = 0; mi < 4; ++mi)                                                            \
        _Pragma("unroll") for (int ni = 0; ni < 4; ++ni) acc[mi][ni] = mfma16(bfr[ni], af[mi], acc[mi][ni]);      \
    }                                                                                                             \
  }
  for (int kt = 0; kt < nk; kt += 2) {
    if (kt + 2 < nk) {
      const unsigned so = (unsigned)(kt + 2) * 128u;
#pragma unroll
      for (int i = 0; i < 4; ++i) { ra0[i] = bload16(gar, aoff[i], so); rb0[i] = bload16(gbr, boff[i], so); }
    }
    GEMM_COMPUTE(0)
#pragma unroll
    for (int i = 0; i < 4; ++i) { *(u32x4*)(As + 128 * GSTR + (lrow + 32 * i) * GSTR + wch * 8) = ra1[i]; *(u32x4*)(Bs + 128 * GSTR + (lrow + 32 * i) * GSTR + wch * 8) = rb1[i]; }
    __syncthreads();
    if (kt + 3 < nk) {
      const unsigned so = (unsigned)(kt + 3) * 128u;
#pragma unroll
      for (int i = 0; i < 4; ++i) { ra1[i] = bload16(gar, aoff[i], so); rb1[i] = bload16(gbr, boff[i], so); }
    }
    GEMM_COMPUTE(1)
    if (kt + 2 < nk) {
#pragma unroll
      for (int i = 0; i < 4; ++i) { *(u32x4*)(As + (lrow + 32 * i) * GSTR + wch * 8) = ra0[i]; *(u32x4*)(Bs + (lrow + 32 * i) * GSTR + wch * 8) = rb0[i]; }
    }
    __syncthreads();
  }
#undef GEMM_COMPUTE
  epi(acc, m0 + wm * 64, n0 + wn * 64, lr, quad);
}

#define BSTG (256 * 32 + 128 * 32)
template <class Epi>
__device__ __forceinline__ void gemm_big_tile(const bf16_t* __restrict__ A, int lda, const bf16_t* __restrict__ Bt, int ldb, int K, int m0, int n0,
                                              const Epi& epi, char* lds) {
  bf16_t* L = (bf16_t*)lds;
  const int tid = otid(), wave = tid >> 6, lane = tid & 63, wm = wave >> 1, wn = wave & 1, lr = lane & 15, quad = lane >> 4;
  const int lrow = tid >> 2, lch = tid & 3;
  const int gsw = (0x1320 >> (((tid >> 4) & 3) * 4)) & 3;
  const int wpos = (lrow * 32 + ((lch ^ gsw) * 8));
  rsrc_t gar = mkbuf(A + (size_t)m0 * lda), gbr = mkbuf(Bt + (size_t)n0 * ldb);
  unsigned aoff[4], boff[2];
#pragma unroll
  for (int i = 0; i < 4; ++i) aoff[i] = (unsigned)((lrow + 64 * i) * lda + lch * 8) * 2u;
#pragma unroll
  for (int i = 0; i < 2; ++i) boff[i] = (unsigned)((lrow + 64 * i) * ldb + lch * 8) * 2u;
  u32x4 ra0[4], rb0[2], ra1[4], rb1[2];
  f32x4 acc[8][4];
#pragma unroll
  for (int i = 0; i < 8; ++i)
#pragma unroll
    for (int j = 0; j < 4; ++j) acc[i][j] = (f32x4){0.f, 0.f, 0.f, 0.f};
  const int nk = K >> 5;
#pragma unroll
  for (int i = 0; i < 4; ++i) ra0[i] = bload16(gar, aoff[i], 0);
#pragma unroll
  for (int i = 0; i < 2; ++i) rb0[i] = bload16(gbr, boff[i], 0);
#pragma unroll
  for (int i = 0; i < 4; ++i) ra1[i] = bload16(gar, aoff[i], 64u);
#pragma unroll
  for (int i = 0; i < 2; ++i) rb1[i] = bload16(gbr, boff[i], 64u);
  __syncthreads();
#pragma unroll
  for (int i = 0; i < 4; ++i) *(u32x4*)(L + wpos + i * 64 * 32) = ra0[i];
#pragma unroll
  for (int i = 0; i < 2; ++i) *(u32x4*)(L + 256 * 32 + wpos + i * 64 * 32) = rb0[i];
  __syncthreads();
  const int rsw = (quad ^ ((0x1320 >> (((lr >> 2) & 3) * 4)) & 3)) * 8;
  const bf16_t* as0 = L + (wm * 128 + lr) * 32 + rsw;
  const bf16_t* bs0 = L + 256 * 32 + (wn * 64 + lr) * 32 + rsw;
#define BIG_FRAGS(ST)                                                                                             \
    bf16x8 af[8], bfr[4];                                                                                         \
    _Pragma("unroll") for (int i = 0; i < 4; ++i) bfr[i] = *(const bf16x8*)(bs0 + (ST) * BSTG + i * 16 * 32);    \
    _Pragma("unroll") for (int i = 0; i < 8; ++i) af[i] = *(const bf16x8*)(as0 + (ST) * BSTG + i * 16 * 32);
#define BIG_MMA(LO, HI)                                                                                           \
    _Pragma("unroll") for (int mi = LO; mi < HI; ++mi)                                                            \
      _Pragma("unroll") for (int ni = 0; ni < 4; ++ni) acc[mi][ni] = mfma16(bfr[ni], af[mi], acc[mi][ni]);
  for (int kt = 0; kt < nk; kt += 2) {
    if (kt + 2 < nk) {
      const unsigned so = (unsigned)(kt + 2) * 64u;
#pragma unroll
      for (int i = 0; i < 4; ++i) ra0[i] = bload16(gar, aoff[i], so);
#pragma unroll
      for (int i = 0; i < 2; ++i) rb0[i] = bload16(gbr, boff[i], so);
    }
    {
      BIG_FRAGS(0)
      BIG_MMA(0, 4)
#pragma unroll
      for (int i = 0; i < 4; ++i) *(u32x4*)(L + BSTG + wpos + i * 64 * 32) = ra1[i];
#pragma unroll
      for (int i = 0; i < 2; ++i) *(u32x4*)(L + BSTG + 256 * 32 + wpos + i * 64 * 32) = rb1[i];
      BIG_MMA(4, 8)
    }
    __syncthreads();
    if (kt + 3 < nk) {
      const unsigned so = (unsigned)(kt + 3) * 64u;
#pragma unroll
      for (int i = 0; i < 4; ++i) ra1[i] = bload16(gar, aoff[i], so);
#pragma unroll
      for (int i = 0; i < 2; ++i) rb1[i] = bload16(gbr, boff[i], so);
    }
    {
      BIG_FRAGS(1)
      BIG_MMA(0, 4)
      if (kt + 2 < nk) {
#pragma unroll
        for (int i = 0; i < 4; ++i) *(u32x4*)(L + wpos + i * 64 * 32) = ra0[i];
#pragma unroll
        for (int i = 0; i < 2; ++i) *(u32x4*)(L + 256 * 32 + wpos + i * 64 * 32) = rb0[i];
      }
      BIG_MMA(4, 8)
    }
    __syncthreads();
  }
#undef BIG_FRAGS
#undef BIG_MMA
  epi(acc, m0 + wm * 128, n0 + wn * 64, lr, quad);
}
__device__ __forceinline__ void big_coord(int t, int nN, int& pm, int& pn) { int gsz = 4 * nN; int g = t / gsz, r = t % gsz; pm = g * 4 + (r & 3); pn = r >> 2; }

__device__ __forceinline__ void tile_coord(int t, int nN, int& pm, int& pn) {
  const int nM = 260, GM = 8;
  int gsz = GM * nN; int g = t / gsz, r = t % gsz; int fm = g * GM; int gm = min(GM, nM - fm);
  pm = fm + (r % gm); pn = r / gm;
}
__device__ __forceinline__ int xcd_tile(int round, int bid, int nb) { return round * nb + (bid & 7) * (nb >> 3) + (bid >> 3); }

struct EpiWin {
  bf16_t* P; const float* rope64;
  template <int NMI>
  __device__ __forceinline__ void operator()(f32x4 (&acc)[NMI][4], int mb, int nbs, int lr, int quad) const {
#pragma unroll
    for (int mi = 0; mi < NMI; ++mi) {
      const int row = mb + mi * 16 + lr;
      if (row < NLAT) {
        const int tok = row & 16383, prow = tok >> 6, pcol = tok & 63;
#pragma unroll
        for (int pp = 0; pp < 2; ++pp) {
          const int col0 = nbs + pp * 32;
          const bool seg = (col0 >= C_RQ && col0 < C_RV) || (col0 >= C_SQ && col0 < C_SV);
          if (seg) {
            const int pos = (col0 & 63) == 32 ? prow : pcol;
            const f32x4 cs0 = *(const f32x4*)(rope64 + (pos * 16 + quad * 4) * 2), cs1 = *(const f32x4*)(rope64 + (pos * 16 + quad * 4) * 2 + 4);
            const float cc[4] = {cs0[0], cs0[2], cs1[0], cs1[2]}, sn[4] = {cs0[1], cs0[3], cs1[1], cs1[3]};
#pragma unroll
            for (int j = 0; j < 4; ++j) {
              const float x1 = acc[mi][2 * pp][j], x2 = acc[mi][2 * pp + 1][j];
              acc[mi][2 * pp][j] = x1 * cc[j] - x2 * sn[j];
              acc[mi][2 * pp + 1][j] = x2 * cc[j] + x1 * sn[j];
            }
          }
        }
      }
      bf16_t* rp = P + (size_t)row * PW + nbs + quad * 4;
#pragma unroll
      for (int ni = 0; ni < 4; ++ni) *(u32x2*)(rp + ni * 16) = MK2(pack2(acc[mi][ni][0], acc[mi][ni][1]), pack2(acc[mi][ni][2], acc[mi][ni][3]));
    }
  }
};

struct EpiResid {
  const Params* p; int l; int goff; int use_src;
  template <int NMI>
  __device__ __forceinline__ void operator()(f32x4 (&acc)[NMI][4], int mb, int nbs, int lr, int quad) const {
#pragma unroll
    for (int mi = 0; mi < NMI; ++mi) {
      int row = mb + mi * 16 + lr;
      const float* gate = p->mod + (size_t)(l * 3 + modv(row)) * 6144 + goff;
      const float* src = use_src ? xsrc(*p, l, row) : xrow(*p, row);
      float* dst = xrow(*p, row);
#pragma unroll
      for (int ni = 0; ni < 4; ++ni) {
        int col = nbs + ni * 16 + quad * 4;
        f32x4 g4 = *(const f32x4*)(gate + col), x4 = *(const f32x4*)(src + col);
#pragma unroll
        for (int j = 0; j < 4; ++j) x4[j] += g4[j] * acc[mi][ni][j];
        *(f32x4*)(dst + col) = x4;
      }
    }
  }
};

struct EpiFfn1 {
  bf16_t* U;
  template <int NMI>
  __device__ __forceinline__ void operator()(f32x4 (&acc)[NMI][4], int mb, int nbs, int lr, int quad) const {
#pragma unroll
    for (int mi = 0; mi < NMI; ++mi) {
      int row = mb + mi * 16 + lr;
#pragma unroll
      for (int pr = 0; pr < 2; ++pr) {
        int ucol = ((nbs + pr * 32) >> 5) * 16 + quad * 4;
        float u[4];
#pragma unroll
        for (int j = 0; j < 4; ++j) u[j] = silu_f(acc[mi][2 * pr][j]) * acc[mi][2 * pr + 1][j];
        *(u32x2*)(U + (size_t)row * 2816 + ucol) = MK2(pack2(u[0], u[1]), pack2(u[2], u[3]));
      }
    }
  }
};

struct EpiUq {
  const Params* p;
  __device__ __forceinline__ void operator()(f32x4 (&acc)[4][4], int mb, int nbs, int lr, int quad) const {
#pragma unroll
    for (int mi = 0; mi < 4; ++mi) {
      int row = mb + mi * 16 + lr;
      const bf16_t* cq = p->P + (size_t)row * PW + C_CQ + quad * 64;
      float ss = 0.f;
#pragma unroll
      for (int i = 0; i < 8; ++i) {
        u32x4 w = *(const u32x4*)(cq + i * 8);
        float a;
        a = lo_f(w.x); ss += a * a; a = hi_f(w.x); ss += a * a; a = lo_f(w.y); ss += a * a; a = hi_f(w.y); ss += a * a;
        a = lo_f(w.z); ss += a * a; a = hi_f(w.z); ss += a * a; a = lo_f(w.w); ss += a * a; a = hi_f(w.w); ss += a * a;
      }
      ss += __shfl_xor(ss, 16); ss += __shfl_xor(ss, 32);
      float rinv = rsqrtf(ss * (1.f / 256.f) + 1e-6f);
      bool latent = row < NLAT;
      int tok = row & 16383, prow = tok >> 6, pcol = tok & 63;
#pragma unroll
      for (int ni = 0; ni < 4; ++ni) {
        int col = nbs + ni * 16 + quad * 4;
        int sub = ((nbs >> 4) + ni) % 6;
        float v[4];
#pragma unroll
        for (int j = 0; j < 4; ++j) v[j] = acc[mi][ni][j] * rinv;
        if (sub >= 4) {
          float o[4];
#pragma unroll
          for (int j = 0; j < 4; ++j) o[j] = __shfl_xor(v[j], 32);
          if (latent) {
            int pos = sub == 4 ? prow : pcol;
#pragma unroll
            for (int j = 0; j < 4; ++j) {
              int i = (quad & 1) * 4 + j;
              float cs = p->rope32[(pos * 8 + i) * 2], sn = p->rope32[(pos * 8 + i) * 2 + 1];
              v[j] = quad < 2 ? v[j] * cs - o[j] * sn : v[j] * cs + o[j] * sn;
            }
          }
        }
        *(u32x2*)(p->Qm + (size_t)row * 384 + col) = MK2(pack2(v[0], v[1]), pack2(v[2], v[3]));
      }
    }
  }
};

__device__ __forceinline__ void mla_key_of_row(int row, int& b, int& key) {
  if (row < NLAT) { b = row >> 14; key = row & 16383; } else { b = (row - NLAT) >> 8; key = 16384 + ((row - NLAT) & 255); }
}

struct EpiUkv {
  const Params* p;
  __device__ __forceinline__ void operator()(f32x4 (&acc)[4][4], int mb, int nbs, int lr, int quad) const {
    int h = nbs >> 7, isv = (nbs >> 6) & 1;
#pragma unroll
    for (int mi = 0; mi < 4; ++mi) {
      int row = mb + mi * 16 + lr;
      const bf16_t* ck = p->P + (size_t)row * PW + C_CKV + quad * 32;
      float ss = 0.f;
#pragma unroll
      for (int i = 0; i < 4; ++i) {
        u32x4 w = *(const u32x4*)(ck + i * 8);
        float a;
        a = lo_f(w.x); ss += a * a; a = hi_f(w.x); ss += a * a; a = lo_f(w.y); ss += a * a; a = hi_f(w.y); ss += a * a;
        a = lo_f(w.z); ss += a * a; a = hi_f(w.z); ss += a * a; a = lo_f(w.w); ss += a * a; a = hi_f(w.w); ss += a * a;
      }
      ss += __shfl_xor(ss, 16); ss += __shfl_xor(ss, 32);
      float rinv = rsqrtf(ss * (1.f / 128.f) + 1e-6f);
      int b, key; mla_key_of_row(row, b, key);
      size_t kidx = (size_t)(b * 4 + h) * 16640 + key;
      bf16_t* dst = isv ? p->Vm + kidx * 64 : p->Km + kidx * 96;
#pragma unroll
      for (int ni = 0; ni < 4; ++ni) {
        f32x4 a = acc[mi][ni];
        *(u32x2*)(dst + ni * 16 + quad * 4) = MK2(pack2(a[0] * rinv, a[1] * rinv), pack2(a[2] * rinv, a[3] * rinv));
      }
    }
  }
};

__device__ __forceinline__ void rope64_pair_vals(const bf16_t* base, int pr, int prow, int pcol, const float* rope64, bool rotate, float (&o1)[8], float (&o2)[8], int& c0) {
  c0 = pr < 2 ? pr : pr + 2;
  int pos = pr < 2 ? prow : pcol, i0 = (pr & 1) * 8;
  u32x4 a = *(const u32x4*)(base + c0 * 8), b = *(const u32x4*)(base + (c0 + 2) * 8);
  unsigned aw[4] = {a.x, a.y, a.z, a.w}, bw[4] = {b.x, b.y, b.z, b.w};
#pragma unroll
  for (int e = 0; e < 8; ++e) {
    float x1 = (e & 1) ? hi_f(aw[e >> 1]) : lo_f(aw[e >> 1]);
    float x2 = (e & 1) ? hi_f(bw[e >> 1]) : lo_f(bw[e >> 1]);
    if (rotate) {
      float cs = rope64[(pos * 16 + i0 + e) * 2], sn = rope64[(pos * 16 + i0 + e) * 2 + 1];
      o1[e] = x1 * cs - x2 * sn; o2[e] = x2 * cs + x1 * sn;
    } else { o1[e] = x1; o2[e] = x2; }
  }
}
__device__ __forceinline__ u32x4 pack8(const float (&o)[8]) { return MK4(pack2(o[0], o[1]), pack2(o[2], o[3]), pack2(o[4], o[5]), pack2(o[6], o[7])); }

#define VSTR 80
__device__ void ret_prep_item(const Params& p, int l, int c, int h, char* lds) {
  bf16_t* vL = (bf16_t*)lds;
  bf16_t* kfL = vL + 128 * VSTR;
  bf16_t* kbL = kfL + 128 * VSTR;
  const int tid = otid(), wave = tid >> 6, lane = tid & 63, lr = lane & 15, quad = lane >> 4;
  const bool latent = c < 256;
  const int r0 = c * 128;
  float df = p.ret_decay[l * 8 + h], db = p.ret_decay[l * 8 + 4 + h];
  float lgf = -log1pf(__expf(-df)) * LOG2E, lgb = -log1pf(__expf(-db)) * LOG2E;
  __syncthreads();
#pragma unroll
  for (int i = 0; i < 2; ++i) {
    int idx = tid + 256 * i, r = idx >> 2, pr = idx & 3;
    int row = r0 + r, tok = row & 16383, prow = tok >> 6, pcol = tok & 63;
    bf16_t* kb = p.P + (size_t)row * PW + C_RK + h * 64;
    float o1[8], o2[8]; int c0;
    rope64_pair_vals(kb, pr, prow, pcol, p.rope64, false, o1, o2, c0);
    float wf = exp2f(lgf * (float)(127 - r)) * 0.125f, wb = exp2f(lgb * (float)r) * 0.125f;
    float t1[8], t2[8];
#pragma unroll
    for (int e = 0; e < 8; ++e) { t1[e] = o1[e] * wf; t2[e] = o2[e] * wf; }
    *(u32x4*)(kfL + r * VSTR + c0 * 8) = pack8(t1); *(u32x4*)(kfL + r * VSTR + (c0 + 2) * 8) = pack8(t2);
#pragma unroll
    for (int e = 0; e < 8; ++e) { t1[e] = o1[e] * wb; t2[e] = o2[e] * wb; }
    *(u32x4*)(kbL + r * VSTR + c0 * 8) = pack8(t1); *(u32x4*)(kbL + r * VSTR + (c0 + 2) * 8) = pack8(t2);
  }
#pragma unroll
  for (int i = 0; i < 4; ++i) {
    int idx = tid + 256 * i, r = idx >> 3, ch = idx & 7;
    *(u32x4*)(vL + r * VSTR + ch * 8) = *(const u32x4*)(p.P + (size_t)(r0 + r) * PW + C_RV + h * 64 + ch * 8);
  }
  __syncthreads();
  f32x4 acc[2][4];
#pragma unroll
  for (int d = 0; d < 2; ++d)
#pragma unroll
    for (int j = 0; j < 4; ++j) acc[d][j] = (f32x4){0.f, 0.f, 0.f, 0.f};
  const int roff = (quad * 4 + (lr >> 2)) * VSTR + (lr & 3) * 4;
#pragma unroll
  for (int ks = 0; ks < 4; ++ks) {
    bf16x8 af = cat8(tr_read(vL + ks * 32 * VSTR + roff + wave * 16), tr_read(vL + (ks * 32 + 16) * VSTR + roff + wave * 16));
#pragma unroll
    for (int dt = 0; dt < 4; ++dt) {
      bf16x8 b0 = cat8(tr_read(kfL + ks * 32 * VSTR + roff + dt * 16), tr_read(kfL + (ks * 32 + 16) * VSTR + roff + dt * 16));
      acc[0][dt] = mfma16(af, b0, acc[0][dt]);
      bf16x8 b1 = cat8(tr_read(kbL + ks * 32 * VSTR + roff + dt * 16), tr_read(kbL + (ks * 32 + 16) * VSTR + roff + dt * 16));
      acc[1][dt] = mfma16(af, b1, acc[1][dt]);
    }
  }
#pragma unroll
  for (int dir = 0; dir < 2; ++dir) {
    float* ks = p.Ksum + ((size_t)(dir * 260 + c) * 4 + h) * 4096;
#pragma unroll
    for (int dt = 0; dt < 4; ++dt)
#pragma unroll
      for (int j = 0; j < 4; ++j) ks[(wave * 16 + quad * 4 + j) * 64 + dt * 16 + lr] = acc[dir][dt][j];
  }
}

__device__ void swa_rope_item(const Params& p, int mt) {
  const int tid = otid();
  for (int idx = tid; idx < 128 * 24; idx += 256) {
    int r = idx / 24, pp = idx % 24;
    int row = mt * 128 + r, tok = row & 16383, prow = tok >> 6, pcol = tok & 63;
    int hd = pp >> 2, pr = pp & 3;
    bf16_t* base = p.P + (size_t)row * PW + (hd < 4 ? C_SQ + hd * 64 : C_SK + (hd - 4) * 64);
    float o1[8], o2[8]; int c0;
    rope64_pair_vals(base, pr, prow, pcol, p.rope64, true, o1, o2, c0);
    *(u32x4*)(base + c0 * 8) = pack8(o1); *(u32x4*)(base + (c0 + 2) * 8) = pack8(o2);
  }
}

__device__ void mla_krope_item(const Params& p, int m0, int h) {
  const int tid = otid();
  int row = m0 + (tid >> 1), part = tid & 1;
  bool latent = row < NLAT;
  int tok = row & 16383, pos = part == 0 ? (tok >> 6) : (tok & 63);
  const bf16_t* src = p.P + (size_t)row * PW + C_KR + part * 16;
  u32x4 a = *(const u32x4*)src, b = *(const u32x4*)(src + 8);
  unsigned aw[4] = {a.x, a.y, a.z, a.w}, bw[4] = {b.x, b.y, b.z, b.w};
  float o1[8], o2[8];
#pragma unroll
  for (int e = 0; e < 8; ++e) {
    float x1 = (e & 1) ? hi_f(aw[e >> 1]) : lo_f(aw[e >> 1]);
    float x2 = (e & 1) ? hi_f(bw[e >> 1]) : lo_f(bw[e >> 1]);
    if (latent) {
      float cs = p.rope32[(pos * 8 + e) * 2], sn = p.rope32[(pos * 8 + e) * 2 + 1];
      o1[e] = x1 * cs - x2 * sn; o2[e] = x2 * cs + x1 * sn;
    } else { o1[e] = x1; o2[e] = x2; }
  }
  int b_, key; mla_key_of_row(row, b_, key);
  bf16_t* dst = p.Km + ((size_t)(b_ * 4 + h) * 16640 + key) * 96 + 64 + part * 16;
  *(u32x4*)dst = pack8(o1); *(u32x4*)(dst + 8) = pack8(o2);
}

struct KVT { const bf16_t* k; const bf16_t* v; };

template <int DQK, bool SOFTMAX, bool PLAIN, class TileFn, class MaskFn>
__device__ __forceinline__ void attn_core(const bf16x8 (&qf)[2][DQK / 32], int ntiles, const TileFn& tf, int ldk, int ldv, const MaskFn& mk,
                                          f32x4 (&o)[4][2], float (&m)[2], float (&l)[2], char* lds) {
  constexpr int KSTR = DQK + 16, NKS = DQK / 32, KCH = DQK / 8, NKL = (64 * KCH) / 256;
  bf16_t* Kl = (bf16_t*)lds;
  bf16_t* Vl = Kl + 2 * 64 * KSTR;
  const int tid = otid(), wave = tid >> 6, lane = tid & 63, lr = lane & 15, quad = lane >> 4;
  constexpr bool MFMA_SUM = SOFTMAX && PLAIN;
  f32x4 lacc[2] = {(f32x4){0.f, 0.f, 0.f, 0.f}, (f32x4){0.f, 0.f, 0.f, 0.f}};
  u32x4 rk[NKL], rv[2];
  unsigned koff[NKL], voff[2];
#pragma unroll
  for (int i = 0; i < NKL; ++i) { int c = tid + i * 256, r = c / KCH, ch = c % KCH; koff[i] = (unsigned)(r * ldk + ch * 8) * 2u; }
#pragma unroll
  for (int i = 0; i < 2; ++i) { int c = tid + i * 256, r = c >> 3, ch = c & 7; voff[i] = (unsigned)(r * ldv + ch * 8) * 2u; }
  __syncthreads();
  {
    KVT kv = tf(0);
    rsrc_t kr = mkbuf(kv.k), vr = mkbuf(kv.v);
#pragma unroll
    for (int i = 0; i < NKL; ++i) rk[i] = bload16(kr, koff[i], 0);
#pragma unroll
    for (int i = 0; i < 2; ++i) rv[i] = bload16(vr, voff[i], 0);
#pragma unroll
    for (int i = 0; i < NKL; ++i) { int c = tid + i * 256, r = c / KCH, ch = c % KCH; *(u32x4*)(Kl + r * KSTR + ch * 8) = rk[i]; }
#pragma unroll
    for (int i = 0; i < 2; ++i) { int c = tid + i * 256, r = c >> 3, ch = c & 7; *(u32x4*)(Vl + r * VSTR + ch * 8) = rv[i]; }
  }
  __syncthreads();
  for (int t = 0; t < ntiles; ++t) {
    const int cur = t & 1;
    if (t + 1 < ntiles) {
      KVT kv = tf(t + 1);
      rsrc_t kr = mkbuf(kv.k), vr = mkbuf(kv.v);
#pragma unroll
      for (int i = 0; i < NKL; ++i) rk[i] = bload16(kr, koff[i], 0);
#pragma unroll
      for (int i = 0; i < 2; ++i) rv[i] = bload16(vr, voff[i], 0);
    }
    f32x4 s[4][2];
#pragma unroll
    for (int kt = 0; kt < 4; ++kt) { s[kt][0] = (f32x4){0.f, 0.f, 0.f, 0.f}; s[kt][1] = (f32x4){0.f, 0.f, 0.f, 0.f}; }
    const bf16_t* kb = Kl + cur * 64 * KSTR + lr * KSTR + quad * 8;
    {
      bf16x8 kfa[NKS][4];
#pragma unroll
      for (int ks = 0; ks < NKS; ++ks)
#pragma unroll
        for (int kt = 0; kt < 4; ++kt) kfa[ks][kt] = *(const bf16x8*)(kb + kt * 16 * KSTR + ks * 32);
#pragma unroll
      for (int ks = 0; ks < NKS; ++ks)
#pragma unroll
        for (int kt = 0; kt < 4; ++kt) {
          s[kt][0] = mfma16(kfa[ks][kt], qf[0][ks], s[kt][0]);
          s[kt][1] = mfma16(kfa[ks][kt], qf[1][ks], s[kt][1]);
        }
    }
    if (!PLAIN) {
#pragma unroll
      for (int kt = 0; kt < 4; ++kt)
#pragma unroll
        for (int qt = 0; qt < 2; ++qt)
#pragma unroll
          for (int j = 0; j < 4; ++j) s[kt][qt][j] = mk(t, wave * 32 + qt * 16 + lr, kt * 16 + quad * 4 + j, s[kt][qt][j]);
    }
    if (SOFTMAX) {
      const float sl2 = PLAIN ? mk(0, 0, 0, 1.0f) : 1.0f;
      float mnew[2], alpha[2];
#pragma unroll
      for (int qt = 0; qt < 2; ++qt) {
        float mx = fmaxf(fmaxf(s[0][qt][0], s[0][qt][1]), fmaxf(s[0][qt][2], s[0][qt][3]));
#pragma unroll
        for (int kt = 1; kt < 4; ++kt) mx = fmaxf(fmaxf(mx, s[kt][qt][0]), fmaxf(fmaxf(s[kt][qt][1], s[kt][qt][2]), s[kt][qt][3]));
        mx = quad_max(mx);
        if (PLAIN) mx *= sl2;
        mnew[qt] = fmaxf(m[qt], mx);
        alpha[qt] = __builtin_amdgcn_exp2f(m[qt] - mnew[qt]);
        m[qt] = mnew[qt];
      }
      if (__any((alpha[0] < 1.f) | (alpha[1] < 1.f))) {
#pragma unroll
        for (int qt = 0; qt < 2; ++qt) {
          l[qt] *= alpha[qt];
          if (MFMA_SUM) { lacc[qt][0] *= alpha[qt]; lacc[qt][1] *= alpha[qt]; lacc[qt][2] *= alpha[qt]; lacc[qt][3] *= alpha[qt]; }
#pragma unroll
          for (int dt = 0; dt < 4; ++dt)
#pragma unroll
            for (int j = 0; j < 4; ++j) o[dt][qt][j] *= alpha[qt];
        }
      }
#pragma unroll
      for (int qt = 0; qt < 2; ++qt) {
        float ls = 0.f;
        const float nm = -mnew[qt];
#pragma unroll
        for (int kt = 0; kt < 4; ++kt)
#pragma unroll
          for (int j = 0; j < 4; ++j) {
            float pv = __builtin_amdgcn_exp2f(PLAIN ? fmaf(s[kt][qt][j], sl2, nm) : s[kt][qt][j] + nm);
            s[kt][qt][j] = pv; if (!MFMA_SUM) ls += pv;
          }
        if (!MFMA_SUM) l[qt] += ls;
      }
    }
    bf16x8 pf[2][2];
#pragma unroll
    for (int qt = 0; qt < 2; ++qt)
#pragma unroll
      for (int kk = 0; kk < 2; ++kk) {
        unsigned w0 = pack2(s[2 * kk][qt][0], s[2 * kk][qt][1]), w1 = pack2(s[2 * kk][qt][2], s[2 * kk][qt][3]);
        unsigned w2 = pack2(s[2 * kk + 1][qt][0], s[2 * kk + 1][qt][1]), w3 = pack2(s[2 * kk + 1][qt][2], s[2 * kk + 1][qt][3]);
        u32x4 u = MK4(w0, w1, w2, w3);
        pf[qt][kk] = __builtin_bit_cast(bf16x8, u);
      }
    const bf16_t* vb = Vl + cur * 64 * VSTR + (quad * 4 + (lr >> 2)) * VSTR + (lr & 3) * 4;
    {
      bf16x8 vfa[2][4];
#pragma unroll
      for (int kk = 0; kk < 2; ++kk)
#pragma unroll
        for (int dt = 0; dt < 4; ++dt) vfa[kk][dt] = cat8(tr_read(vb + (kk * 32) * VSTR + dt * 16), tr_read(vb + (kk * 32 + 16) * VSTR + dt * 16));
#pragma unroll
      for (int kk = 0; kk < 2; ++kk)
#pragma unroll
        for (int dt = 0; dt < 4; ++dt) {
          o[dt][0] = mfma16(vfa[kk][dt], pf[0][kk], o[dt][0]);
          o[dt][1] = mfma16(vfa[kk][dt], pf[1][kk], o[dt][1]);
        }
      if (MFMA_SUM) {
        const bf16x8 ones = {(short)0x3f80, (short)0x3f80, (short)0x3f80, (short)0x3f80, (short)0x3f80, (short)0x3f80, (short)0x3f80, (short)0x3f80};
#pragma unroll
        for (int kk = 0; kk < 2; ++kk) { lacc[0] = mfma16(ones, pf[0][kk], lacc[0]); lacc[1] = mfma16(ones, pf[1][kk], lacc[1]); }
      }
    }
    if (t + 1 < ntiles) {
      const int nx = cur ^ 1;
#pragma unroll
      for (int i = 0; i < NKL; ++i) { int c = tid + i * 256, r = c / KCH, ch = c % KCH; *(u32x4*)(Kl + nx * 64 * KSTR + r * KSTR + ch * 8) = rk[i]; }
#pragma unroll
      for (int i = 0; i < 2; ++i) { int c = tid + i * 256, r = c >> 3, ch = c & 7; *(u32x4*)(Vl + nx * 64 * VSTR + r * VSTR + ch * 8) = rv[i]; }
    }
    __syncthreads();
  }
  if (MFMA_SUM) { const int quad_ = (otid() & 63) >> 4; l[0] = quad_ == 0 ? lacc[0][0] : 0.f; l[1] = quad_ == 0 ? lacc[1][0] : 0.f; }
}

__device__ __forceinline__ void attn_store(f32x4 (&o)[4][2], float (&m)[2], float (&l)[2], bool has_sink, float sink_l2, bf16_t* dst  , int ldo) {
  const int lane = otid() & 63, wave = otid() >> 6, lr = lane & 15, quad = lane >> 4;
#pragma unroll
  for (int qt = 0; qt < 2; ++qt) {
    float lt = l[qt]; lt += __shfl_xor(lt, 16); lt += __shfl_xor(lt, 32);
    if (has_sink) lt += exp2f(sink_l2 - m[qt]);
    float inv = 1.f / lt;
    bf16_t* rp = dst + (size_t)(wave * 32 + qt * 16 + lr) * ldo + quad * 4;
#pragma unroll
    for (int dt = 0; dt < 4; ++dt)
      *(u32x2*)(rp + dt * 16) = MK2(pack2(o[dt][qt][0] * inv, o[dt][qt][1] * inv), pack2(o[dt][qt][2] * inv, o[dt][qt][3] * inv));
  }
}

template <int NKS>
__device__ __forceinline__ void load_q(bf16x8 (&qf)[2][NKS], const bf16_t* q  , int ldq) {
  const int lane = otid() & 63, wave = otid() >> 6, lr = lane & 15, quad = lane >> 4;
#pragma unroll
  for (int qt = 0; qt < 2; ++qt)
#pragma unroll
    for (int ks = 0; ks < NKS; ++ks) qf[qt][ks] = *(const bf16x8*)(q + (size_t)(wave * 32 + qt * 16 + lr) * ldq + ks * 32 + quad * 8);
}

struct TileContig { const bf16_t* k; const bf16_t* v; size_t ks, vs;
  __device__ __forceinline__ KVT operator()(int t) const { return KVT{k + (size_t)t * ks, v + (size_t)t * vs}; } };
struct MaskScale { float sl2; __device__ __forceinline__ float operator()(int, int, int, float s) const { return s * sl2; } };

__device__ void mla_item(const Params& p, int b, int h, int qt128, bool ctxq, char* lds) {
  int r0 = ctxq ? NLAT + b * 256 + qt128 * 128 : b * 16384 + qt128 * 128;
  bf16x8 qf[2][3];
  load_q<3>(qf, p.Qm + (size_t)r0 * 384 + h * 96, 384);
  f32x4 o[4][2]; float m[2] = {-1e30f, -1e30f}, l[2] = {0.f, 0.f};
#pragma unroll
  for (int dt = 0; dt < 4; ++dt) { o[dt][0] = (f32x4){0.f, 0.f, 0.f, 0.f}; o[dt][1] = (f32x4){0.f, 0.f, 0.f, 0.f}; }
  int t0 = ctxq ? 256 : 0, nt = ctxq ? 4 : 260;
  size_t kbase = (size_t)(b * 4 + h) * 16640 + (size_t)t0 * 64;
  TileContig tf{p.Km + kbase * 96, p.Vm + kbase * 64, (size_t)64 * 96, (size_t)64 * 64};
  MaskScale mk{0.10206207261596575f * LOG2E};
  attn_core<96, true, true>(qf, nt, tf, 96, 64, mk, o, m, l, lds);
  attn_store(o, m, l, false, 0.f, p.ACT + (size_t)r0 * 1024 + h * 64, 1024);
}

struct NaTiles { const bf16_t* P; int b, h, lo, nw;
  __device__ __forceinline__ KVT operator()(int t) const {
    size_t row = t < nw ? (size_t)b * 16384 + (size_t)(lo + t) * 64 : (size_t)NLAT + b * 256 + (size_t)(t - nw) * 64;
    return KVT{P + row * PW + C_NK + h * 64, P + row * PW + C_NV + h * 64}; } };
struct NaMask { const float* rpb; int nw, lo, qr0; float sl2;
  __device__ __forceinline__ float operator()(int t, int qi, int kj, float s) const {
    if (t >= nw) return s * sl2;
    int qr = qr0 + (qi >> 6), qc = qi & 63, kr = lo + t;
    int r0q = min(max(qr - 4, 0), 248), c0 = min(max(qc - 8, 0), 48);
    bool ok = (kr >= r0q) & (kr < r0q + 8) & (kj >= c0) & (kj < c0 + 16);
    int dr = min(max(kr - qr + 7, 0), 14), dc = min(max(kj - qc, -15), 15) + 15;
    float bias = rpb[dr * 31 + dc];
    return ok ? s * sl2 + bias * LOG2E : -INFINITY; } };

__device__ void na_item(const Params& p, int l, int b, int h, int pair, char* lds) {
  float* rpbL = (float*)(lds + 60000);
  __syncthreads();
  for (int i = otid(); i < 465; i += 256) rpbL[i] = p.na_rpb[(size_t)(l * 4 + h) * 465 + i];
  int r0 = b * 16384 + pair * 128;
  bf16x8 qf[2][2];
  load_q<2>(qf, p.P + (size_t)r0 * PW + C_NQ + h * 64, PW);
  f32x4 o[4][2]; float m[2] = {-1e30f, -1e30f}, ls[2] = {0.f, 0.f};
#pragma unroll
  for (int dt = 0; dt < 4; ++dt) { o[dt][0] = (f32x4){0.f, 0.f, 0.f, 0.f}; o[dt][1] = (f32x4){0.f, 0.f, 0.f, 0.f}; }
  int qr0 = pair * 2;
  int lo = min(max(qr0 - 4, 0), 248), hi = min(max(qr0 + 1 - 4, 0), 248) + 7;
  int nw = hi - lo + 1;
  NaTiles tf{p.P, b, h, lo, nw};
  NaMask mk{rpbL, nw, lo, qr0, 0.125f * LOG2E};
  attn_core<64, true, false>(qf, nw + 4, tf, PW, PW, mk, o, m, ls, lds);
  attn_store(o, m, ls, false, 0.f, p.ACT + (size_t)r0 * 1024 + 512 + h * 64, 1024);
}

struct SwaTiles { const bf16_t* P; int b, kvh, nlo, nwt;
  __device__ __forceinline__ KVT operator()(int t) const {
    size_t row = t < nwt ? (size_t)b * 16384 + (size_t)(nlo * 128 + t * 64) : (size_t)NLAT + b * 256 + (size_t)(t - nwt) * 64;
    return KVT{P + row * PW + C_SK + kvh * 64, P + row * PW + C_SV + kvh * 64}; } };
struct SwaMask { int nwt, koff  ; float sl2;
  __device__ __forceinline__ float operator()(int t, int qi, int kj, float s) const {
    if (t >= nwt) return s * sl2;
    int delta = koff + t * 64 + kj - qi;
    return (delta <= 128 && delta >= -128) ? s * sl2 : -INFINITY; } };

__device__ void swa_item(const Params& p, int l, int b, int hq, int n, bool ctxq, char* lds) {
  int r0 = ctxq ? NLAT + b * 256 + n * 128 : b * 16384 + n * 128;
  bf16x8 qf[2][2];
  load_q<2>(qf, p.P + (size_t)r0 * PW + C_SQ + hq * 64, PW);
  f32x4 o[4][2]; float m[2] = {-1e30f, -1e30f}, ls[2] = {0.f, 0.f};
#pragma unroll
  for (int dt = 0; dt < 4; ++dt) { o[dt][0] = (f32x4){0.f, 0.f, 0.f, 0.f}; o[dt][1] = (f32x4){0.f, 0.f, 0.f, 0.f}; }
  int nlo = 0, nwt = 0;
  if (!ctxq) { nlo = max(n - 1, 0); int nhi = min(n + 1, 127); nwt = (nhi - nlo + 1) * 2; }
  SwaTiles tf{p.P, b, hq >> 1, nlo, nwt};
  SwaMask mk{nwt, (nlo - n) * 128, 0.125f * LOG2E};
  attn_core<64, true, false>(qf, nwt + 4, tf, PW, PW, mk, o, m, ls, lds);
  float sink = p.swa_sink[l * 4 + hq] * LOG2E;
  attn_store(o, m, ls, true, sink, p.ACT + (size_t)r0 * 1024 + 768 + hq * 64, 1024);
}

__device__ void na_ctx_item(const Params& p, int b, int h, int n, char* lds) {
  int r0 = NLAT + b * 256 + n * 128;
  bf16x8 qf[2][2];
  load_q<2>(qf, p.P + (size_t)r0 * PW + C_NQ + h * 64, PW);
  f32x4 o[4][2]; float m[2] = {-1e30f, -1e30f}, ls[2] = {0.f, 0.f};
#pragma unroll
  for (int dt = 0; dt < 4; ++dt) { o[dt][0] = (f32x4){0.f, 0.f, 0.f, 0.f}; o[dt][1] = (f32x4){0.f, 0.f, 0.f, 0.f}; }
  NaTiles tf{p.P, b, h, 0, 0};
  MaskScale mk{0.125f * LOG2E};
  attn_core<64, true, true>(qf, 4, tf, PW, PW, mk, o, m, ls, lds);
  attn_store(o, m, ls, false, 0.f, p.ACT + (size_t)r0 * 1024 + 512 + h * 64, 1024);
}

__device__ void ret_scan_item(const Params& p, int l, int combo, int part) {
  int dir = combo >> 3, b = (combo >> 2) & 1, h = combo & 3;
  float d = p.ret_decay[l * 8 + dir * 4 + h];
  float lg = -log1pf(__expf(-d)) * LOG2E;
  float gC = exp2f(lg * 128.f);
  int idx = part * 1024 + otid() * 4;
  f32x4 S = (f32x4){0.f, 0.f, 0.f, 0.f};
  const size_t dbase = ((size_t)dir * 260 * 4 + h) * 4096 + idx;
#pragma unroll 1
  for (int s0 = 0; s0 < 130; s0 += 13) {
    f32x4 kv[13]; int ch[13];
#pragma unroll
    for (int u = 0; u < 13; ++u) {
      int step = s0 + u;
      if (dir == 0) ch[u] = step < 2 ? 256 + 2 * b + step : b * 128 + (step - 2);
      else ch[u] = step < 2 ? 256 + 2 * b + 1 - step : b * 128 + 127 - (step - 2);
      kv[u] = *(const f32x4*)(p.Ksum + dbase + (size_t)ch[u] * 16384);
    }
#pragma unroll
    for (int u = 0; u < 13; ++u) {
      *(u32x2*)(p.St + dbase + (size_t)ch[u] * 16384) = MK2(pack2(S[0], S[1]), pack2(S[2], S[3]));
#pragma unroll
      for (int j = 0; j < 4; ++j) S[j] = S[j] * gC + kv[u][j];
    }
  }
}

struct RetMask { float lg; int dir;
  __device__ __forceinline__ float operator()(int t, int qi, int kj, float s) const {
    int j = t * 64 + kj; int df = dir == 0 ? qi - j : j - qi;
    return df >= 0 ? s * 0.125f * __builtin_amdgcn_exp2f(lg * (float)df) : 0.f; } };

__device__ void ret_out_item(const Params& p, int l, int c, int h, char* lds) {
  const int lane = otid() & 63, wave = otid() >> 6, lr = lane & 15, quad = lane >> 4;
  int r0 = c * 128;
  bf16x8 qf[2][2];
  load_q<2>(qf, p.P + (size_t)r0 * PW + C_RQ + h * 64, PW);
  f32x4 res[4][2];
#pragma unroll
  for (int dt = 0; dt < 4; ++dt) { res[dt][0] = (f32x4){0.f, 0.f, 0.f, 0.f}; res[dt][1] = (f32x4){0.f, 0.f, 0.f, 0.f}; }
  TileContig tf{p.P + (size_t)r0 * PW + C_RK + h * 64, p.P + (size_t)r0 * PW + C_RV + h * 64, (size_t)64 * PW, (size_t)64 * PW};
#pragma unroll 1
  for (int dir = 0; dir < 2; ++dir) {
    float d = p.ret_decay[l * 8 + dir * 4 + h];
    float lg = -log1pf(__expf(-d)) * LOG2E;
    f32x4 o[4][2]; float m[2] = {0.f, 0.f}, ls[2] = {0.f, 0.f};
#pragma unroll
    for (int dt = 0; dt < 4; ++dt) { o[dt][0] = (f32x4){0.f, 0.f, 0.f, 0.f}; o[dt][1] = (f32x4){0.f, 0.f, 0.f, 0.f}; }
    rsrc_t str = mkbuf(p.St + ((size_t)(dir * 260 + c) * 4 + h) * 4096);
#pragma unroll
    for (int ks = 0; ks < 2; ++ks)
#pragma unroll
      for (int et = 0; et < 4; ++et) {
        bf16x8 af = __builtin_bit_cast(bf16x8, bload16(str, (unsigned)(lr * 64 + quad * 8) * 2u, (unsigned)(et * 16 * 64 + ks * 32) * 2u));
        o[et][0] = mfma16(af, qf[0][ks], o[et][0]);
        o[et][1] = mfma16(af, qf[1][ks], o[et][1]);
      }
#pragma unroll
    for (int qt = 0; qt < 2; ++qt) {
      int i = wave * 32 + qt * 16 + lr;
      float qdec = exp2f(lg * (float)(dir == 0 ? i + 1 : 128 - i));
#pragma unroll
      for (int et = 0; et < 4; ++et)
#pragma unroll
        for (int j = 0; j < 4; ++j) o[et][qt][j] *= qdec;
    }
    __builtin_amdgcn_sched_barrier(0);
    RetMask mk{lg, dir};
    attn_core<64, false, false>(qf, 2, tf, PW, PW, mk, o, m, ls, lds);
    __builtin_amdgcn_sched_barrier(0);
#pragma unroll
    for (int qt = 0; qt < 2; ++qt) {
      int i = wave * 32 + qt * 16 + lr;
      float ss = 0.f;
#pragma unroll
      for (int et = 0; et < 4; ++et)
#pragma unroll
        for (int j = 0; j < 4; ++j) { float v = o[et][qt][j]; ss += v * v; }
      ss += __shfl_xor(ss, 16); ss += __shfl_xor(ss, 32);
      float rinv = rsqrtf(ss * (1.f / 64.f) + 1e-6f);
      rsrc_t gpr = mkbuf(p.P + (size_t)r0 * PW + (dir == 0 ? C_RGF : C_RGB) + h * 64);
      unsigned goff = (unsigned)(i * PW + quad * 4) * 2u;
#pragma unroll
      for (int et = 0; et < 4; ++et) {
        u32x2 gw = bload8(gpr, goff, et * 32);
        float g0 = lo_f(gw.x), g1 = hi_f(gw.x), g2 = lo_f(gw.y), g3 = hi_f(gw.y);
        res[et][qt][0] += o[et][qt][0] * rinv * silu_f(g0);
        res[et][qt][1] += o[et][qt][1] * rinv * silu_f(g1);
        res[et][qt][2] += o[et][qt][2] * rinv * silu_f(g2);
        res[et][qt][3] += o[et][qt][3] * rinv * silu_f(g3);
      }
    }
  }
#pragma unroll
  for (int qt = 0; qt < 2; ++qt) {
    bf16_t* rp = p.ACT + (size_t)(r0 + wave * 32 + qt * 16 + lr) * 1024 + 256 + h * 64 + quad * 4;
#pragma unroll
    for (int et = 0; et < 4; ++et)
      *(u32x2*)(rp + et * 16) = MK2(pack2(res[et][qt][0], res[et][qt][1]), pack2(res[et][qt][2], res[et][qt][3]));
  }
}


#define XB_TMO      128
#define XB_XCNT(j)  (256  + 64 * (j))
#define XB_XSUB(j)  (1280 + 64 * (j))
#define XB_XGEN(j)  (2304 + 64 * (j))
#define XB_TOP      3328
#define XB_TOPGEN   3392
#define XCD_BAR_WORDS 3456
#define XB_SPIN_CAP (1u << 20)
#define LAS __attribute__((address_space(3)))
__device__ __forceinline__ unsigned xb_ld(unsigned* p)              { return __hip_atomic_load(p, __ATOMIC_RELAXED, __HIP_MEMORY_SCOPE_AGENT); }
__device__ __forceinline__ unsigned xb_add(unsigned* p, unsigned v) { return __hip_atomic_fetch_add(p, v, __ATOMIC_RELAXED, __HIP_MEMORY_SCOPE_AGENT); }
__device__ __forceinline__ unsigned xb_xcc_id() { return (unsigned)__builtin_amdgcn_s_getreg((3 << 11) | 20) & 0xFu; }
#define XB_SPIN(cond, bar) do { unsigned _sp = 0; while (cond) { __builtin_amdgcn_s_sleep(1); \
    if ((++_sp & 255u) == 0u) { if (xb_ld(&(bar)[XB_TMO])) break; if (_sp > XB_SPIN_CAP) { atomicAdd(&(bar)[XB_TMO], 1u); break; } } } } while (0)
struct XcdBarrier { unsigned* bar; unsigned x; volatile LAS unsigned* st; };
__device__ __forceinline__ XcdBarrier xcd_barrier_post(unsigned* bar, volatile LAS unsigned* st) {
    XcdBarrier b; b.bar = bar; b.x = xb_xcc_id(); b.st = st;
    if (threadIdx.x == 0) (void)xb_add(&bar[XB_XCNT(b.x)], 1u);
    return b;
}
__device__ __forceinline__ void xcd_barrier_complete(unsigned* bar, unsigned x, unsigned& nloc, unsigned& nx) {
    const unsigned G = gridDim.x * gridDim.y * gridDim.z;
    unsigned sum, cnt, mine, sp = 0u;
    for (;;) {
        sum = 0u; cnt = 0u; mine = 0u;
#pragma unroll
        for (unsigned j = 0; j < 16; ++j) { const unsigned c = xb_ld(&bar[XB_XCNT(j)]); sum += c; cnt += (c > 0u) ? 1u : 0u; mine = (j == x) ? c : mine; }
        if (sum == G) break;
        __builtin_amdgcn_s_sleep(1);
        if ((++sp & 255u) == 0u) { if (xb_ld(&bar[XB_TMO])) break; if (sp > XB_SPIN_CAP) { atomicAdd(&bar[XB_TMO], 1u); break; } }
    }
    nloc = mine > 0u ? mine : 1u; nx = cnt > 0u ? cnt : 1u;
}
__device__ __forceinline__ void xcd_barrier(const XcdBarrier& b) {
    asm volatile("s_waitcnt vmcnt(0)" ::: "memory");
    __syncthreads();
    if (threadIdx.x == 0) {
        unsigned* bar = b.bar;
        __builtin_amdgcn_s_waitcnt(0);
        unsigned nloc = b.st[0], nx = b.st[1];
        if (nloc == 0u) { xcd_barrier_complete(bar, b.x, nloc, nx); b.st[0] = nloc; b.st[1] = nx; }
        const unsigned old = xb_add(&bar[XB_XSUB(b.x)], 1u);
        const unsigned gen = old / nloc;
        if (old + 1u == (gen + 1u) * nloc) {
            __builtin_amdgcn_fence(__ATOMIC_RELEASE, "agent");
            asm volatile("s_waitcnt vmcnt(0)" ::: "memory");
            const unsigned og = xb_add(&bar[XB_TOP], 1u);
            const unsigned tg = og / nx;
            if (og + 1u == (tg + 1u) * nx) xb_add(&bar[XB_TOPGEN], 1u);
            else XB_SPIN(xb_ld(&bar[XB_TOPGEN]) == tg, bar);
            __builtin_amdgcn_fence(__ATOMIC_ACQUIRE, "agent");
            xb_add(&bar[XB_XGEN(b.x)], 1u);
            asm volatile("s_waitcnt vmcnt(0)" ::: "memory");
        } else {
            XB_SPIN(xb_ld(&bar[XB_XGEN(b.x)]) == gen, bar);
            __builtin_amdgcn_fence(__ATOMIC_ACQUIRE, "agent");
            asm volatile("s_waitcnt vmcnt(0)" ::: "memory");
        }
    }
    __syncthreads();
}

__device__ void run_phase(const Params& p, int ph, int bid, int nb, char* lds) {
#ifndef CM
#define CM 0xff
#endif
#ifndef PH_MASK
#define PH_MASK 0xfffff
#endif
  if (ph == 0) { if (PH_MASK & (1<<9)) prologue_phase(p, bid, nb, lds); return; }
  if (ph == 37) { if (PH_MASK & (1<<10)) final_norm_phase(p, bid, nb); return; }
  const int l = (ph - 1) / 9, sp = (ph - 1) % 9;
  const bf16_t* W = p.W + (size_t)l * W_LAYER;
  if (!((PH_MASK >> sp) & 1)) return;
  switch (sp) {
    case 0: norm_phase(p, l, 0, bid, nb); break;
    case 1: {
      EpiWin epi{p.P, p.rope64};
      for (int rd = 0;; ++rd) { int t = xcd_tile(rd, bid, nb); if (t >= 128 * 24) break; int pm, pn; big_coord(t, 24, pm, pn); gemm_big_tile(p.ACT, 1024, W + WO_IN, 1024, 1024, pm * 256, pn * 128, epi, lds); }
      for (int u = bid; u < 4 * 24; u += nb) gemm_tile(p.ACT, 1024, W + WO_IN, 1024, 1024, (256 + u / 24) * 128, (u % 24) * 128, epi, lds);
    } break;
    case 2: {
      EpiUq eq{&p}; EpiUkv ekv{&p};
      const int n0 = 260 * 4, n1 = n0 + 260 * 4, n2 = n1 + 260 * 3;
      for (int t = bid; t < n2; t += nb) {
        if (t < n0) ret_prep_item(p, l, t >> 2, t & 3, lds);
        else if (t < n1) { int u = t - n0, pm = u >> 2, h = u & 3; gemm_tile(p.P + C_CKV, PW, W + WO_UKV, 128, 128, pm * 128, h * 128, ekv, lds); mla_krope_item(p, pm * 128, h); }
        else { int u = t - n1, pm = u / 3, pn = u % 3; gemm_tile(p.P + C_CQ, PW, W + WO_UQ, 256, 256, pm * 128, pn * 128, eq, lds); }
      }
    } break;
    case 3: {
      int* slot = (int*)(lds + LDS_BYTES - 16);
      if (bid < 64) {
        if (CM & 2) ret_scan_item(p, l, bid >> 2, bid & 3);
        asm volatile("s_waitcnt vmcnt(0)" ::: "memory");
        __syncthreads();
        if (otid() == 0) { __builtin_amdgcn_fence(__ATOMIC_RELEASE, "agent"); asm volatile("s_waitcnt vmcnt(0)" ::: "memory"); xb_add(p.bar + 40 + l, 1u); }
      }
      bool scan_ready = false;
      const int x = bid & 7;
      for (int pass = 0; pass < 8; ++pass) {
        const int cmb = (x + pass) & 7;
        for (;;) {
          __syncthreads();
          if (otid() == 0) *slot = (int)atomicAdd(p.bar + 8 + l * 8 + cmb, 1u);
          __syncthreads();
          const int q = *slot;
          if (q >= 128) break;
          if (CM & 1) mla_item(p, cmb >> 2, cmb & 3, q, false, lds);
        }
      }
      const int n1 = 1024, n2 = n1 + 1024, n3 = n2 + 16, n4 = n3 + 16, n5 = n4 + 16, n6 = n5 + 1040;
      for (;;) {
        __syncthreads();
        if (otid() == 0) *slot = (int)atomicAdd(p.bar + l, 1u);
        __syncthreads();
        const int t = *slot;
        if (t >= n6) break;
        if (t < n1) { int u = t; if (CM & 4) na_item(p, l, u >> 9, (u >> 7) & 3, u & 127, lds); }
        else if (t < n2) { int u = t - n1; if (CM & 16) swa_item(p, l, u >> 9, (u >> 7) & 3, u & 127, false, lds); }
        else if (t < n3) { int u = t - n2; if (CM & 1) mla_item(p, u >> 3, (u >> 1) & 3, u & 1, true, lds); }
        else if (t < n4) { int u = t - n3; if (CM & 8) na_ctx_item(p, u >> 3, (u >> 1) & 3, u & 1, lds); }
        else if (t < n5) { int u = t - n4; if (CM & 16) swa_item(p, l, u >> 3, (u >> 1) & 3, u & 1, true, lds); }
        else {
          if (!scan_ready) {
            if (otid() == 0) { unsigned sp = 0; while (xb_ld(p.bar + 40 + l) < 64u && ++sp < (1u << 22)) __builtin_amdgcn_s_sleep(2); }
            __syncthreads();
            __builtin_amdgcn_fence(__ATOMIC_ACQUIRE, "agent");
            asm volatile("s_waitcnt vmcnt(0)" ::: "memory");
            scan_ready = true;
          }
          int u = t - n5; ret_out_item(p, l, u >> 2, u & 3, lds);
        }
      }
    } break;
    case 4: break;
    case 5: {
      EpiResid epi{&p, l, 2048, 1};
      for (int rd = 0;; ++rd) { int t = xcd_tile(rd, bid, nb); if (t >= 128 * 8) break; int pm, pn; big_coord(t, 8, pm, pn); gemm_big_tile(p.ACT, 1024, W + WO_OUT, 1024, 1024, pm * 256, pn * 128, epi, lds); }
      if (l < 3) for (int u = bid; u < 4 * 8; u += nb) gemm_tile(p.ACT, 1024, W + WO_OUT, 1024, 1024, (256 + (u >> 3)) * 128, (u & 7) * 128, epi, lds);
    } break;
    case 6: norm_phase(p, l, 1, bid, nb); break;
    case 7: {
      EpiFfn1 epi{p.P};
      for (int rd = 0;; ++rd) { int t = xcd_tile(rd, bid, nb); if (t >= 128 * 44) break; int pm, pn; big_coord(t, 44, pm, pn); gemm_big_tile(p.ACT, 1024, W + WO_13, 1024, 1024, pm * 256, pn * 128, epi, lds); }
      if (l < 3) for (int u = bid; u < 4 * 44; u += nb) gemm_tile(p.ACT, 1024, W + WO_13, 1024, 1024, (256 + u / 44) * 128, (u % 44) * 128, epi, lds);
    } break;
    case 8: {
      EpiResid epi{&p, l, 5120, 0};
      for (int rd = 0;; ++rd) { int t = xcd_tile(rd, bid, nb); if (t >= 128 * 8) break; int pm, pn; big_coord(t, 8, pm, pn); gemm_big_tile(p.P, 2816, W + WO_2, 2816, 2816, pm * 256, pn * 128, epi, lds); }
      if (l < 3) for (int u = bid; u < 4 * 8; u += nb) gemm_tile(p.P, 2816, W + WO_2, 2816, 2816, (256 + (u >> 3)) * 128, (u & 7) * 128, epi, lds);
    } break;
  }
}

__global__ void __launch_bounds__(256, 2) mega_kernel(Params p, int ph_lo, int ph_hi) {
  __shared__ __attribute__((aligned(16))) char lds[LDS_BYTES];
  __shared__ u32x4 xb_words;
#ifndef REP_MASK
#define REP_MASK 0
#endif
  if (ph_lo < 0) cg::this_grid().sync();
  if (threadIdx.x == 0) xb_words = (u32x4){0u, 0u, 0u, 0u};
  __syncthreads();
  XcdBarrier xb; xb.bar = p.bar; xb.x = 0; xb.st = (volatile LAS unsigned*)&xb_words;
  if (ph_hi - ph_lo > 1) xb = xcd_barrier_post(p.bar, (volatile LAS unsigned*)&xb_words);
  for (int ph = ph_lo; ph < ph_hi; ++ph) {
    if (ph >= 1 && ph <= 36 && (ph - 1) % 9 == 4) continue;
    const int reps = (REP_MASK && ph >= 1 && ph <= 36 && ((REP_MASK >> ((ph - 1) % 9)) & 1)) ? 2 : 1;
    for (int r = 0; r < reps; ++r) {
      run_phase(p, ph, blockIdx.x, gridDim.x, lds);
      if (r + 1 < reps || ph + 1 < ph_hi) xcd_barrier(xb);
#ifdef EXTRA_SYNC
      for (int e = 0; e < EXTRA_SYNC; ++e) xcd_barrier(xb);
#endif
    }
  }
}

extern "C" void kernel_launch(void* const* d_in, const int* in_sizes, int n_in, void* d_out, int out_size, void* d_ws, size_t ws_size,
                              hipStream_t stream) {
  Params p{};
  const float** f = (const float**)&p;
  for (int i = 0; i < 21; ++i) f[i] = (const float*)d_in[i];
  p.out = (float*)d_out;
  char* w = (char*)d_ws; size_t off = 0;
  auto take = [&](size_t bytes) { char* r = w + off; off += (bytes + 255) & ~(size_t)255; return r; };
  p.Y = (float*)take((size_t)512 * 1024 * 4);
  p.ACT = (bf16_t*)take((size_t)NROWS * 1024 * 2);
  p.P = (bf16_t*)take((size_t)NROWS * PW * 2);
  p.Qm = (bf16_t*)take((size_t)NROWS * 384 * 2);
  p.Km = (bf16_t*)take((size_t)8 * 16640 * 96 * 2);
  p.Vm = (bf16_t*)take((size_t)8 * 16640 * 64 * 2);
  p.Ksum = (float*)take((size_t)2 * 260 * 4 * 4096 * 4);
  p.St = (bf16_t*)take((size_t)2 * 260 * 4 * 4096 * 2);
  p.W = (bf16_t*)take((size_t)4 * W_LAYER * 2);
  p.mod = (float*)take((size_t)4 * 3 * 6144 * 4);
  p.rope64 = (float*)take(256 * 16 * 2 * 4);
  p.rope32 = (float*)take(256 * 8 * 2 * 4);
  p.bar = (unsigned*)take(XCD_BAR_WORDS * 4);
  if (off > ws_size) { fprintf(stderr, "workspace too small: need %zu have %zu\n", off, ws_size); return; }
#if MULTI_LAUNCH
  for (int ph = 0; ph < 38; ++ph) hipLaunchKernelGGL(mega_kernel, dim3(512), dim3(256), 0, stream, p, ph, ph + 1);
#else
  static int grid_blocks = 0;
  if (!grid_blocks) {
    int dev = 0, cus = 0, per_cu = 0;
    hipGetDevice(&dev);
    hipDeviceGetAttribute(&cus, hipDeviceAttributeMultiprocessorCount, dev);
    hipOccupancyMaxActiveBlocksPerMultiprocessor(&per_cu, mega_kernel, 256, 0);
    if (per_cu > 2) per_cu = 2;
    grid_blocks = cus * per_cu;
  }
  hipMemsetAsync(p.bar, 0, XCD_BAR_WORDS * 4, stream);
  int lo = 0, hi = 38;
  void* args[] = {&p, &lo, &hi};
  hipError_t e = hipLaunchCooperativeKernel((void*)mega_kernel, dim3(grid_blocks), dim3(256), args, 0, stream);
  if (e != hipSuccess) fprintf(stderr, "cooperative launch failed: %s (grid %d)\n", hipGetErrorString(e), grid_blocks);
#endif
}
```

```cpp
#include <hip/hip_runtime.h>
#include <hip/hip_cooperative_groups.h>
#include <cstdio>
#include <cstdint>
namespace cg = cooperative_groups;

#ifndef MULTI_LAUNCH
#define MULTI_LAUNCH 0
#endif

typedef unsigned short bf16_t;
typedef short bf16x8 __attribute__((ext_vector_type(8)));
typedef short s16x4 __attribute__((ext_vector_type(4)));
typedef float f32x4 __attribute__((ext_vector_type(4)));
typedef float f32x2 __attribute__((ext_vector_type(2)));
typedef __bf16 bf2_t __attribute__((ext_vector_type(2)));
typedef unsigned u32x4 __attribute__((ext_vector_type(4)));
typedef unsigned u32x2 __attribute__((ext_vector_type(2)));
#define MK4(a,b,c,d) ((u32x4){(a),(b),(c),(d)})
#define MK2(a,b) ((u32x2){(a),(b)})

#define NROWS 33280
#define NLAT 32768
#define PW 3072
#define LOG2E 1.4426950408889634f
#define LDS_BYTES 73728

#define C_CQ 0
#define C_CKV 256
#define C_KR 384
#define C_RQ 416
#define C_RK 672
#define C_RV 928
#define C_RGF 1184
#define C_RGB 1440
#define C_NQ 1696
#define C_NK 1952
#define C_NV 2208
#define C_SQ 2464
#define C_SK 2720
#define C_SV 2848

#define WO_IN 0
#define WO_UQ 3145728
#define WO_UKV 3244032
#define WO_OUT 3309568
#define WO_13 4358144
#define WO_2 10125312
#define W_LAYER 13008896

struct Params {
  const float *x, *c, *ctx, *c_ctx, *ada_w, *ada_b, *norm1_g, *w_in, *mla_q_norm, *mla_w_uq, *mla_kv_norm, *mla_w_ukv,
      *ret_decay, *na_rpb, *swa_sink, *w_out, *norm2_g, *ffn_w1, *ffn_w3, *ffn_w2, *final_g;
  float* out;
  float* Y;
  bf16_t* ACT;
  bf16_t* P;
  bf16_t *Qm, *Km, *Vm;
  float* Ksum;
  bf16_t* St;
  bf16_t* W;
  float* mod;
  float* rope64;
  float* rope32;
  unsigned* bar;
};

__device__ __forceinline__ int otid() { int t = threadIdx.x; asm volatile("" : "+v"(t)); return t; }
typedef __amdgpu_buffer_rsrc_t rsrc_t;
__device__ __forceinline__ rsrc_t mkbuf(const void* base) { return __builtin_amdgcn_make_buffer_rsrc((void*)base, 0, 0x7fffffff, 0x00020000); }
__device__ __forceinline__ u32x4 bload16(rsrc_t r, unsigned voff, unsigned soff) { return __builtin_amdgcn_raw_buffer_load_b128(r, voff, soff, 0); }
__device__ __forceinline__ u32x2 bload8(rsrc_t r, unsigned voff, unsigned soff) { return __builtin_amdgcn_raw_buffer_load_b64(r, voff, soff, 0); }
__device__ __forceinline__ float bf2f(bf16_t h) { return __uint_as_float(((unsigned)h) << 16); }
__device__ __forceinline__ unsigned pack2(float a, float b) { f32x2 v = {a, b}; bf2_t r = __builtin_convertvector(v, bf2_t); return __builtin_bit_cast(unsigned, r); }
__device__ __forceinline__ bf16_t f2bf(float a) { return (bf16_t)(pack2(a, 0.f) & 0xffffu); }
__device__ __forceinline__ float lo_f(unsigned u) { return __uint_as_float(u << 16); }
__device__ __forceinline__ float hi_f(unsigned u) { return __uint_as_float(u & 0xffff0000u); }
__device__ __forceinline__ f32x4 mfma16(bf16x8 a, bf16x8 b, f32x4 c) { return __builtin_amdgcn_mfma_f32_16x16x32_bf16(a, b, c, 0, 0, 0); }
typedef __attribute__((address_space(3))) s16x4 lds_s16x4;
__device__ __forceinline__ s16x4 tr_read(const bf16_t* p) { return __builtin_amdgcn_ds_read_tr16_b64_v4i16((lds_s16x4*)p); }
__device__ __forceinline__ bf16x8 cat8(s16x4 a, s16x4 b) { bf16x8 r; r[0]=a[0]; r[1]=a[1]; r[2]=a[2]; r[3]=a[3]; r[4]=b[0]; r[5]=b[1]; r[6]=b[2]; r[7]=b[3]; return r; }
__device__ __forceinline__ float wave_sum(float v) {
  v += __shfl_xor(v, 32); v += __shfl_xor(v, 16); v += __shfl_xor(v, 8); v += __shfl_xor(v, 4); v += __shfl_xor(v, 2); v += __shfl_xor(v, 1); return v;
}
__device__ __forceinline__ float quad_max(float v) {
  unsigned b = __float_as_uint(v);
  u32x2 r = __builtin_amdgcn_permlane16_swap(b, b, false, false);
  v = fmaxf(__uint_as_float(r[0]), __uint_as_float(r[1]));
  b = __float_as_uint(v);
  r = __builtin_amdgcn_permlane32_swap(b, b, false, false);
  return fmaxf(__uint_as_float(r[0]), __uint_as_float(r[1]));
}
__device__ __forceinline__ float silu_f(float a) { return a * __builtin_amdgcn_rcpf(1.f + __expf(-a)); }

__device__ __forceinline__ float* xrow(const Params& p, int row) { return row < NLAT ? p.out + (size_t)row * 1024 : p.Y + (size_t)(row - NLAT) * 1024; }
__device__ __forceinline__ const float* xsrc(const Params& p, int l, int row) {
  if (l == 0) return row < NLAT ? p.x + (size_t)row * 1024 : p.ctx + (size_t)(row - NLAT) * 1024;
  return xrow(p, row);
}
__device__ __forceinline__ int modv(int row) { return row < 16384 ? 0 : (row < NLAT ? 1 : 2); }

__device__ void transpose_tile(const float* __restrict__ src, int N, int k0, int n0, bf16_t* __restrict__ dst, int ldd, int mode,
                               const float* __restrict__ kscale, char* lds) {
  bf16_t(*t)[66] = (bf16_t(*)[66])lds;
  const int tid = otid();
  __syncthreads();
#pragma unroll 4
  for (int i = 0; i < 16; ++i) {
    int kk = i * 4 + (tid >> 6), nn = tid & 63;
    float v = (n0 + nn < N) ? src[(size_t)(k0 + kk) * N + n0 + nn] : 0.f;
    if (kscale) v *= kscale[k0 + kk];
    t[kk][nn] = f2bf(v);
  }
  __syncthreads();
  int nn = tid >> 2, kq = tid & 3;
  int n = n0 + nn;
  if (n < N) {
    int row = mode == 0 ? n : ((n >> 4) * 32 + (n & 15) + (mode == 2 ? 16 : 0));
    unsigned w[8];
#pragma unroll
    for (int e = 0; e < 8; ++e) w[e] = (unsigned)t[kq * 16 + 2 * e][nn] | ((unsigned)t[kq * 16 + 2 * e + 1][nn] << 16);
    u32x4* d = (u32x4*)(dst + (size_t)row * ldd + k0 + kq * 16);
    d[0] = MK4(w[0], w[1], w[2], w[3]);
    d[1] = MK4(w[4], w[5], w[6], w[7]);
  }
}

__device__ void prologue_phase(const Params& p, int bid, int nb, char* lds) {
  const int tid = otid();
  for (int it = bid; it < 4 * 3160; it += nb) {
    int l = it / 3160, r = it % 3160;
    bf16_t* W = p.W + (size_t)l * W_LAYER;
    if (r < 752) { int kt = r / 47, nt = r % 47; transpose_tile(p.w_in + (size_t)l * 1024 * 2976, 2976, kt * 64, nt * 64, W + WO_IN, 1024, 0, nullptr, lds); continue; }
    r -= 752;
    if (r < 24) { int kt = r / 6, nt = r % 6; transpose_tile(p.mla_w_uq + (size_t)l * 256 * 384, 384, kt * 64, nt * 64, W + WO_UQ, 256, 0, p.mla_q_norm + l * 256, lds); continue; }
    r -= 24;
    if (r < 16) { int kt = r / 8, nt = r % 8; transpose_tile(p.mla_w_ukv + (size_t)l * 128 * 512, 512, kt * 64, nt * 64, W + WO_UKV, 128, 0, p.mla_kv_norm + l * 128, lds); continue; }
    r -= 16;
    if (r < 256) { int kt = r / 16, nt = r % 16; transpose_tile(p.w_out + (size_t)l * 1024 * 1024, 1024, kt * 64, nt * 64, W + WO_OUT, 1024, 0, nullptr, lds); continue; }
    r -= 256;
    if (r < 704) { int kt = r / 44, nt = r % 44; transpose_tile(p.ffn_w1 + (size_t)l * 1024 * 2816, 2816, kt * 64, nt * 64, W + WO_13, 1024, 1, nullptr, lds); continue; }
    r -= 704;
    if (r < 704) { int kt = r / 44, nt = r % 44; transpose_tile(p.ffn_w3 + (size_t)l * 1024 * 2816, 2816, kt * 64, nt * 64, W + WO_13, 1024, 2, nullptr, lds); continue; }
    r -= 704;
    { int kt = r / 16, nt = r % 16; transpose_tile(p.ffn_w2 + (size_t)l * 2816 * 1024, 1024, kt * 64, nt * 64, W + WO_2, 2816, 0, nullptr, lds); }
  }
  for (int it = bid; it < 4 * 48; it += nb) {
    int l = it / 48, part = it % 48;
    u32x4* d = (u32x4*)(p.W + (size_t)l * W_LAYER + WO_IN + (size_t)2976 * 1024);
    d[part * 256 + tid] = MK4(0, 0, 0, 0);
  }
  for (int it = bid; it < 4 * 96; it += nb) {
    int l = it / 96, cb = it % 96;
    float* s = (float*)lds;
    float* red = s + 3 * 1024;
    __syncthreads();
    for (int i = tid; i < 3072; i += 256) {
      int v = i >> 10, k = i & 1023;
      float cv = v < 2 ? p.c[v * 1024 + k] : p.c_ctx[k];
      s[i] = silu_f(cv);
    }
    __syncthreads();
    int col = cb * 64 + (tid & 63), kp = tid >> 6;
    const float* w = p.ada_w + (size_t)l * 1024 * 6144 + (size_t)(kp * 256) * 6144 + col;
    float a0 = 0.f, a1 = 0.f, a2 = 0.f;
#pragma unroll 8
    for (int k = 0; k < 256; ++k) {
      float wv = w[(size_t)k * 6144];
      a0 += s[kp * 256 + k] * wv; a1 += s[1024 + kp * 256 + k] * wv; a2 += s[2048 + kp * 256 + k] * wv;
    }
    red[(kp * 3 + 0) * 64 + (tid & 63)] = a0; red[(kp * 3 + 1) * 64 + (tid & 63)] = a1; red[(kp * 3 + 2) * 64 + (tid & 63)] = a2;
    __syncthreads();
    if (tid < 192) {
      int v = tid >> 6, cc = tid & 63;
      float sum = red[(0 * 3 + v) * 64 + cc] + red[(1 * 3 + v) * 64 + cc] + red[(2 * 3 + v) * 64 + cc] + red[(3 * 3 + v) * 64 + cc];
      p.mod[(size_t)(l * 3 + v) * 6144 + cb * 64 + cc] = sum + p.ada_b[l * 6144 + cb * 64 + cc];
    }
  }
  if (bid == (nb > 1 ? 1 : 0)) {
    int pos = tid;
    for (int i = 0; i < 16; ++i) {
      float inv = exp2f(-(float)(2 * i) / 32.f * 13.287712379549449f);
      float ang = (float)pos * inv;
      float n = rintf(ang * 0.15915494309189535f);
      float r = fmaf(-n, 6.28318548202514648f, ang); r = fmaf(-n, -1.74845553146951715e-07f, r);
      p.rope64[(pos * 16 + i) * 2] = cosf(r); p.rope64[(pos * 16 + i) * 2 + 1] = sinf(r);
    }
    for (int i = 0; i < 8; ++i) {
      float inv = exp2f(-(float)(2 * i) / 16.f * 13.287712379549449f);
      float ang = (float)pos * inv;
      float n = rintf(ang * 0.15915494309189535f);
      float r = fmaf(-n, 6.28318548202514648f, ang); r = fmaf(-n, -1.74845553146951715e-07f, r);
      p.rope32[(pos * 8 + i) * 2] = cosf(r); p.rope32[(pos * 8 + i) * 2 + 1] = sinf(r);
    }
  }
}

__device__ void norm_phase(const Params& p, int l, int which, int bid, int nb) {
  const int wave = otid() >> 6, lane = otid() & 63;
  const float* g = (which == 0 ? p.norm1_g : p.norm2_g) + l * 1024;
  for (int row = bid * 4 + wave; row < NROWS; row += nb * 4) {
    const float* src = which == 0 ? xsrc(p, l, row) : xrow(p, row);
    const float* md = p.mod + (size_t)(l * 3 + modv(row)) * 6144 + which * 3072;
    f32x4 v[4], g4[4], sh[4], sc[4]; float ss = 0.f;
#pragma unroll
    for (int i = 0; i < 4; ++i) {
      int col = i * 256 + lane * 4;
      v[i] = *(const f32x4*)(src + col); g4[i] = *(const f32x4*)(g + col); sh[i] = *(const f32x4*)(md + col); sc[i] = *(const f32x4*)(md + 1024 + col);
    }
#pragma unroll
    for (int i = 0; i < 4; ++i) ss += v[i][0] * v[i][0] + v[i][1] * v[i][1] + v[i][2] * v[i][2] + v[i][3] * v[i][3];
    ss = wave_sum(ss);
    float rinv = rsqrtf(ss * (1.f / 1024.f) + 1e-6f);
#pragma unroll
    for (int i = 0; i < 4; ++i) {
      int col = i * 256 + lane * 4;
      f32x4 y;
#pragma unroll
      for (int j = 0; j < 4; ++j) y[j] = (v[i][j] * rinv * g4[i][j]) * (1.f + sc[i][j]) + sh[i][j];
      *(u32x2*)(p.ACT + (size_t)row * 1024 + col) = MK2(pack2(y[0], y[1]), pack2(y[2], y[3]));
    }
  }
}

__device__ void final_norm_phase(const Params& p, int bid, int nb) {
  const int wave = otid() >> 6, lane = otid() & 63;
  for (int row = bid * 4 + wave; row < NLAT; row += nb * 4) {
    float* src = p.out + (size_t)row * 1024;
    f32x4 v[4]; float ss = 0.f;
#pragma unroll
    for (int i = 0; i < 4; ++i) { v[i] = *(const f32x4*)(src + i * 256 + lane * 4); ss += v[i][0] * v[i][0] + v[i][1] * v[i][1] + v[i][2] * v[i][2] + v[i][3] * v[i][3]; }
    ss = wave_sum(ss);
    float rinv = rsqrtf(ss * (1.f / 1024.f) + 1e-6f);
#pragma unroll
    for (int i = 0; i < 4; ++i) {
      int col = i * 256 + lane * 4;
      f32x4 g4 = *(const f32x4*)(p.final_g + col);
      f32x4 y;
#pragma unroll
      for (int j = 0; j < 4; ++j) y[j] = v[i][j] * rinv * g4[j];
      *(f32x4*)(src + col) = y;
    }
  }
}

#define GSTR 64
template <class Epi>
__device__ __forceinline__ void gemm_tile(const bf16_t* __restrict__ A, int lda, const bf16_t* __restrict__ Bt, int ldb, int K, int m0, int n0,
                                          const Epi& epi, char* lds) {
  bf16_t* As = (bf16_t*)lds;
  bf16_t* Bs = As + 2 * 128 * GSTR;
  const int tid = otid(), wave = tid >> 6, lane = tid & 63, wm = wave >> 1, wn = wave & 1, lr = lane & 15, quad = lane >> 4;
  const int lrow = tid >> 3, lch = tid & 7, wch = lch ^ (lrow & 7);
  rsrc_t gar = mkbuf(A + (size_t)m0 * lda), gbr = mkbuf(Bt + (size_t)n0 * ldb);
  unsigned aoff[4], boff[4];
#pragma unroll
  for (int i = 0; i < 4; ++i) { aoff[i] = (unsigned)((lrow + 32 * i) * lda + lch * 8) * 2u; boff[i] = (unsigned)((lrow + 32 * i) * ldb + lch * 8) * 2u; }
  u32x4 ra0[4], rb0[4], ra1[4], rb1[4];
  f32x4 acc[4][4];
#pragma unroll
  for (int i = 0; i < 4; ++i)
#pragma unroll
    for (int j = 0; j < 4; ++j) acc[i][j] = (f32x4){0.f, 0.f, 0.f, 0.f};
  const int nk = K >> 6;
#pragma unroll
  for (int i = 0; i < 4; ++i) { ra0[i] = bload16(gar, aoff[i], 0); rb0[i] = bload16(gbr, boff[i], 0); }
#pragma unroll
  for (int i = 0; i < 4; ++i) { ra1[i] = bload16(gar, aoff[i], 128u); rb1[i] = bload16(gbr, boff[i], 128u); }
  __syncthreads();
#pragma unroll
  for (int i = 0; i < 4; ++i) { *(u32x4*)(As + (lrow + 32 * i) * GSTR + wch * 8) = ra0[i]; *(u32x4*)(Bs + (lrow + 32 * i) * GSTR + wch * 8) = rb0[i]; }
  __syncthreads();
  const int rsw = (quad ^ (lr & 7)) * 8;
  const bf16_t* as0 = As + (wm * 64 + lr) * GSTR;
  const bf16_t* bs0 = Bs + (wn * 64 + lr) * GSTR;
#define GEMM_COMPUTE(BUF)                                                                                         \
  {                                                                                                               \
    const bf16_t* as = as0 + (BUF) * 128 * GSTR;                                                                  \
    const bf16_t* bs = bs0 + (BUF) * 128 * GSTR;                                                                  \
    _Pragma("unroll") for (int ks = 0; ks < 2; ++ks) {                                                            \
      bf16x8 af[4], bfr[4];                                                                                       \
      _Pragma("unroll") for (int i = 0; i < 4; ++i) {                                                             \
        af[i] = *(const bf16x8*)(as + i * 16 * GSTR + (rsw ^ (ks * 32)));                                         \
        bfr[i] = *(const bf16x8*)(bs + i * 16 * GSTR + (rsw ^ (ks * 32)));                                        \
      }                                                                                                           \
      _Pragma("unroll") for (int mi = 0; mi < 4; ++mi)                                                            \
        _Pragma("unroll") for (int ni = 0; ni < 4; ++ni) acc[mi][ni] = mfma16(bfr[ni], af[mi], acc[mi][ni]);      \
    }                                                                                                             \
  }
  for (int kt = 0; kt < nk; kt += 2) {
    if (kt + 2 < nk) {
      const unsigned so = (unsigned)(kt + 2) * 128u;
#pragma unroll
      for (int i = 0; i < 4; ++i) { ra0[i] = bload16(gar, aoff[i], so); rb0[i] = bload16(gbr, boff[i], so); }
    }
    GEMM_COMPUTE(0)
#pragma unroll
    for (int i = 0; i < 4; ++i) { *(u32x4*)(As + 128 * GSTR + (lrow + 32 * i) * GSTR + wch * 8) = ra1[i]; *(u32x4*)(Bs + 128 * GSTR + (lrow + 32 * i) * GSTR + wch * 8) = rb1[i]; }
    __syncthreads();
    if (kt + 3 < nk) {
      const unsigned so = (unsigned)(kt + 3) * 128u;
#pragma unroll
      for (int i = 0; i < 4; ++i) { ra1[i] = bload16(gar, aoff[i], so); rb1[i] = bload16(gbr, boff[i], so); }
    }
    GEMM_COMPUTE(1)
    if (kt + 2 < nk) {
#pragma unroll
      for (int i = 0; i < 4; ++i) { *(u32x4*)(As + (lrow + 32 * i) * GSTR + wch * 8) = ra0[i]; *(u32x4*)(Bs + (lrow + 32 * i) * GSTR + wch * 8) = rb0[i]; }
    }
    __syncthreads();
  }
#undef GEMM_COMPUTE
  epi(acc, m0 + wm * 64, n0 + wn * 64, lr, quad);
}

#define BSTG (256 * 32 + 128 * 32)
template <class Epi>
__device__ __forceinline__ void gemm_big_tile(const bf16_t* __restrict__ A, int lda, const bf16_t* __restrict__ Bt, int ldb, int K, int m0, int n0,
                                              const Epi& epi, char* lds) {
  bf16_t* L = (bf16_t*)lds;
  const int tid = otid(), wave = tid >> 6, lane = tid & 63, wm = wave >> 1, wn = wave & 1, lr = lane & 15, quad = lane >> 4;
  const int lrow = tid >> 2, lch = tid & 3;
  const int gsw = (0x1320 >> (((tid >> 4) & 3) * 4)) & 3;
  const int wpos = (lrow * 32 + ((lch ^ gsw) * 8));
  rsrc_t gar = mkbuf(A + (size_t)m0 * lda), gbr = mkbuf(Bt + (size_t)n0 * ldb);
  unsigned aoff[4], boff[2];
#pragma unroll
  for (int i = 0; i < 4; ++i) aoff[i] = (unsigned)((lrow + 64 * i) * lda + lch * 8) * 2u;
#pragma unroll
  for (int i = 0; i < 2; ++i) boff[i] = (unsigned)((lrow + 64 * i) * ldb + lch * 8) * 2u;
  u32x4 ra[4], rb[2];
  f32x4 acc[8][4];
#pragma unroll
  for (int i = 0; i < 8; ++i)
#pragma unroll
    for (int j = 0; j < 4; ++j) acc[i][j] = (f32x4){0.f, 0.f, 0.f, 0.f};
  const int nk = K >> 5;
#pragma unroll
  for (int i = 0; i < 4; ++i) ra[i] = bload16(gar, aoff[i], 0);
#pragma unroll
  for (int i = 0; i < 2; ++i) rb[i] = bload16(gbr, boff[i], 0);
  __syncthreads();
#pragma unroll
  for (int i = 0; i < 4; ++i) *(u32x4*)(L + wpos + i * 64 * 32) = ra[i];
#pragma unroll
  for (int i = 0; i < 2; ++i) *(u32x4*)(L + 256 * 32 + wpos + i * 64 * 32) = rb[i];
#pragma unroll
  for (int i = 0; i < 4; ++i) ra[i] = bload16(gar, aoff[i], 64u);
#pragma unroll
  for (int i = 0; i < 2; ++i) rb[i] = bload16(gbr, boff[i], 64u);
  __syncthreads();
  const int rsw = (quad ^ ((0x1320 >> (((lr >> 2) & 3) * 4)) & 3)) * 8;
  const bf16_t* as0 = L + (wm * 128 + lr) * 32 + rsw;
  const bf16_t* bs0 = L + 256 * 32 + (wn * 64 + lr) * 32 + rsw;
#pragma unroll 1
  for (int kt = 0; kt < nk; ++kt) {
    const int st = (kt & 1) * BSTG, nst = BSTG - st;
    bf16x8 af[8], bfr[4];
#pragma unroll
    for (int i = 0; i < 4; ++i) bfr[i] = *(const bf16x8*)(bs0 + st + i * 16 * 32);
#pragma unroll
    for (int i = 0; i < 8; ++i) af[i] = *(const bf16x8*)(as0 + st + i * 16 * 32);
#pragma unroll
    for (int mi = 0; mi < 4; ++mi)
#pragma unroll
      for (int ni = 0; ni < 4; ++ni) acc[mi][ni] = mfma16(bfr[ni], af[mi], acc[mi][ni]);
    if (kt + 1 < nk) {
#pragma unroll
      for (int i = 0; i < 4; ++i) *(u32x4*)(L + nst + wpos + i * 64 * 32) = ra[i];
#pragma unroll
      for (int i = 0; i < 2; ++i) *(u32x4*)(L + nst + 256 * 32 + wpos + i * 64 * 32) = rb[i];
    }
    if (kt + 2 < nk) {
      const unsigned so = (unsigned)(kt + 2) * 64u;
#pragma unroll
      for (int i = 0; i < 4; ++i) ra[i] = bload16(gar, aoff[i], so);
#pragma unroll
      for (int i = 0; i < 2; ++i) rb[i] = bload16(gbr, boff[i], so);
    }
#pragma unroll
    for (int mi = 4; mi < 8; ++mi)
#pragma unroll
      for (int ni = 0; ni < 4; ++ni) acc[mi][ni] = mfma16(bfr[ni], af[mi], acc[mi][ni]);
    __syncthreads();
  }
  epi(acc, m0 + wm * 128, n0 + wn * 64, lr, quad);
}
__device__ __forceinline__ void big_coord(int t, int nN, int& pm, int& pn) { int gsz = 4 * nN; int g = t / gsz, r = t % gsz; pm = g * 4 + (r & 3); pn = r >> 2; }

__device__ __forceinline__ void tile_coord(int t, int nN, int& pm, int& pn) {
  const int nM = 260, GM = 8;
  int gsz = GM * nN; int g = t / gsz, r = t % gsz; int fm = g * GM; int gm = min(GM, nM - fm);
  pm = fm + (r % gm); pn = r / gm;
}
__device__ __forceinline__ int xcd_tile(int round, int bid, int nb) { return round * nb + (bid & 7) * (nb >> 3) + (bid >> 3); }

struct EpiWin {
  bf16_t* P; const float* rope64;
  template <int NMI>
  __device__ __forceinline__ void operator()(f32x4 (&acc)[NMI][4], int mb, int nbs, int lr, int quad) const {
#pragma unroll
    for (int mi = 0; mi < NMI; ++mi) {
      const int row = mb + mi * 16 + lr;
      if (row < NLAT) {
        const int tok = row & 16383, prow = tok >> 6, pcol = tok & 63;
#pragma unroll
        for (int pp = 0; pp < 2; ++pp) {
          const int col0 = nbs + pp * 32;
          const bool seg = (col0 >= C_RQ && col0 < C_RV) || (col0 >= C_SQ && col0 < C_SV);
          if (seg) {
            const int pos = (col0 & 63) == 32 ? prow : pcol;
            const f32x4 cs0 = *(const f32x4*)(rope64 + (pos * 16 + quad * 4) * 2), cs1 = *(const f32x4*)(rope64 + (pos * 16 + quad * 4) * 2 + 4);
            const float cc[4] = {cs0[0], cs0[2], cs1[0], cs1[2]}, sn[4] = {cs0[1], cs0[3], cs1[1], cs1[3]};
#pragma unroll
            for (int j = 0; j < 4; ++j) {
              const float x1 = acc[mi][2 * pp][j], x2 = acc[mi][2 * pp + 1][j];
              acc[mi][2 * pp][j] = x1 * cc[j] - x2 * sn[j];
              acc[mi][2 * pp + 1][j] = x2 * cc[j] + x1 * sn[j];
            }
          }
        }
      }
      bf16_t* rp = P + (size_t)row * PW + nbs + quad * 4;
#pragma unroll
      for (int ni = 0; ni < 4; ++ni) *(u32x2*)(rp + ni * 16) = MK2(pack2(acc[mi][ni][0], acc[mi][ni][1]), pack2(acc[mi][ni][2], acc[mi][ni][3]));
    }
  }
};

struct EpiResid {
  const Params* p; int l; int goff; int use_src;
  template <int NMI>
  __device__ __forceinline__ void operator()(f32x4 (&acc)[NMI][4], int mb, int nbs, int lr, int quad) const {
#pragma unroll
    for (int mi = 0; mi < NMI; ++mi) {
      int row = mb + mi * 16 + lr;
      const float* gate = p->mod + (size_t)(l * 3 + modv(row)) * 6144 + goff;
      const float* src = use_src ? xsrc(*p, l, row) : xrow(*p, row);
      float* dst = xrow(*p, row);
#pragma unroll
      for (int ni = 0; ni < 4; ++ni) {
        int col = nbs + ni * 16 + quad * 4;
        f32x4 g4 = *(const f32x4*)(gate + col), x4 = *(const f32x4*)(src + col);
#pragma unroll
        for (int j = 0; j < 4; ++j) x4[j] += g4[j] * acc[mi][ni][j];
        *(f32x4*)(dst + col) = x4;
      }
    }
  }
};

struct EpiFfn1 {
  bf16_t* U;
  template <int NMI>
  __device__ __forceinline__ void operator()(f32x4 (&acc)[NMI][4], int mb, int nbs, int lr, int quad) const {
#pragma unroll
    for (int mi = 0; mi < NMI; ++mi) {
      int row = mb + mi * 16 + lr;
#pragma unroll
      for (int pr = 0; pr < 2; ++pr) {
        int ucol = ((nbs + pr * 32) >> 5) * 16 + quad * 4;
        float u[4];
#pragma unroll
        for (int j = 0; j < 4; ++j) u[j] = silu_f(acc[mi][2 * pr][j]) * acc[mi][2 * pr + 1][j];
        *(u32x2*)(U + (size_t)row * 2816 + ucol) = MK2(pack2(u[0], u[1]), pack2(u[2], u[3]));
      }
    }
  }
};

struct EpiUq {
  const Params* p;
  __device__ __forceinline__ void operator()(f32x4 (&acc)[4][4], int mb, int nbs, int lr, int quad) const {
#pragma unroll
    for (int mi = 0; mi < 4; ++mi) {
      int row = mb + mi * 16 + lr;
      const bf16_t* cq = p->P + (size_t)row * PW + C_CQ + quad * 64;
      float ss = 0.f;
#pragma unroll
      for (int i = 0; i < 8; ++i) {
        u32x4 w = *(const u32x4*)(cq + i * 8);
        float a;
        a = lo_f(w.x); ss += a * a; a = hi_f(w.x); ss += a * a; a = lo_f(w.y); ss += a * a; a = hi_f(w.y); ss += a * a;
        a = lo_f(w.z); ss += a * a; a = hi_f(w.z); ss += a * a; a = lo_f(w.w); ss += a * a; a = hi_f(w.w); ss += a * a;
      }
      ss += __shfl_xor(ss, 16); ss += __shfl_xor(ss, 32);
      float rinv = rsqrtf(ss * (1.f / 256.f) + 1e-6f);
      bool latent = row < NLAT;
      int tok = row & 16383, prow = tok >> 6, pcol = tok & 63;
#pragma unroll
      for (int ni = 0; ni < 4; ++ni) {
        int col = nbs + ni * 16 + quad * 4;
        int sub = ((nbs >> 4) + ni) % 6;
        float v[4];
#pragma unroll
        for (int j = 0; j < 4; ++j) v[j] = acc[mi][ni][j] * rinv;
        if (sub >= 4) {
          float o[4];
#pragma unroll
          for (int j = 0; j < 4; ++j) o[j] = __shfl_xor(v[j], 32);
          if (latent) {
            int pos = sub == 4 ? prow : pcol;
#pragma unroll
            for (int j = 0; j < 4; ++j) {
              int i = (quad & 1) * 4 + j;
              float cs = p->rope32[(pos * 8 + i) * 2], sn = p->rope32[(pos * 8 + i) * 2 + 1];
              v[j] = quad < 2 ? v[j] * cs - o[j] * sn : v[j] * cs + o[j] * sn;
            }
          }
        }
        *(u32x2*)(p->Qm + (size_t)row * 384 + col) = MK2(pack2(v[0], v[1]), pack2(v[2], v[3]));
      }
    }
  }
};

__device__ __forceinline__ void mla_key_of_row(int row, int& b, int& key) {
  if (row < NLAT) { b = row >> 14; key = row & 16383; } else { b = (row - NLAT) >> 8; key = 16384 + ((row - NLAT) & 255); }
}

struct EpiUkv {
  const Params* p;
  __device__ __forceinline__ void operator()(f32x4 (&acc)[4][4], int mb, int nbs, int lr, int quad) const {
    int h = nbs >> 7, isv = (nbs >> 6) & 1;
#pragma unroll
    for (int mi = 0; mi < 4; ++mi) {
      int row = mb + mi * 16 + lr;
      const bf16_t* ck = p->P + (size_t)row * PW + C_CKV + quad * 32;
      float ss = 0.f;
#pragma unroll
      for (int i = 0; i < 4; ++i) {
        u32x4 w = *(const u32x4*)(ck + i * 8);
        float a;
        a = lo_f(w.x); ss += a * a; a = hi_f(w.x); ss += a * a; a = lo_f(w.y); ss += a * a; a = hi_f(w.y); ss += a * a;
        a = lo_f(w.z); ss += a * a; a = hi_f(w.z); ss += a * a; a = lo_f(w.w); ss += a * a; a = hi_f(w.w); ss += a * a;
      }
      ss += __shfl_xor(ss, 16); ss += __shfl_xor(ss, 32);
      float rinv = rsqrtf(ss * (1.f / 128.f) + 1e-6f);
      int b, key; mla_key_of_row(row, b, key);
      size_t kidx = (size_t)(b * 4 + h) * 16640 + key;
      bf16_t* dst = isv ? p->Vm + kidx * 64 : p->Km + kidx * 96;
#pragma unroll
      for (int ni = 0; ni < 4; ++ni) {
        f32x4 a = acc[mi][ni];
        *(u32x2*)(dst + ni * 16 + quad * 4) = MK2(pack2(a[0] * rinv, a[1] * rinv), pack2(a[2] * rinv, a[3] * rinv));
      }
    }
  }
};

__device__ __forceinline__ void rope64_pair_vals(const bf16_t* base, int pr, int prow, int pcol, const float* rope64, bool rotate, float (&o1)[8], float (&o2)[8], int& c0) {
  c0 = pr < 2 ? pr : pr + 2;
  int pos = pr < 2 ? prow : pcol, i0 = (pr & 1) * 8;
  u32x4 a = *(const u32x4*)(base + c0 * 8), b = *(const u32x4*)(base + (c0 + 2) * 8);
  unsigned aw[4] = {a.x, a.y, a.z, a.w}, bw[4] = {b.x, b.y, b.z, b.w};
#pragma unroll
  for (int e = 0; e < 8; ++e) {
    float x1 = (e & 1) ? hi_f(aw[e >> 1]) : lo_f(aw[e >> 1]);
    float x2 = (e & 1) ? hi_f(bw[e >> 1]) : lo_f(bw[e >> 1]);
    if (rotate) {
      float cs = rope64[(pos * 16 + i0 + e) * 2], sn = rope64[(pos * 16 + i0 + e) * 2 + 1];
      o1[e] = x1 * cs - x2 * sn; o2[e] = x2 * cs + x1 * sn;
    } else { o1[e] = x1; o2[e] = x2; }
  }
}
__device__ __forceinline__ u32x4 pack8(const float (&o)[8]) { return MK4(pack2(o[0], o[1]), pack2(o[2], o[3]), pack2(o[4], o[5]), pack2(o[6], o[7])); }

#define VSTR 80
__device__ void ret_prep_item(const Params& p, int l, int c, int h, char* lds) {
  bf16_t* vL = (bf16_t*)lds;
  bf16_t* kfL = vL + 128 * VSTR;
  bf16_t* kbL = kfL + 128 * VSTR;
  const int tid = otid(), wave = tid >> 6, lane = tid & 63, lr = lane & 15, quad = lane >> 4;
  const bool latent = c < 256;
  const int r0 = c * 128;
  float df = p.ret_decay[l * 8 + h], db = p.ret_decay[l * 8 + 4 + h];
  float lgf = -log1pf(__expf(-df)) * LOG2E, lgb = -log1pf(__expf(-db)) * LOG2E;
  __syncthreads();
#pragma unroll
  for (int i = 0; i < 2; ++i) {
    int idx = tid + 256 * i, r = idx >> 2, pr = idx & 3;
    int row = r0 + r, tok = row & 16383, prow = tok >> 6, pcol = tok & 63;
    bf16_t* kb = p.P + (size_t)row * PW + C_RK + h * 64;
    float o1[8], o2[8]; int c0;
    rope64_pair_vals(kb, pr, prow, pcol, p.rope64, false, o1, o2, c0);
    float wf = exp2f(lgf * (float)(127 - r)) * 0.125f, wb = exp2f(lgb * (float)r) * 0.125f;
    float t1[8], t2[8];
#pragma unroll
    for (int e = 0; e < 8; ++e) { t1[e] = o1[e] * wf; t2[e] = o2[e] * wf; }
    *(u32x4*)(kfL + r * VSTR + c0 * 8) = pack8(t1); *(u32x4*)(kfL + r * VSTR + (c0 + 2) * 8) = pack8(t2);
#pragma unroll
    for (int e = 0; e < 8; ++e) { t1[e] = o1[e] * wb; t2[e] = o2[e] * wb; }
    *(u32x4*)(kbL + r * VSTR + c0 * 8) = pack8(t1); *(u32x4*)(kbL + r * VSTR + (c0 + 2) * 8) = pack8(t2);
  }
#pragma unroll
  for (int i = 0; i < 4; ++i) {
    int idx = tid + 256 * i, r = idx >> 3, ch = idx & 7;
    *(u32x4*)(vL + r * VSTR + ch * 8) = *(const u32x4*)(p.P + (size_t)(r0 + r) * PW + C_RV + h * 64 + ch * 8);
  }
  __syncthreads();
  f32x4 acc[2][4];
#pragma unroll
  for (int d = 0; d < 2; ++d)
#pragma unroll
    for (int j = 0; j < 4; ++j) acc[d][j] = (f32x4){0.f, 0.f, 0.f, 0.f};
  const int roff = (quad * 4 + (lr >> 2)) * VSTR + (lr & 3) * 4;
#pragma unroll
  for (int ks = 0; ks < 4; ++ks) {
    bf16x8 af = cat8(tr_read(vL + ks * 32 * VSTR + roff + wave * 16), tr_read(vL + (ks * 32 + 16) * VSTR + roff + wave * 16));
#pragma unroll
    for (int dt = 0; dt < 4; ++dt) {
      bf16x8 b0 = cat8(tr_read(kfL + ks * 32 * VSTR + roff + dt * 16), tr_read(kfL + (ks * 32 + 16) * VSTR + roff + dt * 16));
      acc[0][dt] = mfma16(af, b0, acc[0][dt]);
      bf16x8 b1 = cat8(tr_read(kbL + ks * 32 * VSTR + roff + dt * 16), tr_read(kbL + (ks * 32 + 16) * VSTR + roff + dt * 16));
      acc[1][dt] = mfma16(af, b1, acc[1][dt]);
    }
  }
#pragma unroll
  for (int dir = 0; dir < 2; ++dir) {
    float* ks = p.Ksum + ((size_t)(dir * 260 + c) * 4 + h) * 4096;
#pragma unroll
    for (int dt = 0; dt < 4; ++dt)
#pragma unroll
      for (int j = 0; j < 4; ++j) ks[(wave * 16 + quad * 4 + j) * 64 + dt * 16 + lr] = acc[dir][dt][j];
  }
}

__device__ void swa_rope_item(const Params& p, int mt) {
  const int tid = otid();
  for (int idx = tid; idx < 128 * 24; idx += 256) {
    int r = idx / 24, pp = idx % 24;
    int row = mt * 128 + r, tok = row & 16383, prow = tok >> 6, pcol = tok & 63;
    int hd = pp >> 2, pr = pp & 3;
    bf16_t* base = p.P + (size_t)row * PW + (hd < 4 ? C_SQ + hd * 64 : C_SK + (hd - 4) * 64);
    float o1[8], o2[8]; int c0;
    rope64_pair_vals(base, pr, prow, pcol, p.rope64, true, o1, o2, c0);
    *(u32x4*)(base + c0 * 8) = pack8(o1); *(u32x4*)(base + (c0 + 2) * 8) = pack8(o2);
  }
}

__device__ void mla_krope_item(const Params& p, int m0, int h) {
  const int tid = otid();
  int row = m0 + (tid >> 1), part = tid & 1;
  bool latent = row < NLAT;
  int tok = row & 16383, pos = part == 0 ? (tok >> 6) : (tok & 63);
  const bf16_t* src = p.P + (size_t)row * PW + C_KR + part * 16;
  u32x4 a = *(const u32x4*)src, b = *(const u32x4*)(src + 8);
  unsigned aw[4] = {a.x, a.y, a.z, a.w}, bw[4] = {b.x, b.y, b.z, b.w};
  float o1[8], o2[8];
#pragma unroll
  for (int e = 0; e < 8; ++e) {
    float x1 = (e & 1) ? hi_f(aw[e >> 1]) : lo_f(aw[e >> 1]);
    float x2 = (e & 1) ? hi_f(bw[e >> 1]) : lo_f(bw[e >> 1]);
    if (latent) {
      float cs = p.rope32[(pos * 8 + e) * 2], sn = p.rope32[(pos * 8 + e) * 2 + 1];
      o1[e] = x1 * cs - x2 * sn; o2[e] = x2 * cs + x1 * sn;
    } else { o1[e] = x1; o2[e] = x2; }
  }
  int b_, key; mla_key_of_row(row, b_, key);
  bf16_t* dst = p.Km + ((size_t)(b_ * 4 + h) * 16640 + key) * 96 + 64 + part * 16;
  *(u32x4*)dst = pack8(o1); *(u32x4*)(dst + 8) = pack8(o2);
}

struct KVT { const bf16_t* k; const bf16_t* v; };

template <int DQK, bool SOFTMAX, bool PLAIN, class TileFn, class MaskFn>
__device__ __forceinline__ void attn_core(const bf16x8 (&qf)[2][DQK / 32], int ntiles, const TileFn& tf, int ldk, int ldv, const MaskFn& mk,
                                          f32x4 (&o)[4][2], float (&m)[2], float (&l)[2], char* lds) {
  constexpr int KSTR = DQK + 16, NKS = DQK / 32, KCH = DQK / 8, NKL = (64 * KCH) / 256;
  bf16_t* Kl = (bf16_t*)lds;
  bf16_t* Vl = Kl + 2 * 64 * KSTR;
  const int tid = otid(), wave = tid >> 6, lane = tid & 63, lr = lane & 15, quad = lane >> 4;
  constexpr bool MFMA_SUM = SOFTMAX && PLAIN;
  f32x4 lacc[2] = {(f32x4){0.f, 0.f, 0.f, 0.f}, (f32x4){0.f, 0.f, 0.f, 0.f}};
  u32x4 rk[NKL], rv[2];
  unsigned koff[NKL], voff[2];
#pragma unroll
  for (int i = 0; i < NKL; ++i) { int c = tid + i * 256, r = c / KCH, ch = c % KCH; koff[i] = (unsigned)(r * ldk + ch * 8) * 2u; }
#pragma unroll
  for (int i = 0; i < 2; ++i) { int c = tid + i * 256, r = c >> 3, ch = c & 7; voff[i] = (unsigned)(r * ldv + ch * 8) * 2u; }
  __syncthreads();
  {
    KVT kv = tf(0);
    rsrc_t kr = mkbuf(kv.k), vr = mkbuf(kv.v);
#pragma unroll
    for (int i = 0; i < NKL; ++i) rk[i] = bload16(kr, koff[i], 0);
#pragma unroll
    for (int i = 0; i < 2; ++i) rv[i] = bload16(vr, voff[i], 0);
#pragma unroll
    for (int i = 0; i < NKL; ++i) { int c = tid + i * 256, r = c / KCH, ch = c % KCH; *(u32x4*)(Kl + r * KSTR + ch * 8) = rk[i]; }
#pragma unroll
    for (int i = 0; i < 2; ++i) { int c = tid + i * 256, r = c >> 3, ch = c & 7; *(u32x4*)(Vl + r * VSTR + ch * 8) = rv[i]; }
  }
  __syncthreads();
  for (int t = 0; t < ntiles; ++t) {
    const int cur = t & 1;
    if (t + 1 < ntiles) {
      KVT kv = tf(t + 1);
      rsrc_t kr = mkbuf(kv.k), vr = mkbuf(kv.v);
#pragma unroll
      for (int i = 0; i < NKL; ++i) rk[i] = bload16(kr, koff[i], 0);
#pragma unroll
      for (int i = 0; i < 2; ++i) rv[i] = bload16(vr, voff[i], 0);
    }
    f32x4 s[4][2];
#pragma unroll
    for (int kt = 0; kt < 4; ++kt) { s[kt][0] = (f32x4){0.f, 0.f, 0.f, 0.f}; s[kt][1] = (f32x4){0.f, 0.f, 0.f, 0.f}; }
    const bf16_t* kb = Kl + cur * 64 * KSTR + lr * KSTR + quad * 8;
    {
      bf16x8 kfa[NKS][4];
#pragma unroll
      for (int ks = 0; ks < NKS; ++ks)
#pragma unroll
        for (int kt = 0; kt < 4; ++kt) kfa[ks][kt] = *(const bf16x8*)(kb + kt * 16 * KSTR + ks * 32);
#pragma unroll
      for (int ks = 0; ks < NKS; ++ks)
#pragma unroll
        for (int kt = 0; kt < 4; ++kt) {
          s[kt][0] = mfma16(kfa[ks][kt], qf[0][ks], s[kt][0]);
          s[kt][1] = mfma16(kfa[ks][kt], qf[1][ks], s[kt][1]);
        }
    }
    if (!PLAIN) {
#pragma unroll
      for (int kt = 0; kt < 4; ++kt)
#pragma unroll
        for (int qt = 0; qt < 2; ++qt)
#pragma unroll
          for (int j = 0; j < 4; ++j) s[kt][qt][j] = mk(t, wave * 32 + qt * 16 + lr, kt * 16 + quad * 4 + j, s[kt][qt][j]);
    }
    if (SOFTMAX) {
      const float sl2 = PLAIN ? mk(0, 0, 0, 1.0f) : 1.0f;
      float mnew[2], alpha[2];
#pragma unroll
      for (int qt = 0; qt < 2; ++qt) {
        float mx = fmaxf(fmaxf(s[0][qt][0], s[0][qt][1]), fmaxf(s[0][qt][2], s[0][qt][3]));
#pragma unroll
        for (int kt = 1; kt < 4; ++kt) mx = fmaxf(fmaxf(mx, s[kt][qt][0]), fmaxf(fmaxf(s[kt][qt][1], s[kt][qt][2]), s[kt][qt][3]));
        mx = quad_max(mx);
        if (PLAIN) mx *= sl2;
        mnew[qt] = fmaxf(m[qt], mx);
        alpha[qt] = __builtin_amdgcn_exp2f(m[qt] - mnew[qt]);
        m[qt] = mnew[qt];
      }
      if (__any((alpha[0] < 1.f) | (alpha[1] < 1.f))) {
#pragma unroll
        for (int qt = 0; qt < 2; ++qt) {
          l[qt] *= alpha[qt];
          if (MFMA_SUM) { lacc[qt][0] *= alpha[qt]; lacc[qt][1] *= alpha[qt]; lacc[qt][2] *= alpha[qt]; lacc[qt][3] *= alpha[qt]; }
#pragma unroll
          for (int dt = 0; dt < 4; ++dt)
#pragma unroll
            for (int j = 0; j < 4; ++j) o[dt][qt][j] *= alpha[qt];
        }
      }
#pragma unroll
      for (int qt = 0; qt < 2; ++qt) {
        float ls = 0.f;
        const float nm = -mnew[qt];
#pragma unroll
        for (int kt = 0; kt < 4; ++kt)
#pragma unroll
          for (int j = 0; j < 4; ++j) {
            float pv = __builtin_amdgcn_exp2f(PLAIN ? fmaf(s[kt][qt][j], sl2, nm) : s[kt][qt][j] + nm);
            s[kt][qt][j] = pv; if (!MFMA_SUM) ls += pv;
          }
        if (!MFMA_SUM) l[qt] += ls;
      }
    }
    bf16x8 pf[2][2];
#pragma unroll
    for (int qt = 0; qt < 2; ++qt)
#pragma unroll
      for (int kk = 0; kk < 2; ++kk) {
        unsigned w0 = pack2(s[2 * kk][qt][0], s[2 * kk][qt][1]), w1 = pack2(s[2 * kk][qt][2], s[2 * kk][qt][3]);
        unsigned w2 = pack2(s[2 * kk + 1][qt][0], s[2 * kk + 1][qt][1]), w3 = pack2(s[2 * kk + 1][qt][2], s[2 * kk + 1][qt][3]);
        u32x4 u = MK4(w0, w1, w2, w3);
        pf[qt][kk] = __builtin_bit_cast(bf16x8, u);
      }
    const bf16_t* vb = Vl + cur * 64 * VSTR + (quad * 4 + (lr >> 2)) * VSTR + (lr & 3) * 4;
    {
      bf16x8 vfa[2][4];
#pragma unroll
      for (int kk = 0; kk < 2; ++kk)
#pragma unroll
        for (int dt = 0; dt < 4; ++dt) vfa[kk][dt] = cat8(tr_read(vb + (kk * 32) * VSTR + dt * 16), tr_read(vb + (kk * 32 + 16) * VSTR + dt * 16));
#pragma unroll
      for (int kk = 0; kk < 2; ++kk)
#pragma unroll
        for (int dt = 0; dt < 4; ++dt) {
          o[dt][0] = mfma16(vfa[kk][dt], pf[0][kk], o[dt][0]);
          o[dt][1] = mfma16(vfa[kk][dt], pf[1][kk], o[dt][1]);
        }
      if (MFMA_SUM) {
        const bf16x8 ones = {(short)0x3f80, (short)0x3f80, (short)0x3f80, (short)0x3f80, (short)0x3f80, (short)0x3f80, (short)0x3f80, (short)0x3f80};
#pragma unroll
        for (int kk = 0; kk < 2; ++kk) { lacc[0] = mfma16(ones, pf[0][kk], lacc[0]); lacc[1] = mfma16(ones, pf[1][kk], lacc[1]); }
      }
    }
    if (t + 1 < ntiles) {
      const int nx = cur ^ 1;
#pragma unroll
      for (int i = 0; i < NKL; ++i) { int c = tid + i * 256, r = c / KCH, ch = c % KCH; *(u32x4*)(Kl + nx * 64 * KSTR + r * KSTR + ch * 8) = rk[i]; }
#pragma unroll
      for (int i = 0; i < 2; ++i) { int c = tid + i * 256, r = c >> 3, ch = c & 7; *(u32x4*)(Vl + nx * 64 * VSTR + r * VSTR + ch * 8) = rv[i]; }
    }
    __syncthreads();
  }
  if (MFMA_SUM) { const int quad_ = (otid() & 63) >> 4; l[0] = quad_ == 0 ? lacc[0][0] : 0.f; l[1] = quad_ == 0 ? lacc[1][0] : 0.f; }
}

__device__ __forceinline__ void attn_store(f32x4 (&o)[4][2], float (&m)[2], float (&l)[2], bool has_sink, float sink_l2, bf16_t* dst  , int ldo) {
  const int lane = otid() & 63, wave = otid() >> 6, lr = lane & 15, quad = lane >> 4;
#pragma unroll
  for (int qt = 0; qt < 2; ++qt) {
    float lt = l[qt]; lt += __shfl_xor(lt, 16); lt += __shfl_xor(lt, 32);
    if (has_sink) lt += exp2f(sink_l2 - m[qt]);
    float inv = 1.f / lt;
    bf16_t* rp = dst + (size_t)(wave * 32 + qt * 16 + lr) * ldo + quad * 4;
#pragma unroll
    for (int dt = 0; dt < 4; ++dt)
      *(u32x2*)(rp + dt * 16) = MK2(pack2(o[dt][qt][0] * inv, o[dt][qt][1] * inv), pack2(o[dt][qt][2] * inv, o[dt][qt][3] * inv));
  }
}

template <int NKS>
__device__ __forceinline__ void load_q(bf16x8 (&qf)[2][NKS], const bf16_t* q  , int ldq) {
  const int lane = otid() & 63, wave = otid() >> 6, lr = lane & 15, quad = lane >> 4;
#pragma unroll
  for (int qt = 0; qt < 2; ++qt)
#pragma unroll
    for (int ks = 0; ks < NKS; ++ks) qf[qt][ks] = *(const bf16x8*)(q + (size_t)(wave * 32 + qt * 16 + lr) * ldq + ks * 32 + quad * 8);
}

struct TileContig { const bf16_t* k; const bf16_t* v; size_t ks, vs;
  __device__ __forceinline__ KVT operator()(int t) const { return KVT{k + (size_t)t * ks, v + (size_t)t * vs}; } };
struct MaskScale { float sl2; __device__ __forceinline__ float operator()(int, int, int, float s) const { return s * sl2; } };

__device__ void mla_item(const Params& p, int b, int h, int qt128, bool ctxq, char* lds) {
  int r0 = ctxq ? NLAT + b * 256 + qt128 * 128 : b * 16384 + qt128 * 128;
  bf16x8 qf[2][3];
  load_q<3>(qf, p.Qm + (size_t)r0 * 384 + h * 96, 384);
  f32x4 o[4][2]; float m[2] = {-1e30f, -1e30f}, l[2] = {0.f, 0.f};
#pragma unroll
  for (int dt = 0; dt < 4; ++dt) { o[dt][0] = (f32x4){0.f, 0.f, 0.f, 0.f}; o[dt][1] = (f32x4){0.f, 0.f, 0.f, 0.f}; }
  int t0 = ctxq ? 256 : 0, nt = ctxq ? 4 : 260;
  size_t kbase = (size_t)(b * 4 + h) * 16640 + (size_t)t0 * 64;
  TileContig tf{p.Km + kbase * 96, p.Vm + kbase * 64, (size_t)64 * 96, (size_t)64 * 64};
  MaskScale mk{0.10206207261596575f * LOG2E};
  attn_core<96, true, true>(qf, nt, tf, 96, 64, mk, o, m, l, lds);
  attn_store(o, m, l, false, 0.f, p.ACT + (size_t)r0 * 1024 + h * 64, 1024);
}

struct NaTiles { const bf16_t* P; int b, h, lo, nw;
  __device__ __forceinline__ KVT operator()(int t) const {
    size_t row = t < nw ? (size_t)b * 16384 + (size_t)(lo + t) * 64 : (size_t)NLAT + b * 256 + (size_t)(t - nw) * 64;
    return KVT{P + row * PW + C_NK + h * 64, P + row * PW + C_NV + h * 64}; } };
struct NaMask { const float* rpb; int nw, lo, qr0; float sl2;
  __device__ __forceinline__ float operator()(int t, int qi, int kj, float s) const {
    if (t >= nw) return s * sl2;
    int qr = qr0 + (qi >> 6), qc = qi & 63, kr = lo + t;
    int r0q = min(max(qr - 4, 0), 248), c0 = min(max(qc - 8, 0), 48);
    bool ok = (kr >= r0q) & (kr < r0q + 8) & (kj >= c0) & (kj < c0 + 16);
    int dr = min(max(kr - qr + 7, 0), 14), dc = min(max(kj - qc, -15), 15) + 15;
    float bias = rpb[dr * 31 + dc];
    return ok ? s * sl2 + bias * LOG2E : -INFINITY; } };

__device__ void na_item(const Params& p, int l, int b, int h, int pair, char* lds) {
  float* rpbL = (float*)(lds + 60000);
  __syncthreads();
  for (int i = otid(); i < 465; i += 256) rpbL[i] = p.na_rpb[(size_t)(l * 4 + h) * 465 + i];
  int r0 = b * 16384 + pair * 128;
  bf16x8 qf[2][2];
  load_q<2>(qf, p.P + (size_t)r0 * PW + C_NQ + h * 64, PW);
  f32x4 o[4][2]; float m[2] = {-1e30f, -1e30f}, ls[2] = {0.f, 0.f};
#pragma unroll
  for (int dt = 0; dt < 4; ++dt) { o[dt][0] = (f32x4){0.f, 0.f, 0.f, 0.f}; o[dt][1] = (f32x4){0.f, 0.f, 0.f, 0.f}; }
  int qr0 = pair * 2;
  int lo = min(max(qr0 - 4, 0), 248), hi = min(max(qr0 + 1 - 4, 0), 248) + 7;
  int nw = hi - lo + 1;
  NaTiles tf{p.P, b, h, lo, nw};
  NaMask mk{rpbL, nw, lo, qr0, 0.125f * LOG2E};
  attn_core<64, true, false>(qf, nw + 4, tf, PW, PW, mk, o, m, ls, lds);
  attn_store(o, m, ls, false, 0.f, p.ACT + (size_t)r0 * 1024 + 512 + h * 64, 1024);
}

struct SwaTiles { const bf16_t* P; int b, kvh, nlo, nwt;
  __device__ __forceinline__ KVT operator()(int t) const {
    size_t row = t < nwt ? (size_t)b * 16384 + (size_t)(nlo * 128 + t * 64) : (size_t)NLAT + b * 256 + (size_t)(t - nwt) * 64;
    return KVT{P + row * PW + C_SK + kvh * 64, P + row * PW + C_SV + kvh * 64}; } };
struct SwaMask { int nwt, koff  ; float sl2;
  __device__ __forceinline__ float operator()(int t, int qi, int kj, float s) const {
    if (t >= nwt) return s * sl2;
    int delta = koff + t * 64 + kj - qi;
    return (delta <= 128 && delta >= -128) ? s * sl2 : -INFINITY; } };

__device__ void swa_item(const Params& p, int l, int b, int hq, int n, bool ctxq, char* lds) {
  int r0 = ctxq ? NLAT + b * 256 + n * 128 : b * 16384 + n * 128;
  bf16x8 qf[2][2];
  load_q<2>(qf, p.P + (size_t)r0 * PW + C_SQ + hq * 64, PW);
  f32x4 o[4][2]; float m[2] = {-1e30f, -1e30f}, ls[2] = {0.f, 0.f};
#pragma unroll
  for (int dt = 0; dt < 4; ++dt) { o[dt][0] = (f32x4){0.f, 0.f, 0.f, 0.f}; o[dt][1] = (f32x4){0.f, 0.f, 0.f, 0.f}; }
  int nlo = 0, nwt = 0;
  if (!ctxq) { nlo = max(n - 1, 0); int nhi = min(n + 1, 127); nwt = (nhi - nlo + 1) * 2; }
  SwaTiles tf{p.P, b, hq >> 1, nlo, nwt};
  SwaMask mk{nwt, (nlo - n) * 128, 0.125f * LOG2E};
  attn_core<64, true, false>(qf, nwt + 4, tf, PW, PW, mk, o, m, ls, lds);
  float sink = p.swa_sink[l * 4 + hq] * LOG2E;
  attn_store(o, m, ls, true, sink, p.ACT + (size_t)r0 * 1024 + 768 + hq * 64, 1024);
}

__device__ void na_ctx_item(const Params& p, int b, int h, int n, char* lds) {
  int r0 = NLAT + b * 256 + n * 128;
  bf16x8 qf[2][2];
  load_q<2>(qf, p.P + (size_t)r0 * PW + C_NQ + h * 64, PW);
  f32x4 o[4][2]; float m[2] = {-1e30f, -1e30f}, ls[2] = {0.f, 0.f};
#pragma unroll
  for (int dt = 0; dt < 4; ++dt) { o[dt][0] = (f32x4){0.f, 0.f, 0.f, 0.f}; o[dt][1] = (f32x4){0.f, 0.f, 0.f, 0.f}; }
  NaTiles tf{p.P, b, h, 0, 0};
  MaskScale mk{0.125f * LOG2E};
  attn_core<64, true, true>(qf, 4, tf, PW, PW, mk, o, m, ls, lds);
  attn_store(o, m, ls, false, 0.f, p.ACT + (size_t)r0 * 1024 + 512 + h * 64, 1024);
}

__device__ void ret_scan_item(const Params& p, int l, int combo, int part) {
  int dir = combo >> 3, b = (combo >> 2) & 1, h = combo & 3;
  float d = p.ret_decay[l * 8 + dir * 4 + h];
  float lg = -log1pf(__expf(-d)) * LOG2E;
  float gC = exp2f(lg * 128.f);
  int idx = part * 1024 + otid() * 4;
  f32x4 S = (f32x4){0.f, 0.f, 0.f, 0.f};
  const size_t dbase = ((size_t)dir * 260 * 4 + h) * 4096 + idx;
#pragma unroll 1
  for (int s0 = 0; s0 < 130; s0 += 13) {
    f32x4 kv[13]; int ch[13];
#pragma unroll
    for (int u = 0; u < 13; ++u) {
      int step = s0 + u;
      if (dir == 0) ch[u] = step < 2 ? 256 + 2 * b + step : b * 128 + (step - 2);
      else ch[u] = step < 2 ? 256 + 2 * b + 1 - step : b * 128 + 127 - (step - 2);
      kv[u] = *(const f32x4*)(p.Ksum + dbase + (size_t)ch[u] * 16384);
    }
#pragma unroll
    for (int u = 0; u < 13; ++u) {
      *(u32x2*)(p.St + dbase + (size_t)ch[u] * 16384) = MK2(pack2(S[0], S[1]), pack2(S[2], S[3]));
#pragma unroll
      for (int j = 0; j < 4; ++j) S[j] = S[j] * gC + kv[u][j];
    }
  }
}

struct RetMask { float lg; int dir;
  __device__ __forceinline__ float operator()(int t, int qi, int kj, float s) const {
    int j = t * 64 + kj; int df = dir == 0 ? qi - j : j - qi;
    return df >= 0 ? s * 0.125f * __builtin_amdgcn_exp2f(lg * (float)df) : 0.f; } };

__device__ void ret_out_item(const Params& p, int l, int c, int h, char* lds) {
  const int lane = otid() & 63, wave = otid() >> 6, lr = lane & 15, quad = lane >> 4;
  int r0 = c * 128;
  bf16x8 qf[2][2];
  load_q<2>(qf, p.P + (size_t)r0 * PW + C_RQ + h * 64, PW);
  f32x4 res[4][2];
#pragma unroll
  for (int dt = 0; dt < 4; ++dt) { res[dt][0] = (f32x4){0.f, 0.f, 0.f, 0.f}; res[dt][1] = (f32x4){0.f, 0.f, 0.f, 0.f}; }
  TileContig tf{p.P + (size_t)r0 * PW + C_RK + h * 64, p.P + (size_t)r0 * PW + C_RV + h * 64, (size_t)64 * PW, (size_t)64 * PW};
#pragma unroll 1
  for (int dir = 0; dir < 2; ++dir) {
    float d = p.ret_decay[l * 8 + dir * 4 + h];
    float lg = -log1pf(__expf(-d)) * LOG2E;
    f32x4 o[4][2]; float m[2] = {0.f, 0.f}, ls[2] = {0.f, 0.f};
#pragma unroll
    for (int dt = 0; dt < 4; ++dt) { o[dt][0] = (f32x4){0.f, 0.f, 0.f, 0.f}; o[dt][1] = (f32x4){0.f, 0.f, 0.f, 0.f}; }
    rsrc_t str = mkbuf(p.St + ((size_t)(dir * 260 + c) * 4 + h) * 4096);
#pragma unroll
    for (int ks = 0; ks < 2; ++ks)
#pragma unroll
      for (int et = 0; et < 4; ++et) {
        bf16x8 af = __builtin_bit_cast(bf16x8, bload16(str, (unsigned)(lr * 64 + quad * 8) * 2u, (unsigned)(et * 16 * 64 + ks * 32) * 2u));
        o[et][0] = mfma16(af, qf[0][ks], o[et][0]);
        o[et][1] = mfma16(af, qf[1][ks], o[et][1]);
      }
#pragma unroll
    for (int qt = 0; qt < 2; ++qt) {
      int i = wave * 32 + qt * 16 + lr;
      float qdec = exp2f(lg * (float)(dir == 0 ? i + 1 : 128 - i));
#pragma unroll
      for (int et = 0; et < 4; ++et)
#pragma unroll
        for (int j = 0; j < 4; ++j) o[et][qt][j] *= qdec;
    }
    __builtin_amdgcn_sched_barrier(0);
    RetMask mk{lg, dir};
    attn_core<64, false, false>(qf, 2, tf, PW, PW, mk, o, m, ls, lds);
    __builtin_amdgcn_sched_barrier(0);
#pragma unroll
    for (int qt = 0; qt < 2; ++qt) {
      int i = wave * 32 + qt * 16 + lr;
      float ss = 0.f;
#pragma unroll
      for (int et = 0; et < 4; ++et)
#pragma unroll
        for (int j = 0; j < 4; ++j) { float v = o[et][qt][j]; ss += v * v; }
      ss += __shfl_xor(ss, 16); ss += __shfl_xor(ss, 32);
      float rinv = rsqrtf(ss * (1.f / 64.f) + 1e-6f);
      rsrc_t gpr = mkbuf(p.P + (size_t)r0 * PW + (dir == 0 ? C_RGF : C_RGB) + h * 64);
      unsigned goff = (unsigned)(i * PW + quad * 4) * 2u;
#pragma unroll
      for (int et = 0; et < 4; ++et) {
        u32x2 gw = bload8(gpr, goff, et * 32);
        float g0 = lo_f(gw.x), g1 = hi_f(gw.x), g2 = lo_f(gw.y), g3 = hi_f(gw.y);
        res[et][qt][0] += o[et][qt][0] * rinv * silu_f(g0);
        res[et][qt][1] += o[et][qt][1] * rinv * silu_f(g1);
        res[et][qt][2] += o[et][qt][2] * rinv * silu_f(g2);
        res[et][qt][3] += o[et][qt][3] * rinv * silu_f(g3);
      }
    }
  }
#pragma unroll
  for (int qt = 0; qt < 2; ++qt) {
    bf16_t* rp = p.ACT + (size_t)(r0 + wave * 32 + qt * 16 + lr) * 1024 + 256 + h * 64 + quad * 4;
#pragma unroll
    for (int et = 0; et < 4; ++et)
      *(u32x2*)(rp + et * 16) = MK2(pack2(res[et][qt][0], res[et][qt][1]), pack2(res[et][qt][2], res[et][qt][3]));
  }
}


#define XB_TMO      128
#define XB_XCNT(j)  (256  + 64 * (j))
#define XB_XSUB(j)  (1280 + 64 * (j))
#define XB_XGEN(j)  (2304 + 64 * (j))
#define XB_TOP      3328
#define XB_TOPGEN   3392
#define XCD_BAR_WORDS 3456
#define XB_SPIN_CAP (1u << 20)
#define LAS __attribute__((address_space(3)))
__device__ __forceinline__ unsigned xb_ld(unsigned* p)              { return __hip_atomic_load(p, __ATOMIC_RELAXED, __HIP_MEMORY_SCOPE_AGENT); }
__device__ __forceinline__ unsigned xb_add(unsigned* p, unsigned v) { return __hip_atomic_fetch_add(p, v, __ATOMIC_RELAXED, __HIP_MEMORY_SCOPE_AGENT); }
__device__ __forceinline__ unsigned xb_xcc_id() { return (unsigned)__builtin_amdgcn_s_getreg((3 << 11) | 20) & 0xFu; }
#define XB_SPIN(cond, bar) do { unsigned _sp = 0; while (cond) { __builtin_amdgcn_s_sleep(1); \
    if ((++_sp & 255u) == 0u) { if (xb_ld(&(bar)[XB_TMO])) break; if (_sp > XB_SPIN_CAP) { atomicAdd(&(bar)[XB_TMO], 1u); break; } } } } while (0)
struct XcdBarrier { unsigned* bar; unsigned x; volatile LAS unsigned* st; };
__device__ __forceinline__ XcdBarrier xcd_barrier_post(unsigned* bar, volatile LAS unsigned* st) {
    XcdBarrier b; b.bar = bar; b.x = xb_xcc_id(); b.st = st;
    if (threadIdx.x == 0) (void)xb_add(&bar[XB_XCNT(b.x)], 1u);
    return b;
}
__device__ __forceinline__ void xcd_barrier_complete(unsigned* bar, unsigned x, unsigned& nloc, unsigned& nx) {
    const unsigned G = gridDim.x * gridDim.y * gridDim.z;
    unsigned sum, cnt, mine, sp = 0u;
    for (;;) {
        sum = 0u; cnt = 0u; mine = 0u;
#pragma unroll
        for (unsigned j = 0; j < 16; ++j) { const unsigned c = xb_ld(&bar[XB_XCNT(j)]); sum += c; cnt += (c > 0u) ? 1u : 0u; mine = (j == x) ? c : mine; }
        if (sum == G) break;
        __builtin_amdgcn_s_sleep(1);
        if ((++sp & 255u) == 0u) { if (xb_ld(&bar[XB_TMO])) break; if (sp > XB_SPIN_CAP) { atomicAdd(&bar[XB_TMO], 1u); break; } }
    }
    nloc = mine > 0u ? mine : 1u; nx = cnt > 0u ? cnt : 1u;
}
__device__ __forceinline__ void xcd_barrier(const XcdBarrier& b) {
    asm volatile("s_waitcnt vmcnt(0)" ::: "memory");
    __syncthreads();
    if (threadIdx.x == 0) {
        unsigned* bar = b.bar;
        __builtin_amdgcn_s_waitcnt(0);
        unsigned nloc = b.st[0], nx = b.st[1];
        if (nloc == 0u) { xcd_barrier_complete(bar, b.x, nloc, nx); b.st[0] = nloc; b.st[1] = nx; }
        const unsigned old = xb_add(&bar[XB_XSUB(b.x)], 1u);
        const unsigned gen = old / nloc;
        if (old + 1u == (gen + 1u) * nloc) {
            __builtin_amdgcn_fence(__ATOMIC_RELEASE, "agent");
            asm volatile("s_waitcnt vmcnt(0)" ::: "memory");
            const unsigned og = xb_add(&bar[XB_TOP], 1u);
            const unsigned tg = og / nx;
            if (og + 1u == (tg + 1u) * nx) xb_add(&bar[XB_TOPGEN], 1u);
            else XB_SPIN(xb_ld(&bar[XB_TOPGEN]) == tg, bar);
            __builtin_amdgcn_fence(__ATOMIC_ACQUIRE, "agent");
            xb_add(&bar[XB_XGEN(b.x)], 1u);
            asm volatile("s_waitcnt vmcnt(0)" ::: "memory");
        } else {
            XB_SPIN(xb_ld(&bar[XB_XGEN(b.x)]) == gen, bar);
            __builtin_amdgcn_fence(__ATOMIC_ACQUIRE, "agent");
            asm volatile("s_waitcnt vmcnt(0)" ::: "memory");
        }
    }
    __syncthreads();
}

__device__ void run_phase(const Params& p, int ph, int bid, int nb, char* lds) {
#ifndef CM
#define CM 0xff
#endif
#ifndef PH_MASK
#define PH_MASK 0xfffff
#endif
  if (ph == 0) { if (PH_MASK & (1<<9)) prologue_phase(p, bid, nb, lds); return; }
  if (ph == 37) { if (PH_MASK & (1<<10)) final_norm_phase(p, bid, nb); return; }
  const int l = (ph - 1) / 9, sp = (ph - 1) % 9;
  const bf16_t* W = p.W + (size_t)l * W_LAYER;
  if (!((PH_MASK >> sp) & 1)) return;
  switch (sp) {
    case 0: norm_phase(p, l, 0, bid, nb); break;
    case 1: {
      EpiWin epi{p.P, p.rope64};
      for (int rd = 0;; ++rd) { int t = xcd_tile(rd, bid, nb); if (t >= 128 * 24) break; int pm, pn; big_coord(t, 24, pm, pn); gemm_big_tile(p.ACT, 1024, W + WO_IN, 1024, 1024, pm * 256, pn * 128, epi, lds); }
      for (int u = bid; u < 4 * 24; u += nb) gemm_tile(p.ACT, 1024, W + WO_IN, 1024, 1024, (256 + u / 24) * 128, (u % 24) * 128, epi, lds);
    } break;
    case 2: {
      EpiUq eq{&p}; EpiUkv ekv{&p};
      const int n0 = 260 * 4, n1 = n0 + 260 * 4, n2 = n1 + 260 * 3;
      for (int t = bid; t < n2; t += nb) {
        if (t < n0) ret_prep_item(p, l, t >> 2, t & 3, lds);
        else if (t < n1) { int u = t - n0, pm = u >> 2, h = u & 3; gemm_tile(p.P + C_CKV, PW, W + WO_UKV, 128, 128, pm * 128, h * 128, ekv, lds); mla_krope_item(p, pm * 128, h); }
        else { int u = t - n1, pm = u / 3, pn = u % 3; gemm_tile(p.P + C_CQ, PW, W + WO_UQ, 256, 256, pm * 128, pn * 128, eq, lds); }
      }
    } break;
    case 3: {
      int* slot = (int*)(lds + LDS_BYTES - 16);
      if (bid < 64) {
        if (CM & 2) ret_scan_item(p, l, bid >> 2, bid & 3);
        asm volatile("s_waitcnt vmcnt(0)" ::: "memory");
        __syncthreads();
        if (otid() == 0) { __builtin_amdgcn_fence(__ATOMIC_RELEASE, "agent"); asm volatile("s_waitcnt vmcnt(0)" ::: "memory"); xb_add(p.bar + 40 + l, 1u); }
      }
      bool scan_ready = false;
      const int x = bid & 7;
      for (int pass = 0; pass < 8; ++pass) {
        const int cmb = (x + pass) & 7;
        for (;;) {
          __syncthreads();
          if (otid() == 0) *slot = (int)atomicAdd(p.bar + 8 + l * 8 + cmb, 1u);
          __syncthreads();
          const int q = *slot;
          if (q >= 128) break;
          if (CM & 1) mla_item(p, cmb >> 2, cmb & 3, q, false, lds);
        }
      }
      const int n1 = 1024, n2 = n1 + 1024, n3 = n2 + 16, n4 = n3 + 16, n5 = n4 + 16, n6 = n5 + 1040;
      for (;;) {
        __syncthreads();
        if (otid() == 0) *slot = (int)atomicAdd(p.bar + l, 1u);
        __syncthreads();
        const int t = *slot;
        if (t >= n6) break;
        if (t < n1) { int u = t; if (CM & 4) na_item(p, l, u >> 9, (u >> 7) & 3, u & 127, lds); }
        else if (t < n2) { int u = t - n1; if (CM & 16) swa_item(p, l, u >> 9, (u >> 7) & 3, u & 127, false, lds); }
        else if (t < n3) { int u = t - n2; if (CM & 1) mla_item(p, u >> 3, (u >> 1) & 3, u & 1, true, lds); }
        else if (t < n4) { int u = t - n3; if (CM & 8) na_ctx_item(p, u >> 3, (u >> 1) & 3, u & 1, lds); }
        else if (t < n5) { int u = t - n4; if (CM & 16) swa_item(p, l, u >> 3, (u >> 1) & 3, u & 1, true, lds); }
        else {
          if (!scan_ready) {
            if (otid() == 0) { unsigned sp = 0; while (xb_ld(p.bar + 40 + l) < 64u && ++sp < (1u << 22)) __builtin_amdgcn_s_sleep(2); }
            __syncthreads();
            __builtin_amdgcn_fence(__ATOMIC_ACQUIRE, "agent");
            asm volatile("s_waitcnt vmcnt(0)" ::: "memory");
            scan_ready = true;
          }
          int u = t - n5; ret_out_item(p, l, u >> 2, u & 3, lds);
        }
      }
    } break;
    case 4: break;
    case 5: {
      EpiResid epi{&p, l, 2048, 1};
      for (int rd = 0;; ++rd) { int t = xcd_tile(rd, bid, nb); if (t >= 128 * 8) break; int pm, pn; big_coord(t, 8, pm, pn); gemm_big_tile(p.ACT, 1024, W + WO_OUT, 1024, 1024, pm * 256, pn * 128, epi, lds); }
      if (l < 3) for (int u = bid; u < 4 * 8; u += nb) gemm_tile(p.ACT, 1024, W + WO_OUT, 1024, 1024, (256 + (u >> 3)) * 128, (u & 7) * 128, epi, lds);
    } break;
    case 6: norm_phase(p, l, 1, bid, nb); break;
    case 7: {
      EpiFfn1 epi{p.P};
      for (int rd = 0;; ++rd) { int t = xcd_tile(rd, bid, nb); if (t >= 128 * 44) break; int pm, pn; big_coord(t, 44, pm, pn); gemm_big_tile(p.ACT, 1024, W + WO_13, 1024, 1024, pm * 256, pn * 128, epi, lds); }
      if (l < 3) for (int u = bid; u < 4 * 44; u += nb) gemm_tile(p.ACT, 1024, W + WO_13, 1024, 1024, (256 + u / 44) * 128, (u % 44) * 128, epi, lds);
    } break;
    case 8: {
      EpiResid epi{&p, l, 5120, 0};
      for (int rd = 0;; ++rd) { int t = xcd_tile(rd, bid, nb); if (t >= 128 * 8) break; int pm, pn; big_coord(t, 8, pm, pn); gemm_big_tile(p.P, 2816, W + WO_2, 2816, 2816, pm * 256, pn * 128, epi, lds); }
      if (l < 3) for (int u = bid; u < 4 * 8; u += nb) gemm_tile(p.P, 2816, W + WO_2, 2816, 2816, (256 + (u >> 3)) * 128, (u & 7) * 128, epi, lds);
    } break;
  }
}

__global__ void __launch_bounds__(256, 2) mega_kernel(Params p, int ph_lo, int ph_hi) {
  __shared__ __attribute__((aligned(16))) char lds[LDS_BYTES];
  __shared__ u32x4 xb_words;
#ifndef REP_MASK
#define REP_MASK 0
#endif
  if (ph_lo < 0) cg::this_grid().sync();
  if (threadIdx.x == 0) xb_words = (u32x4){0u, 0u, 0u, 0u};
  __syncthreads();
  XcdBarrier xb; xb.bar = p.bar; xb.x = 0; xb.st = (volatile LAS unsigned*)&xb_words;
  if (ph_hi - ph_lo > 1) xb = xcd_barrier_post(p.bar, (volatile LAS unsigned*)&xb_words);
  for (int ph = ph_lo; ph < ph_hi; ++ph) {
    if (ph >= 1 && ph <= 36 && (ph - 1) % 9 == 4) continue;
    const int reps = (REP_MASK && ph >= 1 && ph <= 36 && ((REP_MASK >> ((ph - 1) % 9)) & 1)) ? 2 : 1;
    for (int r = 0; r < reps; ++r) {
      run_phase(p, ph, blockIdx.x, gridDim.x, lds);
      if (r + 1 < reps || ph + 1 < ph_hi) xcd_barrier(xb);
#ifdef EXTRA_SYNC
      for (int e = 0; e < EXTRA_SYNC; ++e) xcd_barrier(xb);
#endif
    }
  }
}

extern "C" void kernel_launch(void* const* d_in, const int* in_sizes, int n_in, void* d_out, int out_size, void* d_ws, size_t ws_size,
                              hipStream_t stream) {
  Params p{};
  const float** f = (const float**)&p;
  for (int i = 0; i < 21; ++i) f[i] = (const float*)d_in[i];
  p.out = (float*)d_out;
  char* w = (char*)d_ws; size_t off = 0;
  auto take = [&](size_t bytes) { char* r = w + off; off += (bytes + 255) & ~(size_t)255; return r; };
  p.Y = (float*)take((size_t)512 * 1024 * 4);
  p.ACT = (bf16_t*)take((size_t)NROWS * 1024 * 2);
  p.P = (bf16_t*)take((size_t)NROWS * PW * 2);
  p.Qm = (bf16_t*)take((size_t)NROWS * 384 * 2);
  p.Km = (bf16_t*)take((size_t)8 * 16640 * 96 * 2);
  p.Vm = (bf16_t*)take((size_t)8 * 16640 * 64 * 2);
  p.Ksum = (float*)take((size_t)2 * 260 * 4 * 4096 * 4);
  p.St = (bf16_t*)take((size_t)2 * 260 * 4 * 4096 * 2);
  p.W = (bf16_t*)take((size_t)4 * W_LAYER * 2);
  p.mod = (float*)take((size_t)4 * 3 * 6144 * 4);
  p.rope64 = (float*)take(256 * 16 * 2 * 4);
  p.rope32 = (float*)take(256 * 8 * 2 * 4);
  p.bar = (unsigned*)take(XCD_BAR_WORDS * 4);
  if (off > ws_size) { fprintf(stderr, "workspace too small: need %zu have %zu\n", off, ws_size); return; }
#if MULTI_LAUNCH
  for (int ph = 0; ph < 38; ++ph) hipLaunchKernelGGL(mega_kernel, dim3(512), dim3(256), 0, stream, p, ph, ph + 1);
#else
  static int grid_blocks = 0;
  if (!grid_blocks) {
    int dev = 0, cus = 0, per_cu = 0;
    hipGetDevice(&dev);
    hipDeviceGetAttribute(&cus, hipDeviceAttributeMultiprocessorCount, dev);
    hipOccupancyMaxActiveBlocksPerMultiprocessor(&per_cu, mega_kernel, 256, 0);
    if (per_cu > 2) per_cu = 2;
    grid_blocks = cus * per_cu;
  }
  hipMemsetAsync(p.bar, 0, XCD_BAR_WORDS * 4, stream);
  int lo = 0, hi = 38;
  void* args[] = {&p, &lo, &hi};
  hipError_t e = hipLaunchCooperativeKernel((void*)mega_kernel, dim3(grid_blocks), dim3(256), args, 0, stream);
  if (e != hipSuccess) fprintf(stderr, "cooperative launch failed: %s (grid %d)\n", hipGetErrorString(e), grid_blocks);
#endif
}
```
